# Optimizing an MI355X kernel written in HIP

```python
import math
import jax, jax.numpy as jnp
from jax import lax
import numpy as np

D_MODEL = 1024
BATCH = 8
SEQ = 2048
DEPTH = 1

CHUNK = 64
Q_BLOCK = 128
NORM_EPS = 1e-6

DA_HEADS = 8
DA_HEAD_DIM = 64
DA_V_DIM = 2 * DA_HEAD_DIM
ROPE_THETA = 500000.0
ROPE_DIM = DA_HEAD_DIM // 4
QK_WIDTH = DA_HEADS * 2 * DA_HEAD_DIM
V_WIDTH = DA_HEADS * DA_V_DIM

POOL_WINDOWS = (2, 4, 8, 16)
POOL_GROUPS = len(POOL_WINDOWS)
POOL_GROUP_DIM = 128
POOL_WIDTH = POOL_GROUPS * POOL_GROUP_DIM

N_BRANCHES = 2
IN_WIDTH = 2 * QK_WIDTH + V_WIDTH + POOL_WIDTH + N_BRANCHES * D_MODEL

N_EXPERTS = 32
TOP_K = 4
D_FF = D_MODEL
SWIGLU_LIMIT = 7.0
SWIGLU_ALPHA = 1.702

N_MOD = 6

kernel_name = "hybrid_diffattn_pool_moe_block"


def rms_norm(x, g):
    xf = x.astype(jnp.float32)
    y = xf * lax.rsqrt(jnp.mean(xf * xf, axis=-1, keepdims=True) + NORM_EPS)
    return (y * g.astype(jnp.float32)).astype(x.dtype)


def rope_tables(positions, dtype):
    inv_freq = ROPE_THETA ** (-jnp.arange(0, ROPE_DIM, 2, dtype=jnp.float32) / ROPE_DIM)
    ang = positions.astype(jnp.float32)[..., None] * inv_freq
    return jnp.cos(ang)[:, :, None, :].astype(dtype), jnp.sin(ang)[:, :, None, :].astype(dtype)


def apply_partial_rope(t, cos, sin):
    rot, rest = t[..., :ROPE_DIM], t[..., ROPE_DIM:]
    r1, r2 = rot[..., :ROPE_DIM // 2], rot[..., ROPE_DIM // 2:]
    rot = jnp.concatenate([r1 * cos - r2 * sin, r2 * cos + r1 * sin], axis=-1)
    return jnp.concatenate([rot, rest], axis=-1)


def diff_attention(q, k, v, lam, g_sub, lambda_init):
    B, S = q.shape[0], q.shape[1]
    nb = S // Q_BLOCK
    scale = DA_HEAD_DIM ** -0.5
    qb = q.reshape(B, nb, Q_BLOCK, 2 * DA_HEADS, DA_HEAD_DIM).transpose(1, 0, 3, 2, 4)
    kt = k.transpose(0, 2, 1, 3)
    vt = v.transpose(0, 2, 1, 3)
    key_chunk = jnp.arange(S) // CHUNK

    def block(args):
        q_blk, i = args
        s = jnp.einsum('bnqd,bnkd->bnqk', q_blk, kt).astype(jnp.float32) * scale
        q_chunk = (i * Q_BLOCK + jnp.arange(Q_BLOCK)) // CHUNK
        mask = key_chunk[None, :] <= q_chunk[:, None]
        s = jnp.where(mask, s, -jnp.inf)
        p = jax.nn.softmax(s, axis=-1).reshape(B, DA_HEADS, 2, Q_BLOCK, S)
        a = p[:, :, 0] - lam * p[:, :, 1]
        return jnp.einsum('bhqk,bhkd->bhqd', a.astype(vt.dtype), vt)

    o = lax.map(block, (qb, jnp.arange(nb)))
    o = o.transpose(1, 0, 3, 2, 4).reshape(B, S, DA_HEADS, DA_V_DIM)
    o = rms_norm(o, g_sub) * (1.0 - lambda_init)
    return o.reshape(B, S, V_WIDTH)


def multiscale_pool(p, w_group, pool_scale):
    B, S, _ = p.shape
    pf = p.astype(jnp.float32).reshape(B, S, POOL_GROUPS, POOL_GROUP_DIM)
    cs = jnp.concatenate([jnp.zeros((B, 1, POOL_GROUPS, POOL_GROUP_DIM), jnp.float32),
                          jnp.cumsum(pf, axis=1)], axis=1)
    t = jnp.arange(S)
    outs = []
    for g, w in enumerate(POOL_WINDOWS):
        start = jnp.maximum(t + 1 - w, 0)
        cnt = (t + 1 - start).astype(jnp.float32)
        mean = (cs[:, 1:, g] - cs[:, start, g]) / cnt[None, :, None]
        outs.append(mean - pf[:, :, g])
    mixed = jnp.stack(outs, axis=2).astype(p.dtype)
    y = jnp.einsum('bsgc,gcd->bsgd', mixed, w_group)
    return y.reshape(B, S, POOL_WIDTH) * pool_scale


def routed_experts(h, w_router, b_router, w_gate_up, b_gate_up, w_down, b_down):
    B, S, D = h.shape
    xt = h.reshape(-1, D)
    T = xt.shape[0]
    logits = (xt @ w_router).astype(jnp.float32) + b_router.astype(jnp.float32)
    top_v, top_i = lax.top_k(logits, TOP_K)
    probs = jax.nn.softmax(top_v, axis=-1)
    eid = top_i.reshape(-1)
    tok = jnp.repeat(jnp.arange(T), TOP_K)
    order = jnp.argsort(eid)
    eid_s, tok_s = eid[order], tok[order]
    w_s = probs.reshape(-1)[order]
    group_sizes = jnp.bincount(eid, length=N_EXPERTS).astype(jnp.int32)
    xs = xt[tok_s]
    gu = lax.ragged_dot(xs, w_gate_up, group_sizes) + b_gate_up[eid_s]
    gate, up = gu[:, :D_FF], gu[:, D_FF:]
    gate = jnp.minimum(gate, SWIGLU_LIMIT)
    up = jnp.clip(up, -SWIGLU_LIMIT, SWIGLU_LIMIT)
    act = (up + 1.0) * (gate * jax.nn.sigmoid(SWIGLU_ALPHA * gate))
    y = lax.ragged_dot(act, w_down, group_sizes) + b_down[eid_s]
    out = jnp.zeros((T, D), y.dtype).at[tok_s].add(y * w_s[:, None].astype(y.dtype))
    return out.reshape(B, S, D).astype(h.dtype)


def setup_inputs(seed: int = 0) -> dict:
    key = jax.random.key(seed)
    ks = jax.random.split(key, 32)
    f32 = jnp.float32
    nrm = lambda k, shape, s: jax.random.normal(k, shape, f32) * s
    gain = lambda k, shape: 1.0 + 0.05 * jax.random.normal(k, shape, f32)
    L = DEPTH
    offsets = jax.random.randint(ks[2], (BATCH, 1), 0, 64) * CHUNK
    positions = (offsets + jnp.arange(SEQ)[None, :]).astype(jnp.int32)
    return {
        "x": nrm(ks[0], (BATCH, SEQ, D_MODEL), 1.0),
        "c": nrm(ks[1], (BATCH, D_MODEL), 1.0),
        "positions": positions,
        "w_mod": nrm(ks[3], (L, D_MODEL, N_MOD * D_MODEL), D_MODEL ** -0.5),
        "b_mod": nrm(ks[4], (L, N_MOD * D_MODEL), 0.02),
        "g_pre_mix": gain(ks[5], (L, D_MODEL)),
        "w_in": nrm(ks[6], (L, D_MODEL, IN_WIDTH), D_MODEL ** -0.5),
        "lambda_q1": nrm(ks[7], (L, DA_HEAD_DIM), 0.1),
        "lambda_k1": nrm(ks[8], (L, DA_HEAD_DIM), 0.1),
        "lambda_q2": nrm(ks[9], (L, DA_HEAD_DIM), 0.1),
        "lambda_k2": nrm(ks[10], (L, DA_HEAD_DIM), 0.1),
        "g_sub": gain(ks[11], (L, DA_V_DIM)),
        "w_pool_group": nrm(ks[12], (L, POOL_GROUPS, POOL_GROUP_DIM, POOL_GROUP_DIM), POOL_GROUP_DIM ** -0.5),
        "pool_scale": gain(ks[13], (L, POOL_WIDTH)),
        "w_att_branch": nrm(ks[14], (L, V_WIDTH, D_MODEL), V_WIDTH ** -0.5),
        "w_pool_branch": nrm(ks[15], (L, POOL_WIDTH, D_MODEL), POOL_WIDTH ** -0.5),
        "w_out": nrm(ks[16], (L, D_MODEL, D_MODEL), D_MODEL ** -0.5),
        "g_post_mix": gain(ks[17], (L, D_MODEL)),
        "g_pre_ffn": gain(ks[18], (L, D_MODEL)),
        "w_router": nrm(ks[19], (L, D_MODEL, N_EXPERTS), D_MODEL ** -0.5),
        "b_router": nrm(ks[20], (L, N_EXPERTS), 0.01),
        "w_gate_up": nrm(ks[21], (L, N_EXPERTS, D_MODEL, 2 * D_FF), D_MODEL ** -0.5),
        "b_gate_up": nrm(ks[22], (L, N_EXPERTS, 2 * D_FF), 0.01),
        "w_down": nrm(ks[23], (L, N_EXPERTS, D_FF, D_MODEL), D_FF ** -0.5),
        "b_down": nrm(ks[24], (L, N_EXPERTS, D_MODEL), 0.01),
        "g_post_ffn": gain(ks[25], (L, D_MODEL)),
    }


def reference(x, c, positions, w_mod, b_mod, g_pre_mix, w_in, lambda_q1, lambda_k1,
              lambda_q2, lambda_k2, g_sub, w_pool_group, pool_scale, w_att_branch,
              w_pool_branch, w_out, g_post_mix, g_pre_ffn, w_router, b_router,
              w_gate_up, b_gate_up, w_down, b_down, g_post_ffn):
    B, S, D = x.shape
    cos, sin = rope_tables(positions, x.dtype)
    c_act = jax.nn.silu(c)
    splits = np.cumsum([QK_WIDTH, QK_WIDTH, V_WIDTH, POOL_WIDTH, D_MODEL]).tolist()
    for l in range(DEPTH):
        lambda_init = 0.8 - 0.6 * math.exp(-0.3 * l)
        mod = (c_act @ w_mod[l] + b_mod[l])[:, None, :]
        shift_m, scale_m, gate_m, shift_f, scale_f, gate_f = jnp.split(mod, N_MOD, axis=-1)

        u = rms_norm(x, g_pre_mix[l]) * (1.0 + scale_m) + shift_m
        z = u @ w_in[l]
        q, k, v, p, ga, gp = jnp.split(z, splits, axis=-1)
        q = apply_partial_rope(q.reshape(B, S, 2 * DA_HEADS, DA_HEAD_DIM), cos, sin)
        k = apply_partial_rope(k.reshape(B, S, 2 * DA_HEADS, DA_HEAD_DIM), cos, sin)
        v = v.reshape(B, S, DA_HEADS, DA_V_DIM)
        lam = (jnp.exp(jnp.sum(lambda_q1[l].astype(jnp.float32) * lambda_k1[l].astype(jnp.float32)))
               - jnp.exp(jnp.sum(lambda_q2[l].astype(jnp.float32) * lambda_k2[l].astype(jnp.float32)))
               + lambda_init)
        y_att = diff_attention(q, k, v, lam, g_sub[l], lambda_init) @ w_att_branch[l]
        y_pool = multiscale_pool(p, w_pool_group[l], pool_scale[l]) @ w_pool_branch[l]
        merged = jax.nn.sigmoid(ga) * y_att + jax.nn.sigmoid(gp) * y_pool
        mix_out = merged @ w_out[l]
        x = x + gate_m * rms_norm(mix_out, g_post_mix[l])

        u = rms_norm(x, g_pre_ffn[l]) * (1.0 + scale_f) + shift_f
        f = routed_experts(u, w_router[l], b_router[l], w_gate_up[l], b_gate_up[l],
                           w_down[l], b_down[l])
        x = x + gate_f * rms_norm(f, g_post_ffn[l])
    return x
```

```cpp
#include <hip/hip_runtime.h>
#include <hip/hip_bf16.h>
#include <cstdio>
#include <cstdint>
#include <cmath>
namespace nv {
constexpr int T = 16384, D = 1024, SEQ = 2048, NB = 8, INW = 5632, NE = 32, DFF = 1024, NMOD = 6144;
constexpr float EPS = 1e-6f;

__device__ __forceinline__ float wsum(float v) {
#pragma unroll
    for (int o = 1; o < 64; o <<= 1) v += __shfl_xor(v, o);
    return v;
}
__device__ __forceinline__ float sigm(float x) { return 1.f / (1.f + __expf(-x)); }

__global__ void k_mod(const float* c, const float* w_mod, const float* b_mod, float* mod) {
    for (int idx = blockIdx.x * blockDim.x + threadIdx.x; idx < NB * NMOD; idx += gridDim.x * blockDim.x) {
        const int b = idx / NMOD, j = idx % NMOD;
        float acc = b_mod[j];
        for (int k = 0; k < D; ++k) { const float cv = c[b * D + k]; acc += (cv / (1.f + expf(-cv))) * w_mod[(size_t)k * NMOD + j]; }
        mod[idx] = acc;
    }
}
__global__ void k_u(const float* x, const float* g, const float* mod, int shift_off, int scale_off, float* u) {
    const int lane = threadIdx.x & 63, gw = (blockIdx.x * blockDim.x + threadIdx.x) >> 6, nw = (gridDim.x * blockDim.x) >> 6;
    for (int m = gw; m < T; m += nw) {
        const int b = m / SEQ;
        float v[16]; float ss = 0.f;
#pragma unroll
        for (int j = 0; j < 16; ++j) { v[j] = x[(size_t)m * D + lane + 64 * j]; ss += v[j] * v[j]; }
        const float rstd = rsqrtf(wsum(ss) * (1.f / D) + EPS);
#pragma unroll
        for (int j = 0; j < 16; ++j) { const int k = lane + 64 * j;
            u[(size_t)m * D + k] = v[j] * rstd * g[k] * (1.f + mod[b * NMOD + scale_off + k]) + mod[b * NMOD + shift_off + k]; }
    }
}
template <int MODE>
__device__ void gemm_tiles(const float* A, int lda, const float* B, int ldb, float* C, int ldc, const float* bias, const float* cscale,
                           const int* rowlist, int a_shift, int Mcount, int N, int K, int item0, int stride, float* sm) {
    float* As = sm;
    float* Bs = sm + 16 * 128;
    float* Bs2 = Bs + 16 * 64;
    const int tid = threadIdx.x, ty = tid >> 4, tx = tid & 15;
    const int ntn = N / 64, ntm = (Mcount + 127) / 128;
    for (int item = item0; item < ntm * ntn; item += stride) {
        const int tm = item / ntn, tn = item % ntn;
        float acc[8][4], acc2[8][4];
#pragma unroll
        for (int i = 0; i < 8; ++i)
#pragma unroll
            for (int j = 0; j < 4; ++j) { acc[i][j] = 0.f; acc2[i][j] = 0.f; }
        const int lr = tid >> 1, lk = (tid & 1) * 8;
        const int gi = tm * 128 + lr;
        const bool rv = gi < Mcount;
        size_t arow = 0;
        if (rv) { const int cr = rowlist ? rowlist[gi] : gi; arow = (size_t)(cr >> a_shift); }
        const int bk = tid >> 4, bc = (tid & 15) * 4;
        for (int k0 = 0; k0 < K; k0 += 16) {
            float4 a0 = make_float4(0, 0, 0, 0), a1 = a0;
            if (rv) { a0 = *(const float4*)(A + arow * lda + k0 + lk); a1 = *(const float4*)(A + arow * lda + k0 + lk + 4); }
            const float4 b0 = *(const float4*)(B + (size_t)(k0 + bk) * ldb + tn * 64 + bc);
            float4 b1 = make_float4(0, 0, 0, 0);
            if (MODE == 1) b1 = *(const float4*)(B + (size_t)(k0 + bk) * ldb + N + tn * 64 + bc);
            __syncthreads();
            As[(lk + 0) * 128 + lr] = a0.x; As[(lk + 1) * 128 + lr] = a0.y; As[(lk + 2) * 128 + lr] = a0.z; As[(lk + 3) * 128 + lr] = a0.w;
            As[(lk + 4) * 128 + lr] = a1.x; As[(lk + 5) * 128 + lr] = a1.y; As[(lk + 6) * 128 + lr] = a1.z; As[(lk + 7) * 128 + lr] = a1.w;
            *(float4*)(Bs + bk * 64 + bc) = b0;
            if (MODE == 1) *(float4*)(Bs2 + bk * 64 + bc) = b1;
            __syncthreads();
#pragma unroll 2
            for (int k = 0; k < 16; ++k) {
                const float4 x0 = *(const float4*)(As + k * 128 + ty * 8), x1 = *(const float4*)(As + k * 128 + ty * 8 + 4);
                const float4 y = *(const float4*)(Bs + k * 64 + tx * 4);
                const float av[8] = {x0.x, x0.y, x0.z, x0.w, x1.x, x1.y, x1.z, x1.w};
                const float bv[4] = {y.x, y.y, y.z, y.w};
#pragma unroll
                for (int i = 0; i < 8; ++i)
#pragma unroll
                    for (int j = 0; j < 4; ++j) acc[i][j] += av[i] * bv[j];
                if (MODE == 1) {
                    const float4 y2 = *(const float4*)(Bs2 + k * 64 + tx * 4);
                    const float bv2[4] = {y2.x, y2.y, y2.z, y2.w};
#pragma unroll
                    for (int i = 0; i < 8; ++i)
#pragma unroll
                        for (int j = 0; j < 4; ++j) acc2[i][j] += av[i] * bv2[j];
                }
            }
        }
#pragma unroll
        for (int i = 0; i < 8; ++i) {
            const int gr = tm * 128 + ty * 8 + i;
            if (gr < Mcount) {
                const size_t crow = rowlist ? (size_t)rowlist[gr] : (size_t)gr;
#pragma unroll
                for (int j = 0; j < 4; ++j) {
                    const int col = tn * 64 + tx * 4 + j;
                    float v = acc[i][j] + (bias ? bias[col] : 0.f);
                    if (MODE == 1) {
                        float gt = fminf(v, 7.f);
                        float up = acc2[i][j] + (bias ? bias[N + col] : 0.f);
                        up = fminf(fmaxf(up, -7.f), 7.f);
                        v = (up + 1.f) * (gt * sigm(1.702f * gt));
                    }
                    if (cscale) v *= cscale[col];
                    C[crow * ldc + col] = v;
                }
            }
        }
    }
}
template <int MODE>
__global__ void __launch_bounds__(256) k_gemm(const float* A, int lda, const float* B, int ldb, float* C, int ldc, const float* bias, const float* cscale, int M, int N, int K) {
    __shared__ float sm[16 * 128 + 2 * 16 * 64];
    gemm_tiles<MODE>(A, lda, B, ldb, C, ldc, bias, cscale, nullptr, 0, M, N, K, blockIdx.x, gridDim.x, sm);
}
template <int MODE>
__global__ void __launch_bounds__(256) k_gemm_moe(const float* A, int lda, const float* Ball, size_t bstride, int ldb, float* C, int ldc, const float* biasall, int biasstride,
                                                   const int* cnt, const int* lists, int a_shift, int N, int K) {
    __shared__ float sm[16 * 128 + 2 * 16 * 64];
    for (int e = 0; e < NE; ++e) {
        const int c = cnt[e];
        gemm_tiles<MODE>(A, lda, Ball + (size_t)e * bstride, ldb, C, ldc, biasall + (size_t)e * biasstride, nullptr, lists + (size_t)e * T, a_shift, c, N, K, blockIdx.x, gridDim.x, sm);
    }
}
__global__ void k_rope(float* z, const int* pos) {
    const size_t total = (size_t)T * 2 * 16 * 8;
    for (size_t idx = (size_t)blockIdx.x * blockDim.x + threadIdx.x; idx < total; idx += (size_t)gridDim.x * blockDim.x) {
        const int i = idx & 7, n = (idx >> 3) & 15, w = (idx >> 7) & 1; const int m = (int)(idx >> 8);
        const double invf = pow(500000.0, -(double)i / 8.0);
        const double ang = (double)pos[m] * invf;
        const float cs = (float)cos(ang), sn = (float)sin(ang);
        float* p = z + (size_t)m * INW + w * 1024 + n * 64 + i;
        const float r1 = p[0], r2 = p[8];
        p[0] = r1 * cs - r2 * sn; p[8] = r2 * cs + r1 * sn;
    }
}
__global__ void __launch_bounds__(256) k_attn(const float* z, const float* lq1, const float* lk1, const float* lq2, const float* lk2, const float* g_sub, float* o) {
    __shared__ float Ks1[64 * 64], Ks2[64 * 64], Vs[64 * 128];
    const int tid = threadIdx.x, r = tid >> 2, j = tid & 3;
    float d1 = 0.f, d2 = 0.f;
    for (int i = 0; i < 64; ++i) { d1 += lq1[i] * lk1[i]; d2 += lq2[i] * lk2[i]; }
    const float lam = expf(d1) - expf(d2) + 0.2f;
    for (int item = blockIdx.x; item < NB * 8 * 32; item += gridDim.x) {
        const int b = item >> 8, h = (item >> 5) & 7, c = item & 31;
        const size_t m = (size_t)b * SEQ + c * 64 + r;
        float q1[16], q2[16];
#pragma unroll
        for (int i = 0; i < 16; ++i) { q1[i] = z[m * INW + (2 * h) * 64 + j * 16 + i] * 0.125f; q2[i] = z[m * INW + (2 * h + 1) * 64 + j * 16 + i] * 0.125f; }
        float m1 = -INFINITY, l1 = 0.f, m2 = -INFINITY, l2 = 0.f, a1[32], a2[32];
#pragma unroll
        for (int d = 0; d < 32; ++d) { a1[d] = 0.f; a2[d] = 0.f; }
        for (int kt = 0; kt <= c; ++kt) {
            __syncthreads();
            for (int e = tid; e < 64 * 64; e += 256) { const int kr = e >> 6, kc = e & 63; const size_t km = (size_t)b * SEQ + kt * 64 + kr;
                Ks1[e] = z[km * INW + 1024 + (2 * h) * 64 + kc]; Ks2[e] = z[km * INW + 1024 + (2 * h + 1) * 64 + kc]; }
            for (int e = tid; e < 64 * 128; e += 256) { const int kr = e >> 7, kc = e & 127; const size_t km = (size_t)b * SEQ + kt * 64 + kr;
                Vs[e] = z[km * INW + 2048 + h * 128 + kc]; }
            __syncthreads();
            for (int kk = 0; kk < 64; ++kk) {
                float s1 = 0.f, s2 = 0.f;
#pragma unroll
                for (int i = 0; i < 16; ++i) { s1 += q1[i] * Ks1[kk * 64 + j * 16 + i]; s2 += q2[i] * Ks2[kk * 64 + j * 16 + i]; }
                s1 += __shfl_xor(s1, 1); s1 += __shfl_xor(s1, 2); s2 += __shfl_xor(s2, 1); s2 += __shfl_xor(s2, 2);
                { const float mn = fmaxf(m1, s1), al = __expf(m1 - mn), p = __expf(s1 - mn); l1 = l1 * al + p; m1 = mn;
#pragma unroll
                  for (int d = 0; d < 32; ++d) a1[d] = a1[d] * al + p * Vs[kk * 128 + j * 32 + d]; }
                { const float mn = fmaxf(m2, s2), al = __expf(m2 - mn), p = __expf(s2 - mn); l2 = l2 * al + p; m2 = mn;
#pragma unroll
                  for (int d = 0; d < 32; ++d) a2[d] = a2[d] * al + p * Vs[kk * 128 + j * 32 + d]; }
            }
        }
        float ov[32], ss = 0.f; const float i1 = 1.f / l1, i2 = lam / l2;
#pragma unroll
        for (int d = 0; d < 32; ++d) { ov[d] = a1[d] * i1 - a2[d] * i2; ss += ov[d] * ov[d]; }
        ss += __shfl_xor(ss, 1); ss += __shfl_xor(ss, 2);
        const float rstd = rsqrtf(ss * (1.f / 128.f) + EPS) * 0.8f;
#pragma unroll
        for (int d = 0; d < 32; ++d) o[m * D + h * 128 + j * 32 + d] = ov[d] * rstd * g_sub[j * 32 + d];
    }
}
__global__ void k_poolmix(const float* z, float* mixed) {
    for (size_t idx = (size_t)blockIdx.x * blockDim.x + threadIdx.x; idx < (size_t)T * 512; idx += (size_t)gridDim.x * blockDim.x) {
        const int col = idx & 511; const int m = (int)(idx >> 9); const int g = col >> 7, w = 2 << g, s = m & (SEQ - 1);
        const int start = (s + 1 - w) > 0 ? (s + 1 - w) : 0, cnt = s + 1 - start;
        float acc = 0.f;
        for (int t = start; t <= s; ++t) acc += z[(size_t)(m - s + t) * INW + 3072 + col];
        mixed[idx] = acc / (float)cnt - z[(size_t)m * INW + 3072 + col];
    }
}
__global__ void k_gate(const float* z, float* yatt, const float* ypool) {
    for (size_t idx = (size_t)blockIdx.x * blockDim.x + threadIdx.x; idx < (size_t)T * D; idx += (size_t)gridDim.x * blockDim.x) {
        const int col = idx & 1023; const size_t m = idx >> 10;
        yatt[idx] = sigm(z[m * INW + 3584 + col]) * yatt[idx] + sigm(z[m * INW + 4608 + col]) * ypool[idx];
    }
}
__global__ void k_p6(const float* x, const float* mixout, const float* mod, const float* g_post_mix, const float* g_pre_ffn, const float* w_router, const float* b_router,
                     float* out, float* u2, float* prob, int* cnt, int* lists) {
    const int lane = threadIdx.x & 63, gw = (blockIdx.x * blockDim.x + threadIdx.x) >> 6, nw = (gridDim.x * blockDim.x) >> 6;
    for (int m = gw; m < T; m += nw) {
        const int b = m / SEQ; const float* md = mod + b * NMOD;
        float v[16]; float ss = 0.f;
#pragma unroll
        for (int j = 0; j < 16; ++j) { v[j] = mixout[(size_t)m * D + lane + 64 * j]; ss += v[j] * v[j]; }
        float rstd = rsqrtf(wsum(ss) * (1.f / D) + EPS);
        ss = 0.f;
#pragma unroll
        for (int j = 0; j < 16; ++j) { const int k = lane + 64 * j; v[j] = x[(size_t)m * D + k] + md[2048 + k] * (v[j] * rstd * g_post_mix[k]); out[(size_t)m * D + k] = v[j]; ss += v[j] * v[j]; }
        rstd = rsqrtf(wsum(ss) * (1.f / D) + EPS);
#pragma unroll
        for (int j = 0; j < 16; ++j) { const int k = lane + 64 * j; v[j] = v[j] * rstd * g_pre_ffn[k] * (1.f + md[4096 + k]) + md[3072 + k]; u2[(size_t)m * D + k] = v[j]; }
        float mylg = -INFINITY;
#pragma unroll 1
        for (int e = 0; e < NE; ++e) { float p = 0.f;
#pragma unroll
            for (int j = 0; j < 16; ++j) p += v[j] * w_router[(size_t)(lane + 64 * j) * NE + e];
            const float s = wsum(p) + b_router[e];
            if (lane == e) mylg = s; }
        int sel[4]; float sv[4];
#pragma unroll
        for (int k = 0; k < 4; ++k) { float bv = mylg; int bi = lane;
#pragma unroll
            for (int off = 1; off < 64; off <<= 1) { const float ov = __shfl_xor(bv, off); const int oi = __shfl_xor(bi, off);
                if (ov > bv || (ov == bv && oi < bi)) { bv = ov; bi = oi; } }
            sel[k] = bi; sv[k] = bv; if (lane == bi) mylg = -INFINITY; }
        float den = 0.f, pe[4];
#pragma unroll
        for (int k = 0; k < 4; ++k) { pe[k] = __expf(sv[k] - sv[0]); den += pe[k]; }
        if (lane == 0) {
#pragma unroll
            for (int k = 0; k < 4; ++k) { prob[m * 4 + k] = pe[k] / den; const int slot = atomicAdd(&cnt[sel[k]], 1); lists[(size_t)sel[k] * T + slot] = m * 4 + k; }
        }
    }
}
__global__ void k_final(const float* y, const float* prob, const float* mod, const float* g_post_ffn, float* out) {
    const int lane = threadIdx.x & 63, gw = (blockIdx.x * blockDim.x + threadIdx.x) >> 6, nw = (gridDim.x * blockDim.x) >> 6;
    for (int m = gw; m < T; m += nw) {
        const int b = m / SEQ; const float* md = mod + b * NMOD;
        float f[16]; float ss = 0.f;
#pragma unroll
        for (int j = 0; j < 16; ++j) { const int k = lane + 64 * j; float a = 0.f;
#pragma unroll
            for (int kk = 0; kk < 4; ++kk) a += prob[m * 4 + kk] * y[((size_t)m * 4 + kk) * D + k];
            f[j] = a; ss += a * a; }
        const float rstd = rsqrtf(wsum(ss) * (1.f / D) + EPS);
#pragma unroll
        for (int j = 0; j < 16; ++j) { const int k = lane + 64 * j; out[(size_t)m * D + k] += md[5120 + k] * (f[j] * rstd * g_post_ffn[k]); }
    }
}
}

extern "C" void kernel_launch(void* const* d_in, const int* in_sizes, int n_in, void* d_out, int out_size, void* d_ws, size_t ws_size, hipStream_t stream) {
    using namespace nv;
    const float* x = (const float*)d_in[0]; const float* c = (const float*)d_in[1]; const int* pos = (const int*)d_in[2];
    const float* w_mod = (const float*)d_in[3]; const float* b_mod = (const float*)d_in[4]; const float* g_pre_mix = (const float*)d_in[5];
    const float* w_in = (const float*)d_in[6]; const float* lq1 = (const float*)d_in[7]; const float* lk1 = (const float*)d_in[8];
    const float* lq2 = (const float*)d_in[9]; const float* lk2 = (const float*)d_in[10]; const float* g_sub = (const float*)d_in[11];
    const float* w_pg = (const float*)d_in[12]; const float* pool_scale = (const float*)d_in[13]; const float* w_att = (const float*)d_in[14];
    const float* w_pb = (const float*)d_in[15]; const float* w_out = (const float*)d_in[16]; const float* g_post_mix = (const float*)d_in[17];
    const float* g_pre_ffn = (const float*)d_in[18]; const float* w_router = (const float*)d_in[19]; const float* b_router = (const float*)d_in[20];
    const float* w_gu = (const float*)d_in[21]; const float* b_gu = (const float*)d_in[22]; const float* w_dn = (const float*)d_in[23];
    const float* b_dn = (const float*)d_in[24]; const float* g_post_ffn = (const float*)d_in[25];
    float* out = (float*)d_out; float* ws = (float*)d_ws;
    const size_t TD = (size_t)T * D;
    size_t o = 0;
    float* mod = ws + o; o += 65536;
    const size_t regA = o;
    float* u = ws + o; o += TD;
    float* z = ws + o; o += (size_t)T * INW;
    float* ob = ws + o; o += TD;
    float* mixed = ws + o; o += TD / 2;
    float* ypp = ws + o; o += TD / 2;
    float* yatt = ws + o; o += TD;
    float* ypool = ws + o; o += TD;
    float* mixout = ws + o; o += TD;
    float* u2 = ws + o; o += TD;
    float* prob = ws + o; o += 65536;
    int* cnt = (int*)(ws + o); o += 1024;
    int* lists = (int*)(ws + o); o += (size_t)NE * T;
    float* act = ws + regA; float* y = ws + regA + 4 * TD;
    if (o * 4 > ws_size || n_in != 26) return;
    const int G = 2048, B = 256;
    hipMemsetAsync(cnt, 0, 4096, stream);
    k_mod<<<192, B, 0, stream>>>(c, w_mod, b_mod, mod);
    k_u<<<G, B, 0, stream>>>(x, g_pre_mix, mod, 0, 1024, u);
    k_gemm<0><<<G, B, 0, stream>>>(u, D, w_in, INW, z, INW, nullptr, nullptr, T, INW, D);
    k_rope<<<G, B, 0, stream>>>(z, pos);
    k_attn<<<G, B, 0, stream>>>(z, lq1, lk1, lq2, lk2, g_sub, ob);
    k_poolmix<<<G, B, 0, stream>>>(z, mixed);
    for (int g = 0; g < 4; ++g)
        k_gemm<0><<<G, B, 0, stream>>>(mixed + g * 128, 512, w_pg + (size_t)g * 128 * 128, 128, ypp + g * 128, 512, nullptr, pool_scale + g * 128, T, 128, 128);
    k_gemm<0><<<G, B, 0, stream>>>(ob, D, w_att, D, yatt, D, nullptr, nullptr, T, D, D);
    k_gemm<0><<<G, B, 0, stream>>>(ypp, 512, w_pb, D, ypool, D, nullptr, nullptr, T, D, 512);
    k_gate<<<G, B, 0, stream>>>(z, yatt, ypool);
    k_gemm<0><<<G, B, 0, stream>>>(yatt, D, w_out, D, mixout, D, nullptr, nullptr, T, D, D);
    k_p6<<<G, B, 0, stream>>>(x, mixout, mod, g_post_mix, g_pre_ffn, w_router, b_router, out, u2, prob, cnt, lists);
    k_gemm_moe<1><<<G, B, 0, stream>>>(u2, D, w_gu, (size_t)D * 2 * DFF, 2 * DFF, act, DFF, b_gu, 2 * DFF, cnt, lists, 2, DFF, D);
    k_gemm_moe<0><<<G, B, 0, stream>>>(act, DFF, w_dn, (size_t)DFF * D, D, y, D, b_dn, D, cnt, lists, 0, D, DFF);
    k_final<<<G, B, 0, stream>>>(y, prob, mod, g_post_ffn, out);
}
```

```cpp
#include <hip/hip_runtime.h>
#include <hip/hip_bf16.h>
#include <cstdio>
#include <cstdint>
#include <cmath>
#define GAS __attribute__((address_space(1)))
#define LAS __attribute__((address_space(3)))
typedef unsigned short bf16;
typedef unsigned v4u __attribute__((ext_vector_type(4)));
typedef float f32x4 __attribute__((ext_vector_type(4)));
typedef short bf16x8 __attribute__((ext_vector_type(8)));
typedef GAS unsigned gu32;
typedef GAS unsigned long long gu64;
#define RLX_AGENT __ATOMIC_RELAXED, __HIP_MEMORY_SCOPE_AGENT
#define LDS_WAIT() asm volatile("s_waitcnt lgkmcnt(0)" ::: "memory")
#define VM_WAIT() asm volatile("s_waitcnt vmcnt(0)" ::: "memory")
__device__ __forceinline__ unsigned long long rt() { return __builtin_amdgcn_s_memrealtime(); }
__device__ __forceinline__ unsigned f2bf(float f) { unsigned u = __builtin_bit_cast(unsigned, f); return (u + 0x7fffu + ((u >> 16) & 1u)) >> 16; }
__device__ __forceinline__ unsigned pk2(float lo, float hi) { return f2bf(lo) | (f2bf(hi) << 16); }

#define XB_TMO      128
#define XB_XCNT(j)  (256  + 64 * (j))
#define XB_XSUB(j)  (1280 + 64 * (j))
#define XB_XGEN(j)  (2304 + 64 * (j))
#define XB_TOP      3328
#define XB_TOPGEN   3392
#define XCD_BAR_WORDS 3456
#define XB_SPIN_CAP (1u << 18)

__device__ __forceinline__ unsigned xb_ld(unsigned* p)              { return __hip_atomic_load(p, __ATOMIC_RELAXED, __HIP_MEMORY_SCOPE_AGENT); }
__device__ __forceinline__ unsigned xb_add(unsigned* p, unsigned v) { return __hip_atomic_fetch_add(p, v, __ATOMIC_RELAXED, __HIP_MEMORY_SCOPE_AGENT); }
__device__ __forceinline__ unsigned xb_xcc_id() { return (unsigned)__builtin_amdgcn_s_getreg((3 << 11) | 20) & 0xFu; }
#define XB_SPIN(cond, bar) do { unsigned _sp = 0; while (cond) { __builtin_amdgcn_s_sleep(1); \
    if ((++_sp & 255u) == 0u) { if (xb_ld(&(bar)[XB_TMO])) break; if (_sp > XB_SPIN_CAP) { atomicAdd(&(bar)[XB_TMO], 1u); break; } } } } while (0)

struct XcdBarrier {
    unsigned* bar; unsigned x;
    volatile LAS unsigned* st;
};

__device__ __forceinline__ XcdBarrier xcd_barrier_post(unsigned* bar, volatile LAS unsigned* st) {
    XcdBarrier b; b.bar = bar; b.x = xb_xcc_id(); b.st = st;
    if (threadIdx.x == 0) (void)xb_add(&bar[XB_XCNT(b.x)], 1u);
    return b;
}
__device__ __forceinline__ void xcd_barrier_complete(unsigned* bar, unsigned x, unsigned& nloc, unsigned& nx) {
    const unsigned G = gridDim.x * gridDim.y * gridDim.z;
    unsigned sum, cnt, mine, sp = 0u;
    for (;;) {
        sum = 0u; cnt = 0u; mine = 0u;
#pragma unroll
        for (unsigned j = 0; j < 16; ++j) { const unsigned c = xb_ld(&bar[XB_XCNT(j)]); sum += c; cnt += (c > 0u) ? 1u : 0u; mine = (j == x) ? c : mine; }
        if (sum == G) break;
        __builtin_amdgcn_s_sleep(1);
        if ((++sp & 255u) == 0u) { if (xb_ld(&bar[XB_TMO])) break; if (sp > XB_SPIN_CAP) { atomicAdd(&bar[XB_TMO], 1u); break; } }
    }
    nloc = mine > 0u ? mine : 1u; nx = cnt > 0u ? cnt : 1u;
}

__device__ __forceinline__ void xcd_barrier(const XcdBarrier& b) {
    asm volatile("s_waitcnt vmcnt(0)" ::: "memory");
    __syncthreads();
    if (threadIdx.x == 0) {
        unsigned* bar = b.bar;
        __builtin_amdgcn_s_waitcnt(0);
        unsigned nloc = b.st[0], nx = b.st[1];
        if (nloc == 0u) { xcd_barrier_complete(bar, b.x, nloc, nx); b.st[0] = nloc; b.st[1] = nx; }
        const unsigned old = xb_add(&bar[XB_XSUB(b.x)], 1u);
        const unsigned gen = old / nloc;
        if (old + 1u == (gen + 1u) * nloc) {
            __builtin_amdgcn_fence(__ATOMIC_RELEASE, "agent");
            asm volatile("s_waitcnt vmcnt(0)" ::: "memory");
            const unsigned og = xb_add(&bar[XB_TOP], 1u);
            const unsigned tg = og / nx;
            if (og + 1u == (tg + 1u) * nx) xb_add(&bar[XB_TOPGEN], 1u);
            else XB_SPIN(xb_ld(&bar[XB_TOPGEN]) == tg, bar);
            __builtin_amdgcn_fence(__ATOMIC_ACQUIRE, "agent");
            xb_add(&bar[XB_XGEN(b.x)], 1u);
            asm volatile("s_waitcnt vmcnt(0)" ::: "memory");
        } else {
            XB_SPIN(xb_ld(&bar[XB_XGEN(b.x)]) == gen, bar);
            __builtin_amdgcn_fence(__ATOMIC_ACQUIRE, "agent");
            asm volatile("s_waitcnt vmcnt(0)" ::: "memory");
        }
    }
    __syncthreads();
}


namespace pg8 {
#define PG8_LAS __attribute__((address_space(3)))
typedef unsigned short bf16_t;
typedef short bf16x8 __attribute__((ext_vector_type(8)));
typedef float f32x4 __attribute__((ext_vector_type(4)));
typedef unsigned u32x4 __attribute__((ext_vector_type(4)));
typedef unsigned u32x2 __attribute__((ext_vector_type(2)));
constexpr int BM = 256, BK = 64, HALF = 128, HTB = HALF * BK * 2  , STAGE_BYTES = 8 * HTB, NXCD = 8, WGM = 8;

__host__ __device__ __forceinline__ int lds_byte(int r, int c) { const int st = (r >> 4) * 2 + (c >> 5), rr = r & 15, cc = c & 31, ob = rr * 64 + cc * 2; return st * 1024 + (ob ^ (((ob >> 9) & 1) << 5)); }
__host__ __device__ __forceinline__ void stage_rc(int b, int& R, int& C) { const int st = b / 1024, sb = b % 1024, swz = sb ^ (((sb >> 9) & 1) << 5); R = (st >> 1) * 16 + swz / 64; C = (st & 1) * 32 + (swz % 64) / 2; }
__host__ __device__ __forceinline__ int perm32(int rho) { const int n = rho >> 4, i = rho & 15; return 8 * (i >> 2) + 4 * n + (i & 3); }

struct Unit { int pm, pn, e, ui; };
struct Gemm { const bf16_t* A; int K; };

struct StaticOrder {
    int nM, nN, nwg, G, c, lda; const bf16_t* Bt; int K;
    __device__ void init(int M, int N, int K_, int lda_, const bf16_t* Bt_, int G_, int c_) { nM = M / BM; nN = N / BM; nwg = nM * nN; G = G_; c = c_; lda = lda_; Bt = Bt_; K = K_; }
    __device__ bool next(int i, Unit& u) const {
        const long L = (long)i * G + c; if (L >= nwg) return false;
        int wgid = (int)L; { const int q = nwg / NXCD, r = nwg % NXCD, xcd = wgid % NXCD, off = wgid / NXCD; wgid = (xcd < r ? xcd * (q + 1) : r * (q + 1) + (xcd - r) * q) + off; }
        const int nig = WGM * nN, gid = wgid / nig, fm = gid * WGM;
        u.pm = fm + ((wgid % nig) % WGM); u.pn = (wgid % nig) / WGM; u.e = 0; u.ui = i; return true;
    }
    __device__ __forceinline__ unsigned a_off(const Unit& u, int r, int C) const { return (unsigned)(((size_t)(u.pm * BM + r) * lda + C) * 2u); }
    __device__ __forceinline__ const char* b_base(const Unit& u) const { return (const char*)Bt + (size_t)u.pn * BM * K * 2; }
    __device__ __forceinline__ void a_ready(const Unit&) const {}
    __device__ __forceinline__ void done(const Unit&) const {}
};

typedef int v8i_t __attribute__((ext_vector_type(8))); typedef int v4i_t __attribute__((ext_vector_type(4)));
__device__ __forceinline__ v8i_t cat8(bf16x8 a, bf16x8 b) { const v4i_t x = __builtin_bit_cast(v4i_t, a), y = __builtin_bit_cast(v4i_t, b); return __builtin_shufflevector(x, y, 0, 1, 2, 3, 4, 5, 6, 7); }
__device__ __forceinline__ unsigned cvt_pk_bf16(float lo, float hi) { unsigned r; asm volatile("v_cvt_pk_bf16_f32 %0, %1, %2" : "=v"(r) : "v"(lo), "v"(hi)); return r; }

template <class Epi, class Sched, bool ALIGN_EPI = true, bool FP8 = false>
__device__ __forceinline__ void gemm_phase(PG8_LAS unsigned char* lds, const Gemm g, const Sched& S, const Epi& E, const int tid) {
    const int wid = __builtin_amdgcn_readfirstlane(tid >> 6), lane = tid & 63, wr = wid >> 2, wc = wid & 3, fr = lane & 15, fq = lane >> 4;
    const int K = g.K, nt = K / BK;
    unsigned voffB[2];
#pragma unroll
    for (int i = 0; i < 2; ++i) { int R, C; stage_rc(tid * 16 + i * 8192, R, C); const int Rb = Epi::PERM ? ((R & ~31) + perm32(R & 31)) : R; voffB[i] = (unsigned)(Rb * K + C) * 2u; }
#define PG8_AOFF(dst, unit) do { _Pragma("unroll") for (int _i = 0; _i < 2; ++_i) { int _R, _C; stage_rc(tid * 16 + _i * 8192, _R, _C); dst[0][_i] = S.a_off(unit, _R, _C); dst[1][_i] = S.a_off(unit, HALF + _R, _C); } } while (0)
    const size_t kstep = (size_t)(BK * 2);
    const size_t hstepB = (size_t)HALF * K * 2;
    const unsigned ldsw = (unsigned)wid * 1024u;
    const int aoff = lds_byte(wr * 64 + fr, fq * 8), boff = lds_byte(wc * 32 + fr, fq * 8);
#define PG8_SA(b, h) (((b) * 2 + (h)) * HTB)
#define PG8_SB(b, h) ((4 + (b) * 2 + (h)) * HTB)
#define PG8_STAGE(bufoff, gbase, voff) do { _Pragma("unroll") for (int _i = 0; _i < 2; ++_i) { unsigned _o = (voff)[_i]; asm volatile("" : "+v"(_o));     \
        __builtin_amdgcn_global_load_lds((const unsigned*)((const char*)(gbase) + _o), (PG8_LAS unsigned*)(lds + (bufoff) + ldsw + _i * 8192), 16, 0, 0); } } while (0)
#define PG8_LDA(dst, b, h) do { _Pragma("unroll") for (int m = 0; m < 4; ++m) { const v4i_t _lo = *(const PG8_LAS v4i_t*)(lds + PG8_SA(b, h) + aoff + m * 2048), _hi = *(const PG8_LAS v4i_t*)(lds + PG8_SA(b, h) + aoff + m * 2048 + 1024); \
        dst[m] = __builtin_shufflevector(_lo, _hi, 0, 1, 2, 3, 4, 5, 6, 7); } } while (0)
#define PG8_LDB(dst, b, h) do { _Pragma("unroll") for (int n = 0; n < 2; ++n) { const v4i_t _lo = *(const PG8_LAS v4i_t*)(lds + PG8_SB(b, h) + boff + n * 2048), _hi = *(const PG8_LAS v4i_t*)(lds + PG8_SB(b, h) + boff + n * 2048 + 1024); \
        dst[n] = __builtin_shufflevector(_lo, _hi, 0, 1, 2, 3, 4, 5, 6, 7); } } while (0)
#define PG8_LO(v) __builtin_bit_cast(bf16x8, __builtin_shufflevector(v, v, 0, 1, 2, 3))
#define PG8_HI(v) __builtin_bit_cast(bf16x8, __builtin_shufflevector(v, v, 4, 5, 6, 7))
#define PG8_MMA(ai, bj, At, Bt) do { __builtin_amdgcn_s_setprio(1); \
        if constexpr (FP8) { _Pragma("unroll") for (int m = 0; m < 4; ++m) _Pragma("unroll") for (int n = 0; n < 2; ++n) \
            asm volatile("v_mfma_scale_f32_16x16x128_f8f6f4 %0, %1, %2, %0, %3, %3 op_sel_hi:[0,0,0]" : "+v"(acc[ai][bj][m][n]) : "v"(Bt[n]), "v"(At[m]), "v"(sc1)); } \
        else { _Pragma("unroll") for (int m = 0; m < 4; ++m) _Pragma("unroll") for (int n = 0; n < 2; ++n) { \
            acc[ai][bj][m][n] = __builtin_amdgcn_mfma_f32_16x16x32_bf16(PG8_LO(Bt[n]), PG8_LO(At[m]), acc[ai][bj][m][n], 0, 0, 0); \
            acc[ai][bj][m][n] = __builtin_amdgcn_mfma_f32_16x16x32_bf16(PG8_HI(Bt[n]), PG8_HI(At[m]), acc[ai][bj][m][n], 0, 0, 0); } } \
        __builtin_amdgcn_s_setprio(0); } while (0)
#define PG8_WAIT_V(n) asm volatile("s_waitcnt vmcnt(" #n ")" ::: "memory")
#define PG8_WAIT_L(n) asm volatile("s_waitcnt lgkmcnt(" #n ")" ::: "memory")
#define PG8_BAR __builtin_amdgcn_s_barrier()
#define PG8_SCHED __builtin_amdgcn_sched_barrier(0)
    Unit cur, nxt; int ui = 0;
    if (!S.next(0, cur)) return;
    f32x4 acc[2][2][4][2];
    int sc1 = 0x7F7F7F7F; asm volatile("" : "+v"(sc1));
    v8i_t At[4], B0[2], B1[2];
    const char* const Ab = (const char*)g.A;
    unsigned aoc[2][2];
    PG8_AOFF(aoc, cur);
    const char* cB = S.b_base(cur);
    S.a_ready(cur);
    PG8_STAGE(PG8_SB(0, 0), cB, voffB); PG8_STAGE(PG8_SB(0, 1), cB + hstepB, voffB); PG8_STAGE(PG8_SA(0, 0), Ab, aoc[0]); PG8_STAGE(PG8_SA(0, 1), Ab, aoc[1]);
    if (wr == 1) PG8_BAR;
    PG8_WAIT_V(2); PG8_BAR;
    PG8_STAGE(PG8_SB(1, 0), cB + kstep, voffB); PG8_STAGE(PG8_SA(1, 0), Ab + kstep, aoc[0]); PG8_STAGE(PG8_SB(1, 1), cB + hstepB + kstep, voffB);
    PG8_WAIT_V(6); PG8_BAR;
#pragma unroll
    for (int a = 0; a < 2; ++a)
#pragma unroll
        for (int b = 0; b < 2; ++b)
#pragma unroll
            for (int m = 0; m < 4; ++m)
#pragma unroll
                for (int n = 0; n < 2; ++n) acc[a][b][m][n] = (f32x4){0.f, 0.f, 0.f, 0.f};
    for (;;) {
        const bool has_next = S.next(ui + 1, nxt);
        const char* nB = has_next ? S.b_base(nxt) : cB;
        int t = 0;
#pragma unroll 1
        for (int seg = 0; seg < (Epi::MID_T >= 0 ? 2 : 1); ++seg) {
        const int tend = (Epi::MID_T >= 0 && seg == 0) ? Epi::MID_T : nt;
#pragma unroll 1
        for (; t < tend; t += 2) {
            const bool last = (t == nt - 2);
            const char* a1 = Ab + (size_t)(t + 1) * kstep;
            const char* a2 = last ? Ab : Ab + (size_t)(t + 2) * kstep; const char* b2 = last ? nB : cB + (size_t)(t + 2) * kstep;
            const char* a3 = a2 + kstep; const char* b3 = b2 + kstep;
            unsigned o2[2][2];
#pragma unroll
            for (int h = 0; h < 2; ++h)
#pragma unroll
                for (int i = 0; i < 2; ++i) o2[h][i] = aoc[h][i];
            if (last && has_next) PG8_AOFF(o2, nxt);
            if (last && has_next) S.a_ready(nxt);
            PG8_LDB(B0, 0, 0); PG8_LDB(B1, 0, 1); PG8_SCHED; PG8_LDA(At, 0, 0); PG8_STAGE(PG8_SA(1, 1), a1, aoc[1]);
            PG8_WAIT_V(8); PG8_WAIT_L(0); PG8_BAR; PG8_MMA(0, 0, At, B0); PG8_MMA(0, 1, At, B1); PG8_BAR; PG8_SCHED;
            PG8_LDA(At, 0, 1); PG8_STAGE(PG8_SB(0, 0), b2, voffB); PG8_STAGE(PG8_SB(0, 1), b2 + hstepB, voffB); PG8_STAGE(PG8_SA(0, 0), a2, o2[0]);
            PG8_WAIT_V(8); PG8_WAIT_L(0); PG8_BAR; PG8_MMA(1, 0, At, B0); PG8_MMA(1, 1, At, B1); PG8_BAR; PG8_SCHED;
            PG8_LDB(B0, 1, 0); PG8_LDB(B1, 1, 1); PG8_SCHED; PG8_LDA(At, 1, 0); PG8_STAGE(PG8_SA(0, 1), a2, o2[1]);
            PG8_WAIT_V(8); PG8_WAIT_L(0); PG8_BAR; PG8_MMA(0, 0, At, B0); PG8_MMA(0, 1, At, B1); PG8_BAR; PG8_SCHED;
            PG8_LDA(At, 1, 1); PG8_STAGE(PG8_SB(1, 0), b3, voffB); PG8_STAGE(PG8_SB(1, 1), b3 + hstepB, voffB); PG8_STAGE(PG8_SA(1, 0), a3, o2[0]);
            PG8_WAIT_V(8); PG8_WAIT_L(0); PG8_BAR; PG8_MMA(1, 0, At, B0); PG8_MMA(1, 1, At, B1); PG8_BAR; PG8_SCHED;
        }
        if (Epi::MID_T >= 0) { if (seg == 0) E.mid(acc, cur, wr, wc, fr, fq); }
        }
        if constexpr (FP8) asm volatile("s_nop 15\n\ts_nop 7" ::: "memory");
        if constexpr (ALIGN_EPI) { if (wr == 0) PG8_BAR; }
        cur.pm = __builtin_amdgcn_readfirstlane(cur.pm); cur.pn = __builtin_amdgcn_readfirstlane(cur.pn); cur.e = __builtin_amdgcn_readfirstlane(cur.e); cur.ui = __builtin_amdgcn_readfirstlane(cur.ui);
        asm volatile("" : "+s"(cur.pm), "+s"(cur.pn), "+s"(cur.e), "+s"(cur.ui));
        { int t_ = tid; asm volatile("" : "+v"(t_)); const int fr_ = t_ & 15, fq_ = (t_ & 63) >> 4;
          E(acc, cur, wr, wc, fr_, fq_); } S.done(cur);
        if (!has_next) break;
#pragma unroll
        for (int a = 0; a < 2; ++a)
#pragma unroll
            for (int b = 0; b < 2; ++b)
#pragma unroll
                for (int m = 0; m < 4; ++m)
#pragma unroll
                    for (int n = 0; n < 2; ++n) acc[a][b][m][n] = (f32x4){0.f, 0.f, 0.f, 0.f};
        cur = nxt; cB = nB; ++ui;
        PG8_AOFF(aoc, cur);
        if constexpr (ALIGN_EPI) { if (wr == 1) PG8_BAR; }
    }
    PG8_WAIT_V(0);
    if constexpr (!ALIGN_EPI) { if (wr == 0) PG8_BAR; }
    PG8_BAR;
#undef PG8_AOFF
#undef PG8_SA
#undef PG8_SB
#undef PG8_STAGE
#undef PG8_LDA
#undef PG8_LDB
#undef PG8_MMA
#undef PG8_LO
#undef PG8_HI
#undef PG8_WAIT_V
#undef PG8_WAIT_L
#undef PG8_BAR
#undef PG8_SCHED
}
}

namespace mk {
constexpr int T = 16384, D = 1024, SEQ = 2048, NB = 8, INW = 5632, NE = 32, DFF = 1024, NMOD = 6144;
constexpr int NW = 8, NTHR = 512;
constexpr float EPS = 1e-6f;
constexpr float W8_SCALE = 64.f, A8_SCALE = 8.f, MOE_DESCALE = 1.f / 512.f;
constexpr float C2 = 0.18033688011112042f;
constexpr int LDS_BYTES = 155648;
constexpr int RING_OFF = 0, TAB_OFF = 131072, MISC_OFF = 155648 - 256;

struct Params {
    const GAS float *x, *c; const GAS int* pos;
    const GAS float *w_mod, *b_mod, *g_pre_mix, *w_in, *lq1, *lk1, *lq2, *lk2, *g_sub, *w_pg, *pool_scale, *w_att, *w_pb, *w_out, *g_post_mix, *g_pre_ffn, *w_router, *b_router, *w_gu, *b_gu, *w_dn, *b_dn, *g_post_ffn;
    GAS float* out;
    GAS unsigned* ctl; GAS float* modp; GAS float* rope;
    GAS bf16 *Wt_in, *Wt_mix, *Wt_out, *Wt_pg, *Wt_gu, *Wt_dn;
    GAS bf16 *U, *QKV, *PB, *GR, *SGP, *AM, *MERGED, *MIXOUT, *ACT, *Y;
    GAS float* prob; GAS int* lists;
    int ph_lo, ph_hi, li, flags;
};
#define P_x ((const float*)p.x)
#define P_c ((const float*)p.c)
#define P_w_mod ((const float*)p.w_mod)
#define P_b_mod ((const float*)p.b_mod)
#define P_g_pre_mix ((const float*)p.g_pre_mix)
#define P_w_in ((const float*)p.w_in)
#define P_lq1 ((const float*)p.lq1)
#define P_lk1 ((const float*)p.lk1)
#define P_lq2 ((const float*)p.lq2)
#define P_lk2 ((const float*)p.lk2)
#define P_g_sub ((const float*)p.g_sub)
#define P_w_pg ((const float*)p.w_pg)
#define P_pool_scale ((const float*)p.pool_scale)
#define P_w_att ((const float*)p.w_att)
#define P_w_pb ((const float*)p.w_pb)
#define P_w_out ((const float*)p.w_out)
#define P_g_post_mix ((const float*)p.g_post_mix)
#define P_g_pre_ffn ((const float*)p.g_pre_ffn)
#define P_w_router ((const float*)p.w_router)
#define P_b_router ((const float*)p.b_router)
#define P_w_gu ((const float*)p.w_gu)
#define P_b_gu ((const float*)p.b_gu)
#define P_w_dn ((const float*)p.w_dn)
#define P_b_dn ((const float*)p.b_dn)
#define P_g_post_ffn ((const float*)p.g_post_ffn)
#define P_pos ((const int*)p.pos)
#define P_out ((float*)p.out)
#define P_ctl ((unsigned*)p.ctl)
#define P_modp ((float*)p.modp)
#define P_rope ((float*)p.rope)
#define P_prob ((float*)p.prob)
#define P_lists ((int*)p.lists)
#define P_Wt_in ((bf16*)p.Wt_in)
#define P_Wt_mix ((bf16*)p.Wt_mix)
#define P_Wt_out ((bf16*)p.Wt_out)
#define P_Wt_pg ((bf16*)p.Wt_pg)
#define P_Wt_gu ((bf16*)p.Wt_gu)
#define P_Wt_dn ((bf16*)p.Wt_dn)
#define P_U ((bf16*)p.U)
#define P_QKV ((bf16*)p.QKV)
#define P_PB ((bf16*)p.PB)
#define P_GR ((bf16*)p.GR)
#define P_SGP ((bf16*)p.SGP)
#define P_AM ((bf16*)p.AM)
#define P_MERGED ((bf16*)p.MERGED)
#define P_MIXOUT ((bf16*)p.MIXOUT)
#define P_ACT ((bf16*)p.ACT)
#define P_Y ((bf16*)p.Y)
constexpr int CW_TMO = 0, CW_CNT = 64  , CW_BAR = 4096  ;

__device__ __forceinline__ float wave_sum(float v) {
#pragma unroll
    for (int o = 1; o < 64; o <<= 1) v += __shfl_xor(v, o);
    return v;
}
__device__ __forceinline__ void tr_item(const float* W, int ldw, int k0, int n0, bf16* WT, int ldt, int drow0, int kcol0, LAS float* scr, int lane) {
#pragma unroll 8
    for (int i = 0; i < 32; ++i) { const int kk = 2 * i + (lane >> 5); scr[kk * 33 + (lane & 31)] = __builtin_nontemporal_load(&W[(size_t)(k0 + kk) * ldw + n0 + (lane & 31)]); }
    LDS_WAIT(); asm volatile("" ::: "memory");
    const int c = lane & 7;
#pragma unroll
    for (int j = 0; j < 4; ++j) { const int n = (lane >> 3) + 8 * j; const LAS float* s = scr + (8 * c) * 33 + n;
        v4u o; o.x = pk2(s[0 * 33], s[1 * 33]); o.y = pk2(s[2 * 33], s[3 * 33]); o.z = pk2(s[4 * 33], s[5 * 33]); o.w = pk2(s[6 * 33], s[7 * 33]);
        *(GAS v4u*)(WT + (size_t)(drow0 + n) * ldt + kcol0 + k0 + 8 * c) = o; }
    LDS_WAIT(); asm volatile("" ::: "memory");
}
__device__ __forceinline__ unsigned pk4_fp8(float a, float b, float c, float d) {
    a = fminf(fmaxf(a, -448.f), 448.f); b = fminf(fmaxf(b, -448.f), 448.f); c = fminf(fmaxf(c, -448.f), 448.f); d = fminf(fmaxf(d, -448.f), 448.f);
    int w = __builtin_amdgcn_cvt_pk_fp8_f32(a, b, 0, false); w = __builtin_amdgcn_cvt_pk_fp8_f32(c, d, w, true); return (unsigned)w; }
__device__ __forceinline__ void tr_item8(const float* W, int ldw, int k0, int n0, unsigned char* WT, int ldt, int drow0, LAS float* scr, int lane, float scale) {
#pragma unroll 8
    for (int i = 0; i < 64; ++i) { const int kk = 2 * i + (lane >> 5); scr[kk * 33 + (lane & 31)] = __builtin_nontemporal_load(&W[(size_t)(k0 + kk) * ldw + n0 + (lane & 31)]); }
    LDS_WAIT(); asm volatile("" ::: "memory");
    const int c = lane & 7;
#pragma unroll
    for (int j = 0; j < 4; ++j) { const int n = (lane >> 3) + 8 * j; const LAS float* s = scr + (16 * c) * 33 + n;
        v4u o; o.x = pk4_fp8(s[0 * 33] * scale, s[1 * 33] * scale, s[2 * 33] * scale, s[3 * 33] * scale); o.y = pk4_fp8(s[4 * 33] * scale, s[5 * 33] * scale, s[6 * 33] * scale, s[7 * 33] * scale);
        o.z = pk4_fp8(s[8 * 33] * scale, s[9 * 33] * scale, s[10 * 33] * scale, s[11 * 33] * scale); o.w = pk4_fp8(s[12 * 33] * scale, s[13 * 33] * scale, s[14 * 33] * scale, s[15 * 33] * scale);
        *(GAS v4u*)(WT + (size_t)(drow0 + n) * ldt + k0 + 16 * c) = o; }
    LDS_WAIT(); asm volatile("" ::: "memory");
}
__device__ __forceinline__ int ilv_row(int n, int H) { const int w = n >= H ? 1 : 0, c = n - w * H; return 256 * (c >> 7) + 128 * w + (c & 127); }

__device__ __forceinline__ void p0_prologue(const Params& p, LAS unsigned char* lds, int tid, int wave, int lane, int vcu, int G) {
    LAS float* sc = (LAS float*)lds;
    for (int i = tid; i < NB * D; i += NTHR) { const float cv = P_c[i]; sc[i] = cv / (1.f + expf(-cv)); }
    __syncthreads();
    const int gw = vcu * NW + wave, NGW = G * NW;
    for (int task = (wave < 3 ? vcu * 3 + wave : 96 * 8); task < 96 * 8; task += G * 3) {
        const int cg = task >> 3, ks = task & 7, col = cg * 64 + lane;
        float acc[NB];
#pragma unroll
        for (int b = 0; b < NB; ++b) acc[b] = 0.f;
#pragma unroll 4
        for (int k = ks * 128; k < ks * 128 + 128; ++k) { const float wv = __builtin_nontemporal_load(&P_w_mod[(size_t)k * NMOD + col]);
#pragma unroll
            for (int b = 0; b < NB; ++b) acc[b] += sc[b * D + k] * wv; }
#pragma unroll
        for (int b = 0; b < NB; ++b) P_modp[(size_t)(ks * NB + b) * NMOD + col] = acc[b];
    }
    __syncthreads();
    LAS float* scr = (LAS float*)(lds + wave * 17408);
    constexpr int I1 = 16 * 176, I2 = 16 * 32, I3 = 8 * 32, I4 = 16 * 32, I5 = 32, I6E = 8 * 64, I7E = 8 * 32;
    const int nitems = (p.flags & 1) ? (I1 + I2 + I3 + I4 + I5) : (I1 + I2 + I3 + I4 + I5 + NE * I6E + NE * I7E);
    for (int it = gw; it < nitems; it += NGW) {
        int r = it;
        if (r < I1) { const int kb = r / 176, nb = r % 176, n0 = nb * 32; const int dr = n0 < 3584 ? n0 : 3584 + ilv_row(n0 - 3584, 1024);
            tr_item(P_w_in, INW, kb * 64, n0, P_Wt_in, D, dr, 0, scr, lane); continue; } r -= I1;
        if (r < I2) { const int kb = r / 32, nb = r % 32; tr_item(P_w_att, D, kb * 64, nb * 32, P_Wt_mix, 1536, nb * 32, 0, scr, lane); continue; } r -= I2;
        if (r < I3) { const int kb = r / 32, nb = r % 32; tr_item(P_w_pb, D, kb * 64, nb * 32, P_Wt_mix, 1536, nb * 32, 1024, scr, lane); continue; } r -= I3;
        if (r < I4) { const int kb = r / 32, nb = r % 32; tr_item(P_w_out, D, kb * 64, nb * 32, P_Wt_out, D, nb * 32, 0, scr, lane); continue; } r -= I4;
        if (r < I5) { const int g = r >> 3, q = r & 7, kb = q >> 2, nb = q & 3; tr_item(P_w_pg + (size_t)g * 128 * 128, 128, kb * 64, nb * 32, P_Wt_pg + (size_t)g * 128 * 128, 128, nb * 32, 0, scr, lane); continue; } r -= I5;
        if (r < NE * I6E) { const int e = r / I6E, q = r % I6E, kb = q / 64, nb = q % 64, n0 = nb * 32;
            tr_item8(P_w_gu + (size_t)e * D * 2 * DFF, 2 * DFF, kb * 128, n0, (unsigned char*)P_Wt_gu + (size_t)e * 2 * DFF * D, D, ilv_row(n0, DFF), scr, lane, W8_SCALE); continue; } r -= NE * I6E;
        { const int e = r / I7E, q = r % I7E, kb = q / 32, nb = q % 32; tr_item8(P_w_dn + (size_t)e * DFF * D, D, kb * 128, nb * 32, (unsigned char*)P_Wt_dn + (size_t)e * D * DFF, DFF, nb * 32, scr, lane, W8_SCALE); }
    }
}
__device__ __forceinline__ double rope_invf(int i) {
    return i == 0 ? 1.0 : i == 1 ? 0.19392274474868576 : i == 2 ? 0.03760603093086393 : i == 3 ? 0.007292664737217109 : i == 4 ? 0.001414213562373095 : i == 5 ? 0.0002742481756762073 : i == 6 ? 5.318295896944988e-05 : 1.031338537721246e-05;
}
__device__ __forceinline__ f32x4 mod4(const Params& p, int b, int off, int k) {
    const float* base = P_modp + (size_t)b * NMOD + off + k;
    f32x4 t[9]; t[8] = *(const f32x4*)(P_b_mod + off + k);
#pragma unroll
    for (int ks = 0; ks < 8; ++ks) t[ks] = *(const f32x4*)(base + (size_t)ks * NB * NMOD);
    asm volatile("" : "+v"(t[0]), "+v"(t[1]), "+v"(t[2]), "+v"(t[3]), "+v"(t[4]), "+v"(t[5]), "+v"(t[6]), "+v"(t[7]), "+v"(t[8]));
    return t[8] + (((t[0] + t[1]) + (t[2] + t[3])) + ((t[4] + t[5]) + (t[6] + t[7])));
}
constexpr int MODF_OFF = 8 * NB * NMOD;
__device__ __forceinline__ void p1_rows(const Params& p, LAS unsigned char* lds, int tid, int wave, int lane, int vcu, int G) {
    LAS float* av = (LAS float*)lds; LAS float* sv = av + D;
    for (int grp = vcu; grp < T / 64; grp += G) {
        const int row0 = grp * 64 + wave * 8, b = row0 / SEQ;
        __syncthreads();
        { const int k = 4 * (tid & 255);
          if (tid < 256) *(LAS f32x4*)(av + k) = *(const f32x4*)(P_g_pre_mix + k) * (1.f + mod4(p, b, 1024, k)); else *(LAS f32x4*)(sv + k) = mod4(p, b, 0, k);
          if ((grp & 31) == 0) {
#pragma unroll
              for (int q = 0; q < 2; ++q) { const int vi = (tid >> 8) * 2 + q; const int off = vi == 0 ? 2048 : vi == 1 ? 3072 : vi == 2 ? 4096 : 5120;
                  *(f32x4*)(P_modp + MODF_OFF + (size_t)(b * 4 + vi) * D + k) = mod4(p, b, off, k); } } }
        __syncthreads();
        f32x4 a[4], sh[4];
#pragma unroll
        for (int j = 0; j < 4; ++j) { const int k = 4 * lane + 256 * j; a[j] = *(const LAS f32x4*)(av + k); sh[j] = *(const LAS f32x4*)(sv + k); }
#pragma unroll 1
        for (int rb = 0; rb < 8; rb += 4) {
            f32x4 v[4][4]; float ss[4];
#pragma unroll
            for (int r = 0; r < 4; ++r) { const GAS f32x4* xr = (const GAS f32x4*)(P_x + (size_t)(row0 + rb + r) * D) + lane;
#pragma unroll
                for (int j = 0; j < 4; ++j) v[r][j] = __builtin_nontemporal_load(xr + 64 * j); }
#pragma unroll
            for (int r = 0; r < 4; ++r) { float s = 0.f;
#pragma unroll
                for (int j = 0; j < 4; ++j) s += (v[r][j].x * v[r][j].x + v[r][j].y * v[r][j].y) + (v[r][j].z * v[r][j].z + v[r][j].w * v[r][j].w);
                ss[r] = s; }
#pragma unroll
            for (int o = 1; o < 64; o <<= 1) {
#pragma unroll
                for (int r = 0; r < 4; ++r) ss[r] += __shfl_xor(ss[r], o); }
#pragma unroll
            for (int r = 0; r < 4; ++r) { const int m = row0 + rb + r; const float rstd = 1.f / sqrtf(ss[r] * (1.f / D) + EPS);
                GAS unsigned long long* o8 = (GAS unsigned long long*)(P_U + (size_t)m * D) + lane;
#pragma unroll
                for (int j = 0; j < 4; ++j) { const f32x4 u = v[r][j] * rstd * a[j] + sh[j]; o8[64 * j] = (unsigned long long)pk2(u.x, u.y) | ((unsigned long long)pk2(u.z, u.w) << 32); } }
        }
        if (lane < 8) {
            const double invf = rope_invf(lane);
#pragma unroll 1
            for (int r = 0; r < 8; ++r) { const int m = row0 + r; const double ang = (double)P_pos[m] * invf; const double kk = __builtin_rint(ang * 0.15915494309189535);
                const float rr = (float)(ang - kk * 6.283185307179586); P_rope[(size_t)m * 16 + lane] = cosf(rr); P_rope[(size_t)m * 16 + 8 + lane] = sinf(rr); }
        }
    }
}
struct EpiZ {
    static constexpr bool PERM = true; static constexpr int MID_T = -1;
    bf16 *QKV, *PB, *GR, *SGP; const float* rope;
    __device__ __forceinline__ void mid(pg8::f32x4 (&)[2][2][4][2], const pg8::Unit&, int, int, int, int) const {}
    __device__ __forceinline__ void operator()(const pg8::f32x4 (&acc)[2][2][4][2], const pg8::Unit& u, int wr, int wc, int fr, int fq) const {
        const int row0 = u.pm * 256 + wr * 64 + fr, pn = u.pn, cw = wc * 32 + 8 * fq;
        if (pn < 14) {
            const bool rp = pn < 8 && (wc & 1) == 0; const float sc = pn < 4 ? C2 : 1.f;
            bf16* base = pn < 12 ? QKV : PB; const int ld = pn < 12 ? 3072 : 512; const int colt = (pn < 12 ? pn : pn - 12) * 256 + cw;
#pragma unroll
            for (int ai = 0; ai < 2; ++ai)
#pragma unroll
                for (int m = 0; m < 4; ++m) {
                    const int row = row0 + ai * 128 + m * 16;
                    f32x4 c0 = {1.f, 1.f, 1.f, 1.f}, c1 = c0, s0 = {0.f, 0.f, 0.f, 0.f}, s1 = s0;
                    if (rp) { const f32x4* rt = (const f32x4*)(rope + (size_t)row * 16); c0 = rt[0]; c1 = rt[1]; s0 = rt[2]; s1 = rt[3]; }
#pragma unroll
                    for (int bj = 0; bj < 2; ++bj) {
                        f32x4 v0 = acc[ai][bj][m][0], v1 = acc[ai][bj][m][1];
                        if (rp) {
                            f32x4 p0, p1;
#pragma unroll
                            for (int j = 0; j < 4; ++j) { p0[j] = __shfl_xor(v0[j], 16); p1[j] = __shfl_xor(v1[j], 16); }
                            if (fq == 0) { v0 = v0 * c0 - p0 * s0; v1 = v1 * c1 - p1 * s1; }
                            else if (fq == 1) { v0 = v0 * c0 + p0 * s0; v1 = v1 * c1 + p1 * s1; }
                        }
                        v0 = v0 * sc; v1 = v1 * sc;
                        pg8::u32x4 w; w.x = pg8::cvt_pk_bf16(v0[0], v0[1]); w.y = pg8::cvt_pk_bf16(v0[2], v0[3]); w.z = pg8::cvt_pk_bf16(v1[0], v1[1]); w.w = pg8::cvt_pk_bf16(v1[2], v1[3]);
                        *(pg8::u32x4*)(base + (size_t)row * ld + colt + bj * 128) = w;
                    }
                }
        } else {
            const int colt = (pn - 14) * 128 + cw;
#pragma unroll
            for (int ai = 0; ai < 2; ++ai)
#pragma unroll
                for (int m = 0; m < 4; ++m) {
                    const int row = row0 + ai * 128 + m * 16;
                    float r[8], g[8];
#pragma unroll
                    for (int n = 0; n < 2; ++n)
#pragma unroll
                        for (int j = 0; j < 4; ++j) { const float a = fminf(fmaxf(acc[ai][0][m][n][j], -30.f), 30.f), b = fminf(fmaxf(acc[ai][1][m][n][j], -30.f), 30.f);
                            const float ea = __builtin_amdgcn_exp2f(-1.4426950408889634f * a), eb = __builtin_amdgcn_exp2f(-1.4426950408889634f * b); r[n * 4 + j] = (1.f + eb) * __builtin_amdgcn_rcpf(1.f + ea); g[n * 4 + j] = __builtin_amdgcn_rcpf(1.f + eb); }
                    pg8::u32x4 w; w.x = pg8::cvt_pk_bf16(r[0], r[1]); w.y = pg8::cvt_pk_bf16(r[2], r[3]); w.z = pg8::cvt_pk_bf16(r[4], r[5]); w.w = pg8::cvt_pk_bf16(r[6], r[7]);
                    *(pg8::u32x4*)(GR + (size_t)row * D + colt) = w;
                    w.x = pg8::cvt_pk_bf16(g[0], g[1]); w.y = pg8::cvt_pk_bf16(g[2], g[3]); w.z = pg8::cvt_pk_bf16(g[4], g[5]); w.w = pg8::cvt_pk_bf16(g[6], g[7]);
                    *(pg8::u32x4*)(SGP + (size_t)row * D + colt) = w;
                }
        }
    }
};
}

namespace mk {
__device__ __forceinline__ float bf2f(unsigned short v) { return __uint_as_float((unsigned)v << 16); }
__device__ __forceinline__ float lam_value(const Params& p) {
    float d1 = 0.f, d2 = 0.f;
    for (int i = 0; i < 64; ++i) { d1 += P_lq1[i] * P_lk1[i]; d2 += P_lq2[i] * P_lk2[i]; }
    return expf(d1) - expf(d2) + 0.2f;
}
__device__ __forceinline__ void attn_interim(const Params& p, LAS unsigned char* lds, int tid, int vcu, int G) {
    const float lam = lam_value(p);
    const int sub = tid >> 8, t = tid & 255, r = t >> 2, j = t & 3;
    LAS float* Ks1 = (LAS float*)(lds + sub * 65536); LAS float* Ks2 = Ks1 + 4096; LAS float* Vs = Ks2 + 4096;
    for (int it = 0;; ++it) {
        const int pi = vcu + G * it; if (pi >= 1024) break;
        const int cc = pi & 31, c = (it & 1) ? 31 - cc : cc;
        const int bh = 2 * (pi >> 5) + sub, b = bh >> 3, h = bh & 7;
        const size_t m = (size_t)b * SEQ + c * 64 + r;
        float q1[16], q2[16];
#pragma unroll
        for (int i = 0; i < 16; ++i) { q1[i] = bf2f(P_QKV[m * 3072 + (2 * h) * 64 + j * 16 + i]); q2[i] = bf2f(P_QKV[m * 3072 + (2 * h + 1) * 64 + j * 16 + i]); }
        float m1 = -INFINITY, l1 = 0.f, m2 = -INFINITY, l2 = 0.f, a1[32], a2[32];
#pragma unroll
        for (int d = 0; d < 32; ++d) { a1[d] = 0.f; a2[d] = 0.f; }
        for (int kt = 0; kt <= c; ++kt) {
            __syncthreads();
            for (int e = t; e < 64 * 64; e += 256) { const int kr = e >> 6, kc = e & 63; const size_t km = (size_t)b * SEQ + kt * 64 + kr;
                Ks1[e] = bf2f(P_QKV[km * 3072 + 1024 + (2 * h) * 64 + kc]); Ks2[e] = bf2f(P_QKV[km * 3072 + 1024 + (2 * h + 1) * 64 + kc]); }
            for (int e = t; e < 64 * 128; e += 256) { const int kr = e >> 7, kc = e & 127; const size_t km = (size_t)b * SEQ + kt * 64 + kr; Vs[e] = bf2f(P_QKV[km * 3072 + 2048 + h * 128 + kc]); }
            __syncthreads();
            for (int kk = 0; kk < 64; ++kk) {
                float s1 = 0.f, s2 = 0.f;
#pragma unroll
                for (int i = 0; i < 16; ++i) { s1 += q1[i] * Ks1[kk * 64 + j * 16 + i]; s2 += q2[i] * Ks2[kk * 64 + j * 16 + i]; }
                s1 += __shfl_xor(s1, 1); s1 += __shfl_xor(s1, 2); s2 += __shfl_xor(s2, 1); s2 += __shfl_xor(s2, 2);
                { const float mn = fmaxf(m1, s1), al = exp2f(m1 - mn), pp = exp2f(s1 - mn); l1 = l1 * al + pp; m1 = mn;
#pragma unroll
                  for (int d = 0; d < 32; ++d) a1[d] = a1[d] * al + pp * Vs[kk * 128 + j * 32 + d]; }
                { const float mn = fmaxf(m2, s2), al = exp2f(m2 - mn), pp = exp2f(s2 - mn); l2 = l2 * al + pp; m2 = mn;
#pragma unroll
                  for (int d = 0; d < 32; ++d) a2[d] = a2[d] * al + pp * Vs[kk * 128 + j * 32 + d]; }
            }
        }
        float ss = 0.f; const float i1 = 1.f / l1, i2 = lam / l2;
#pragma unroll
        for (int d = 0; d < 32; ++d) { a1[d] = a1[d] * i1 - a2[d] * i2; ss += a1[d] * a1[d]; }
        ss += __shfl_xor(ss, 1); ss += __shfl_xor(ss, 2);
        const float rstd = (1.f / sqrtf(ss * (1.f / 128.f) + EPS)) * 0.8f;
#pragma unroll
        for (int d = 0; d < 32; d += 2) { const float o0 = a1[d] * rstd * P_g_sub[j * 32 + d], o1 = a1[d + 1] * rstd * P_g_sub[j * 32 + d + 1];
            *(unsigned*)(P_AM + m * 1536 + h * 128 + j * 32 + d) = pk2(o0, o1); }
    }
    __syncthreads();
}
__device__ __forceinline__ void pool_phase(const Params& p, LAS unsigned char* lds, int tid, int wave, int lane, int vcu, int G) {
    LAS float* Pf = (LAS float*)lds;
    LAS unsigned short* Mx = (LAS unsigned short*)(lds + 144 * 128 * 4);
    const int fr = lane & 15, fq = lane >> 4;
    for (int unit = vcu; unit < 512; unit += G) {
        const int rt = unit >> 2, g = unit & 3, w = 2 << g, row0 = rt * 128, s0 = row0 & (SEQ - 1);
        for (int ch = tid; ch < 144 * 16; ch += NTHR) { const int r = ch >> 4, c8 = (ch & 15) * 8, tt = s0 - 16 + r;
            v4u raw = {0u, 0u, 0u, 0u};
            if (tt >= 0) raw = *(const GAS v4u*)(P_PB + (size_t)(row0 - 16 + r) * 512 + g * 128 + c8);
            LAS float* d = Pf + r * 128 + c8;
            d[0] = __uint_as_float(raw.x << 16); d[1] = __uint_as_float(raw.x & 0xffff0000u); d[2] = __uint_as_float(raw.y << 16); d[3] = __uint_as_float(raw.y & 0xffff0000u);
            d[4] = __uint_as_float(raw.z << 16); d[5] = __uint_as_float(raw.z & 0xffff0000u); d[6] = __uint_as_float(raw.w << 16); d[7] = __uint_as_float(raw.w & 0xffff0000u); }
        __syncthreads();
        { const int c = tid & 127, rb = (tid >> 7) * 32;
          float ssum = 0.f;
          for (int q = 0; q < w; ++q) ssum += Pf[(rb + 16 - q) * 128 + c];
          for (int i = 0; i < 32; ++i) { const int r = rb + i, s = s0 + r; const int cnt = (s + 1) < w ? (s + 1) : w;
              const float pv = Pf[(r + 16) * 128 + c]; const float mx = ssum * __builtin_amdgcn_rcpf((float)cnt) - pv;
              Mx[r * 136 + c] = (unsigned short)f2bf(mx);
              if (i < 31) ssum += Pf[(r + 17) * 128 + c] - Pf[(r + 17 - w) * 128 + c]; } }
        __syncthreads();
        f32x4 acc[8];
#pragma unroll
        for (int nt = 0; nt < 8; ++nt) acc[nt] = (f32x4){0.f, 0.f, 0.f, 0.f};
        const bf16* Wg = P_Wt_pg + (size_t)g * 128 * 128;
#pragma unroll
        for (int ks = 0; ks < 4; ++ks) {
            const bf16x8 a = *(const LAS bf16x8*)(Mx + (16 * wave + fr) * 136 + 32 * ks + 8 * fq);
#pragma unroll
            for (int nt = 0; nt < 8; ++nt) { const bf16x8 bw = *(const GAS bf16x8*)(Wg + (size_t)(16 * nt + fr) * 128 + 32 * ks + 8 * fq);
                acc[nt] = __builtin_amdgcn_mfma_f32_16x16x32_bf16(bw, a, acc[nt], 0, 0, 0); }
        }
        bf16* orow = P_AM + (size_t)(row0 + 16 * wave + fr) * 1536 + 1024 + g * 128;
#pragma unroll
        for (int nt = 0; nt < 8; ++nt) { const int d = 16 * nt + 4 * fq; const f32x4 sc = *(const f32x4*)(P_pool_scale + g * 128 + d); const f32x4 v = acc[nt] * sc;
            *(GAS unsigned long long*)(orow + d) = (unsigned long long)pk2(v[0], v[1]) | ((unsigned long long)pk2(v[2], v[3]) << 32); }
        __syncthreads();
    }
}
struct EpiMerge {
    static constexpr bool PERM = true; static constexpr int MID_T = 16;
    const bf16 *GR, *SGP; bf16* O;
    __device__ __forceinline__ void scale(pg8::f32x4 (&acc)[2][2][4][2], const bf16* Sm, const pg8::Unit& u, int wr, int wc, int fr, int fq) const {
        const __amdgpu_buffer_rsrc_t rs = __builtin_amdgcn_make_buffer_rsrc((void*)Sm, 0, T * D * 2, 0x00020000);
        const int voff = ((u.pm * 256 + wr * 64 + fr) * D + u.pn * 256 + wc * 32 + 8 * fq) * 2;
#pragma unroll
        for (int ai = 0; ai < 2; ++ai)
#pragma unroll
            for (int m = 0; m < 4; ++m) {
#pragma unroll
                for (int bj = 0; bj < 2; ++bj) { const pg8::u32x4 w = __builtin_amdgcn_raw_buffer_load_b128(rs, voff, ((ai * 128 + m * 16) * D + bj * 128) * 2, 0);
                    acc[ai][bj][m][0][0] *= __uint_as_float(w.x << 16); acc[ai][bj][m][0][1] *= __uint_as_float(w.x & 0xffff0000u); acc[ai][bj][m][0][2] *= __uint_as_float(w.y << 16); acc[ai][bj][m][0][3] *= __uint_as_float(w.y & 0xffff0000u);
                    acc[ai][bj][m][1][0] *= __uint_as_float(w.z << 16); acc[ai][bj][m][1][1] *= __uint_as_float(w.z & 0xffff0000u); acc[ai][bj][m][1][2] *= __uint_as_float(w.w << 16); acc[ai][bj][m][1][3] *= __uint_as_float(w.w & 0xffff0000u); }
                asm volatile("" : "+v"(acc[ai][0][m][0]), "+v"(acc[ai][0][m][1]), "+v"(acc[ai][1][m][0]), "+v"(acc[ai][1][m][1])); asm volatile("" ::: "memory");
            }
    }
    __device__ __forceinline__ void mid(pg8::f32x4 (&acc)[2][2][4][2], const pg8::Unit& u, int wr, int wc, int fr, int fq) const { scale(acc, GR, u, wr, wc, fr, fq); }
    __device__ __forceinline__ void operator()(pg8::f32x4 (&acc)[2][2][4][2], const pg8::Unit& u, int wr, int wc, int fr, int fq) const {
        scale(acc, SGP, u, wr, wc, fr, fq);
        const int row0 = u.pm * 256 + wr * 64 + fr, col0 = u.pn * 256 + wc * 32 + 8 * fq;
#pragma unroll
        for (int ai = 0; ai < 2; ++ai)
#pragma unroll
            for (int m = 0; m < 4; ++m)
#pragma unroll
                for (int bj = 0; bj < 2; ++bj) { const pg8::f32x4 v0 = acc[ai][bj][m][0], v1 = acc[ai][bj][m][1];
                    pg8::u32x4 w; w.x = pg8::cvt_pk_bf16(v0[0], v0[1]); w.y = pg8::cvt_pk_bf16(v0[2], v0[3]); w.z = pg8::cvt_pk_bf16(v1[0], v1[1]); w.w = pg8::cvt_pk_bf16(v1[2], v1[3]);
                    *(pg8::u32x4*)(O + (size_t)(row0 + ai * 128 + m * 16) * D + col0 + bj * 128) = w; }
    }
};
struct EpiNull {
    static constexpr bool PERM = true; static constexpr int MID_T = -1;
    __device__ __forceinline__ void mid(pg8::f32x4 (&)[2][2][4][2], const pg8::Unit&, int, int, int, int) const {}
    __device__ __forceinline__ void operator()(pg8::f32x4 (&acc)[2][2][4][2], const pg8::Unit&, int, int, int, int) const {
#pragma unroll
        for (int ai = 0; ai < 2; ++ai)
#pragma unroll
            for (int bj = 0; bj < 2; ++bj)
#pragma unroll
                for (int m = 0; m < 4; ++m) asm volatile("" :: "v"(acc[ai][bj][m][0]), "v"(acc[ai][bj][m][1]));
    }
};
struct EpiStore {
    static constexpr bool PERM = true; static constexpr int MID_T = -1;
    bf16* O; int ldc;
    __device__ __forceinline__ void mid(pg8::f32x4 (&)[2][2][4][2], const pg8::Unit&, int, int, int, int) const {}
    __device__ __forceinline__ void operator()(pg8::f32x4 (&acc)[2][2][4][2], const pg8::Unit& u, int wr, int wc, int fr, int fq) const {
        const int row0 = u.pm * 256 + wr * 64 + fr, col0 = u.pn * 256 + wc * 32 + 8 * fq;
#pragma unroll
        for (int ai = 0; ai < 2; ++ai)
#pragma unroll
            for (int m = 0; m < 4; ++m)
#pragma unroll
                for (int bj = 0; bj < 2; ++bj) { const pg8::f32x4 v0 = acc[ai][bj][m][0], v1 = acc[ai][bj][m][1];
                    pg8::u32x4 w; w.x = pg8::cvt_pk_bf16(v0[0], v0[1]); w.y = pg8::cvt_pk_bf16(v0[2], v0[3]); w.z = pg8::cvt_pk_bf16(v1[0], v1[1]); w.w = pg8::cvt_pk_bf16(v1[2], v1[3]);
                    *(pg8::u32x4*)(O + (size_t)(row0 + ai * 128 + m * 16) * ldc + col0 + bj * 128) = w; }
    }
};
typedef float f32x16 __attribute__((ext_vector_type(16)));
__device__ __forceinline__ void p6_rows(const Params& p, LAS unsigned char* lds, int tid, int wave, int lane, int vcu, int G) {
    LAS float* tile = (LAS float*)lds;
    constexpr int RB = 1;
    float wreg[64];
#pragma unroll
    for (int i = 0; i < 64; ++i) wreg[i] = P_w_router[(size_t)(128 * wave + 2 * i + (lane >> 5)) * NE + (lane & 31)];
    for (int grp = vcu; grp < T / 64; grp += G) {
        const int b = (grp * 64) / SEQ;
        LAS float* vec = (LAS float*)(lds + TAB_OFF + 256);
        LAS int* lcnt = (LAS int*)(lds + TAB_OFF + 256 + 16384); LAS int* gbase = lcnt + 32; LAS int* pel = lcnt + 64;
        __syncthreads();
        if (tid < NE) lcnt[tid] = 0;
        if (tid < 256) { const int k = 4 * tid; const float* mf = P_modp + MODF_OFF + (size_t)b * 4 * D + k;
            const f32x4 a = *(const f32x4*)mf, g1 = *(const f32x4*)(P_g_post_mix + k), c = *(const f32x4*)(P_g_pre_ffn + k) * (1.f + *(const f32x4*)(mf + 2 * D)), d = *(const f32x4*)(mf + D);
            *(LAS f32x4*)(vec + k) = a; *(LAS f32x4*)(vec + 1024 + k) = g1; *(LAS f32x4*)(vec + 2048 + k) = c; *(LAS f32x4*)(vec + 3072 + k) = d; }
        __syncthreads();
#pragma unroll 1
        for (int half = 0; half < 2; ++half) {
#pragma unroll 1
            for (int sb = 0; sb < 4; sb += RB) {
                const int tr0 = wave * 4 + sb, m0 = grp * 64 + half * 32 + tr0;
                unsigned long long mw[RB][4]; f32x4 xv[RB][4]; float ss[RB];
#pragma unroll
                for (int rr = 0; rr < RB; ++rr)
#pragma unroll
                    for (int j = 0; j < 4; ++j) { mw[rr][j] = __builtin_nontemporal_load((const GAS unsigned long long*)(P_MIXOUT + (size_t)(m0 + rr) * D) + lane + 64 * j); xv[rr][j] = __builtin_nontemporal_load((const GAS f32x4*)(P_x + (size_t)(m0 + rr) * D) + lane + 64 * j); }
#define P6_UNPK(w) ((f32x4){__uint_as_float((unsigned)(w) << 16), __uint_as_float((unsigned)(w) & 0xffff0000u), __uint_as_float((unsigned)((w) >> 32) << 16), __uint_as_float((unsigned)((w) >> 32) & 0xffff0000u)})
#pragma unroll
                for (int rr = 0; rr < RB; ++rr) { float s = 0.f;
#pragma unroll
                    for (int j = 0; j < 4; ++j) { const f32x4 v = P6_UNPK(mw[rr][j]); s += (v.x * v.x + v.y * v.y) + (v.z * v.z + v.w * v.w); }
                    ss[rr] = s; }
#pragma unroll
                for (int o = 1; o < 64; o <<= 1) {
#pragma unroll
                    for (int rr = 0; rr < RB; ++rr) ss[rr] += __shfl_xor(ss[rr], o); }
#pragma unroll
                for (int rr = 0; rr < RB; ++rr) { const float rstd = 1.f / sqrtf(ss[rr] * (1.f / D) + EPS); GAS f32x4* orow = (GAS f32x4*)(P_out + (size_t)(m0 + rr) * D) + lane; float s = 0.f;
#pragma unroll
                    for (int j = 0; j < 4; ++j) { const int k = 4 * lane + 256 * j; const f32x4 v = P6_UNPK(mw[rr][j]);
                        const f32x4 x1 = xv[rr][j] + *(const LAS f32x4*)(vec + k) * (v * rstd * *(const LAS f32x4*)(vec + 1024 + k)); xv[rr][j] = x1; orow[64 * j] = x1; s += (x1.x * x1.x + x1.y * x1.y) + (x1.z * x1.z + x1.w * x1.w); }
                    ss[rr] = s; }
#undef P6_UNPK
#pragma unroll
                for (int o = 1; o < 64; o <<= 1) {
#pragma unroll
                    for (int rr = 0; rr < RB; ++rr) ss[rr] += __shfl_xor(ss[rr], o); }
#pragma unroll
                for (int rr = 0; rr < RB; ++rr) { const float rstd = 1.f / sqrtf(ss[rr] * (1.f / D) + EPS);
#pragma unroll
                    for (int j = 0; j < 4; ++j) { const int k = 4 * lane + 256 * j; const f32x4 u = xv[rr][j] * rstd * *(const LAS f32x4*)(vec + 2048 + k) + *(const LAS f32x4*)(vec + 3072 + k);
                        *((GAS unsigned*)((unsigned char*)P_U + (size_t)(m0 + rr) * D) + lane + 64 * j) = pk4_fp8(u.x * A8_SCALE, u.y * A8_SCALE, u.z * A8_SCALE, u.w * A8_SCALE);
                        LAS float* tp = tile + (tr0 + rr) * 1025 + k; tp[0] = u.x; tp[1] = u.y; tp[2] = u.z; tp[3] = u.w; } }
            }
            __syncthreads();
            f32x16 acc;
#pragma unroll
            for (int r = 0; r < 16; ++r) acc[r] = 0.f;
            { const LAS float* ap = tile + (lane & 31) * 1025 + 128 * wave + (lane >> 5);
#pragma unroll
              for (int i = 0; i < 64; ++i) acc = __builtin_amdgcn_mfma_f32_32x32x2f32(ap[2 * i], wreg[i], acc, 0, 0, 0); }
            __syncthreads();
            LAS float* part = (LAS float*)lds;
#pragma unroll
            for (int r = 0; r < 16; ++r) part[(wave * 32 + (r & 3) + 8 * (r >> 2) + 4 * (lane >> 5)) * 32 + (lane & 31)] = acc[r];
            __syncthreads();
#pragma unroll 1
            for (int rr = 0; rr < 4; ++rr) {
                const int tr = wave * 4 + rr, m = grp * 64 + half * 32 + tr;
                float mylg = -INFINITY;
                if (lane < 32) { float s = P_b_router[lane];
#pragma unroll
                    for (int w8 = 0; w8 < 8; ++w8) s += part[(w8 * 32 + tr) * 32 + lane];
                    mylg = s; }
                int sel[4]; float sv[4];
#pragma unroll
                for (int k = 0; k < 4; ++k) { float bv = mylg; int bi = lane;
#pragma unroll
                    for (int off = 1; off < 64; off <<= 1) { const float ov = __shfl_xor(bv, off); const int oi = __shfl_xor(bi, off);
                        if (ov > bv || (ov == bv && oi < bi)) { bv = ov; bi = oi; } }
                    sel[k] = bi; sv[k] = bv; if (lane == bi) mylg = -INFINITY; }
                float den = 0.f, pe[4];
#pragma unroll
                for (int k = 0; k < 4; ++k) { pe[k] = __expf(sv[k] - sv[0]); den += pe[k]; }
                if (lane == 0) {
#pragma unroll
                    for (int k = 0; k < 4; ++k) { P_prob[m * 4 + k] = pe[k] / den; const int loc = __hip_atomic_fetch_add(lcnt + sel[k], 1, __ATOMIC_RELAXED, __HIP_MEMORY_SCOPE_WORKGROUP);
                        pel[(half * 32 + tr) * 4 + k] = (sel[k] << 16) | loc; }
                }
            }
            __syncthreads();
        }
        if (tid < NE) { const int c = lcnt[tid]; gbase[tid] = c ? (int)__hip_atomic_fetch_add(P_ctl + CW_CNT + 64 * tid, (unsigned)c, __ATOMIC_RELAXED, __HIP_MEMORY_SCOPE_AGENT) : 0; }
        __syncthreads();
        if (tid < 256) { const int v = pel[tid], e = v >> 16, loc = v & 0xffff; P_lists[(size_t)e * T + gbase[e] + loc] = grp * 256 + tid; }
        __syncthreads();
    }
}
constexpr int MOE_MAXU = 10;
struct MoeSched {
    const bf16* Bt_all; size_t bstride; int K, ncol, a_shift, lda, G, c, total;
    const LAS int* pre;
    const LAS int* idx;
    const LAS int* utab;
    __device__ __forceinline__ bool locate(int i, pg8::Unit& u) const {
        const int L = (G == 256) ? ((i * 8 + (c & 7)) * 32 + (c >> 3)) : (i * G + c);
        if (L >= total || i >= MOE_MAXU) return false;
        const int RT = L / ncol; u.pn = L - RT * ncol;
        int e = 0;
#pragma unroll 1
        for (int q = 1; q < NE; ++q) e += (pre[q] <= RT) ? 1 : 0;
        u.e = e; u.pm = RT - pre[e]; u.ui = i; return true;
    }
    __device__ __forceinline__ bool next(int i, pg8::Unit& u) const {
        if (i >= MOE_MAXU) return false;
        const pg8::v4i_t t = *(const LAS pg8::v4i_t*)(utab + 4 * i);
        u.e = t[0]; u.pm = t[1]; u.pn = t[2]; u.ui = i; return t[3] != 0;
    }
    __device__ __forceinline__ unsigned a_off(const pg8::Unit& u, int r, int C) const {
        int pair = idx[u.ui * 256 + r]; if (pair < 0) pair = idx[u.ui * 256];
        return (unsigned)(((size_t)(pair >> a_shift) * lda + C) * 2u);
    }
    __device__ __forceinline__ const char* b_base(const pg8::Unit& u) const { return (const char*)(Bt_all + (size_t)u.e * bstride + (size_t)u.pn * 256 * K); }
    __device__ __forceinline__ void a_ready(const pg8::Unit&) const {}
    __device__ __forceinline__ void done(const pg8::Unit&) const {}
};
__device__ __forceinline__ void moe_setup(const Params& p, MoeSched& S, LAS int* pre, LAS int* idx, int tid) {
    LAS int* utab = pre + 48;
    if (tid == 0) { int acc = 0; for (int e = 0; e < NE; ++e) { pre[e] = acc; const int c = (int)__hip_atomic_load(P_ctl + CW_CNT + 64 * e, __ATOMIC_RELAXED, __HIP_MEMORY_SCOPE_AGENT); acc += (c + 255) >> 8; } pre[NE] = acc; }
    __syncthreads();
    S.pre = pre; S.idx = idx; S.utab = utab; S.total = pre[NE] * S.ncol;
    for (int i = 0; i < MOE_MAXU; ++i) { pg8::Unit u; const bool ok = S.locate(i, u);
        if (tid == 0) { utab[4 * i] = ok ? u.e : 0; utab[4 * i + 1] = ok ? u.pm : 0; utab[4 * i + 2] = ok ? u.pn : 0; utab[4 * i + 3] = ok ? 1 : 0; }
        if (!ok) continue;
        if (tid < 256) { const int cnt = (int)__hip_atomic_load(P_ctl + CW_CNT + 64 * u.e, __ATOMIC_RELAXED, __HIP_MEMORY_SCOPE_AGENT); const int r = u.pm * 256 + tid;
            idx[i * 256 + tid] = r < cnt ? P_lists[(size_t)u.e * T + r] : -1; } }
    __syncthreads();
}
struct EpiAct {
    static constexpr bool PERM = true; static constexpr int MID_T = -1;
    bf16* ACT; const float* b_gu; const LAS int* idx;
    __device__ __forceinline__ void mid(pg8::f32x4 (&)[2][2][4][2], const pg8::Unit&, int, int, int, int) const {}
    __device__ __forceinline__ void operator()(pg8::f32x4 (&acc)[2][2][4][2], const pg8::Unit& u, int wr, int wc, int fr, int fq) const {
        const int col = u.pn * 128 + wc * 32 + 8 * fq; const float* bg = b_gu + (size_t)u.e * 2 * DFF + col;
        const f32x4 bg0 = *(const f32x4*)bg, bg1 = *(const f32x4*)(bg + 4), bu0 = *(const f32x4*)(bg + DFF), bu1 = *(const f32x4*)(bg + DFF + 4);
#pragma unroll
        for (int ai = 0; ai < 2; ++ai)
#pragma unroll
            for (int m = 0; m < 4; ++m) {
                const int pair = idx[u.ui * 256 + ai * 128 + wr * 64 + m * 16 + fr];
                float o[8];
#pragma unroll
                for (int n = 0; n < 2; ++n)
#pragma unroll
                    for (int j = 0; j < 4; ++j) { float g = acc[ai][0][m][n][j] * MOE_DESCALE + (n ? bg1[j] : bg0[j]); float up = acc[ai][1][m][n][j] * MOE_DESCALE + (n ? bu1[j] : bu0[j]);
                        g = fminf(g, 7.f); up = fminf(fmaxf(up, -7.f), 7.f);
                        o[n * 4 + j] = (up * A8_SCALE + A8_SCALE) * (g * __builtin_amdgcn_rcpf(1.f + __builtin_amdgcn_exp2f(-2.4554669595930156f * g))); }
                if (pair >= 0) { pg8::u32x2 w; int w0 = __builtin_amdgcn_cvt_pk_fp8_f32(o[0], o[1], 0, false); w0 = __builtin_amdgcn_cvt_pk_fp8_f32(o[2], o[3], w0, true);
                    int w1 = __builtin_amdgcn_cvt_pk_fp8_f32(o[4], o[5], 0, false); w1 = __builtin_amdgcn_cvt_pk_fp8_f32(o[6], o[7], w1, true); w.x = (unsigned)w0; w.y = (unsigned)w1;
                    *(pg8::u32x2*)((unsigned char*)ACT + (size_t)pair * DFF + col) = w; }
            }
    }
};
struct EpiY {
    static constexpr bool PERM = true; static constexpr int MID_T = -1;
    bf16* Y; const float* b_dn; const LAS int* idx;
    __device__ __forceinline__ void mid(pg8::f32x4 (&)[2][2][4][2], const pg8::Unit&, int, int, int, int) const {}
    __device__ __forceinline__ void operator()(pg8::f32x4 (&acc)[2][2][4][2], const pg8::Unit& u, int wr, int wc, int fr, int fq) const {
        const int col0 = u.pn * 256 + wc * 32 + 8 * fq; const float* bb = b_dn + (size_t)u.e * D + col0;
        f32x4 bv[2][2];
#pragma unroll
        for (int bj = 0; bj < 2; ++bj) { bv[bj][0] = *(const f32x4*)(bb + bj * 128); bv[bj][1] = *(const f32x4*)(bb + bj * 128 + 4); }
#pragma unroll
        for (int ai = 0; ai < 2; ++ai)
#pragma unroll
            for (int m = 0; m < 4; ++m) {
                const int pair = idx[u.ui * 256 + ai * 128 + wr * 64 + m * 16 + fr];
                if (pair >= 0) {
#pragma unroll
                    for (int bj = 0; bj < 2; ++bj) { const pg8::f32x4 v0 = acc[ai][bj][m][0] * MOE_DESCALE + bv[bj][0], v1 = acc[ai][bj][m][1] * MOE_DESCALE + bv[bj][1];
                        pg8::u32x4 w; w.x = pg8::cvt_pk_bf16(v0[0], v0[1]); w.y = pg8::cvt_pk_bf16(v0[2], v0[3]); w.z = pg8::cvt_pk_bf16(v1[0], v1[1]); w.w = pg8::cvt_pk_bf16(v1[2], v1[3]);
                        *(pg8::u32x4*)(Y + (size_t)pair * D + col0 + bj * 128) = w; }
                }
            }
    }
};
__device__ __forceinline__ void p9_rows(const Params& p, int wave, int lane, int vcu, int G) {
    for (int grp = vcu; grp < T / 64; grp += G) {
        const int row0 = grp * 64 + wave * 8, b = row0 / SEQ;
        f32x4 gf[2][2];
#pragma unroll
        for (int j = 0; j < 2; ++j)
#pragma unroll
            for (int q = 0; q < 2; ++q) { const int k = 8 * lane + 512 * j + 4 * q; gf[j][q] = *(const f32x4*)(P_modp + MODF_OFF + (size_t)(b * 4 + 3) * D + k) * *(const f32x4*)(P_g_post_ffn + k); }
#pragma unroll 1
        for (int rb = 0; rb < 8; rb += 2) {
            v4u yw[2][4][2]; f32x4 xv[2][2][2]; f32x4 pr[2];
#pragma unroll
            for (int r = 0; r < 2; ++r) { const int m = row0 + rb + r; pr[r] = *(const f32x4*)(P_prob + (size_t)m * 4);
#pragma unroll
                for (int kk = 0; kk < 4; ++kk)
#pragma unroll
                    for (int j = 0; j < 2; ++j) yw[r][kk][j] = __builtin_nontemporal_load((const GAS v4u*)(P_Y + ((size_t)m * 4 + kk) * D) + lane + 64 * j);
#pragma unroll
                for (int j = 0; j < 2; ++j)
#pragma unroll
                    for (int q = 0; q < 2; ++q) xv[r][j][q] = *((const GAS f32x4*)(P_out + (size_t)m * D) + 2 * lane + 128 * j + q); }
            f32x4 f[2][2][2]; float ss[2];
#pragma unroll
            for (int r = 0; r < 2; ++r) { float s = 0.f;
#pragma unroll
                for (int j = 0; j < 2; ++j) { f32x4 f0 = {0.f, 0.f, 0.f, 0.f}, f1 = f0;
#pragma unroll
                    for (int kk = 0; kk < 4; ++kk) { const v4u w = yw[r][kk][j]; const float pk = pr[r][kk];
                        f0 += (f32x4){__uint_as_float(w.x << 16), __uint_as_float(w.x & 0xffff0000u), __uint_as_float(w.y << 16), __uint_as_float(w.y & 0xffff0000u)} * pk;
                        f1 += (f32x4){__uint_as_float(w.z << 16), __uint_as_float(w.z & 0xffff0000u), __uint_as_float(w.w << 16), __uint_as_float(w.w & 0xffff0000u)} * pk; }
                    f[r][j][0] = f0; f[r][j][1] = f1; s += (f0.x * f0.x + f0.y * f0.y) + (f0.z * f0.z + f0.w * f0.w) + (f1.x * f1.x + f1.y * f1.y) + (f1.z * f1.z + f1.w * f1.w); }
                ss[r] = s; }
#pragma unroll
            for (int o = 1; o < 64; o <<= 1) {
#pragma unroll
                for (int r = 0; r < 2; ++r) ss[r] += __shfl_xor(ss[r], o); }
#pragma unroll
            for (int r = 0; r < 2; ++r) { const int m = row0 + rb + r; const float rstd = 1.f / sqrtf(ss[r] * (1.f / D) + EPS);
#pragma unroll
                for (int j = 0; j < 2; ++j)
#pragma unroll
                    for (int q = 0; q < 2; ++q) __builtin_nontemporal_store(xv[r][j][q] + gf[j][q] * (f[r][j][q] * rstd), (GAS f32x4*)(P_out + (size_t)m * D) + 2 * lane + 128 * j + q); }
        }
    }
}
}

namespace mk {
namespace at {
typedef float f32x16 __attribute__((ext_vector_type(16)));
typedef short s16x4 __attribute__((ext_vector_type(4)));
typedef short v4i16_t __attribute__((ext_vector_type(4)));
typedef LAS const char* lds_cptr;
constexpr int KSLOT = 8192, VSLOT = 16384;
constexpr int L_K = 0, L_V = 3 * KSLOT, L_WS = L_V + 3 * VSLOT, L_ST = L_WS + NW * 256, L_END = L_ST + NW * 8192;
static_assert(L_END <= MISC_OFF, "attention LDS map");
__device__ __forceinline__ int crow(int r, int hi) { return (r & 3) + 8 * (r >> 2) + 4 * hi; }
__device__ __forceinline__ void glds16(const void* gsrc, unsigned lds_dst) { unsigned keep;
    asm volatile("s_mov_b32 %0, m0\n\ts_mov_b32 m0, %2\n\ts_nop 0\n\tglobal_load_lds_dwordx4 %1, off\n\ts_mov_b32 m0, %0" : "=&s"(keep) : "v"(gsrc), "s"(lds_dst) : "memory"); }
__device__ __forceinline__ void glds16s(const void* sbase, unsigned voff, unsigned lds_dst) { unsigned keep;
    asm volatile("s_mov_b32 %0, m0\n\ts_mov_b32 m0, %3\n\ts_nop 0\n\tglobal_load_lds_dwordx4 %1, %2\n\ts_mov_b32 m0, %0" : "=&s"(keep) : "v"(voff), "s"(sbase), "s"(lds_dst) : "memory"); }
__device__ __forceinline__ unsigned cvtpk(float lo, float hi) { typedef float f2 __attribute__((ext_vector_type(2))); typedef __bf16 b2 __attribute__((ext_vector_type(2))); f2 v = {lo, hi}; b2 b = __builtin_convertvector(v, b2); return __builtin_bit_cast(unsigned, b); }
__device__ __forceinline__ s16x4 vtr(lds_cptr p) { return __builtin_bit_cast(s16x4, __builtin_amdgcn_ds_read_tr16_b64_v4i16((LAS v4i16_t*)p)); }
__device__ __forceinline__ float swap_max(float m) { auto rr = __builtin_amdgcn_permlane32_swap(__float_as_uint(m), __float_as_uint(m), false, false); return fmaxf(__uint_as_float(rr[0]), __uint_as_float(rr[1])); }
__device__ __forceinline__ float swap_sum(float m) { auto rr = __builtin_amdgcn_permlane32_swap(__float_as_uint(m), __float_as_uint(m), false, false); return __uint_as_float(rr[0]) + __uint_as_float(rr[1]); }
#define AT_MFMA(a, b, c) __builtin_amdgcn_mfma_f32_32x32x16_bf16(a, b, c, 0, 0, 0)
__device__ __forceinline__ float at_max3(float a, float b, float c) { float r; asm("v_max3_f32 %0, %1, %2, %3" : "=v"(r) : "v"(a), "v"(b), "v"(c)); return r; }

constexpr float THRL = 8.f;
template <int VAR>
__device__ __forceinline__ void attn_unit(const Params& p, LAS unsigned char* lds, int tid, int b, int h, int qb, float lam, bf16* AMo) {
    const int lane = tid & 63, r32 = lane & 31, hi = lane >> 5; const int wid = __builtin_amdgcn_readfirstlane(tid >> 6);
    const size_t rowbase = (size_t)b * SEQ;
    const int q0 = qb * 256 + wid * 32;
    const int NT = 4 * qb + 4;
    const int my_last = 4 * qb + (wid >> 1);
    const unsigned lds0 = (unsigned)(uintptr_t)lds;
    LAS float* wsf = (LAS float*)(lds + L_WS) + wid * 64;
    const lds_cptr kp0 = (lds_cptr)(lds + L_K) + hi * 1024 + r32 * 16;
    const lds_cptr vp0 = (lds_cptr)(lds + L_V) + ((lane >> 4) & 1) * 32 + (lane & 3) * 8 + (4 * hi + ((lane & 15) >> 2)) * 64;
    LAS unsigned short* const stg = (LAS unsigned short*)(lds + L_ST + wid * 8192);
#pragma unroll 1
    for (int mp = 0; mp < 2; ++mp) {
        const int n = 2 * h + mp;
        bf16x8 qr[4];
        { const bf16* qw = P_QKV + (rowbase + q0 + r32) * 3072 + n * 64 + hi * 8;
#pragma unroll
          for (int d0 = 0; d0 < 4; ++d0) qr[d0] = *(const GAS bf16x8*)(qw + d0 * 16); }
        asm volatile("" : "+v"(qr[0]), "+v"(qr[1]), "+v"(qr[2]), "+v"(qr[3]));
        const char* kbase = (const char*)(P_QKV + rowbase * 3072 + 1024 + n * 64 + wid * 8);
        const char* vbase = (const char*)(P_QKV + (rowbase + 16 * (wid & 3)) * 3072 + 2048 + h * 128 + (wid >> 2) * 32);
        const unsigned klo = (unsigned)lane * 6144u, vlo = (unsigned)(lane >> 2) * 6144u + (unsigned)(lane & 3) * 16u;
#define AT_DMA(t, s) do { const size_t to_ = (size_t)(t) * 64 * 6144; \
                          glds16s(kbase + to_, klo, (unsigned)__builtin_amdgcn_readfirstlane(lds0 + L_K + (s) * KSLOT + wid * 1024)); \
                          glds16s(vbase + to_, vlo, (unsigned)__builtin_amdgcn_readfirstlane(lds0 + L_V + (s) * VSLOT + wid * 1024)); \
                          glds16s(vbase + to_ + 128, vlo, (unsigned)__builtin_amdgcn_readfirstlane(lds0 + L_V + (s) * VSLOT + (wid + 8) * 1024)); } while (0)
        AT_DMA(0, 0); AT_DMA(1, 1);
        f32x16 o[4];
        float mrow = 0.f, lsum = 0.f;
        int s = 0;
        f32x16 pA0, pA1, pB0, pB1;
        f32x16 negm = {0.f, 0.f, 0.f, 0.f, 0.f, 0.f, 0.f, 0.f, 0.f, 0.f, 0.f, 0.f, 0.f, 0.f, 0.f, 0.f};
#define AT_KRD(dst, kb, d0) do { dst[0] = *(const LAS bf16x8*)((kb) + (d0) * 2048); dst[1] = *(const LAS bf16x8*)((kb) + (d0) * 2048 + 512); } while (0)
#define AT_QK(P0, P1, sl) do { const lds_cptr kb_ = kp0 + (sl) * KSLOT; bf16x8 ka_[2], kb2_[2]; \
            AT_KRD(ka_, kb_, 0); AT_KRD(kb2_, kb_, 1); __builtin_amdgcn_sched_barrier(0); \
            P0 = AT_MFMA(ka_[0], qr[0], negm); P1 = AT_MFMA(ka_[1], qr[0], negm); AT_KRD(ka_, kb_, 2); __builtin_amdgcn_sched_barrier(0); \
            P0 = AT_MFMA(kb2_[0], qr[1], P0); P1 = AT_MFMA(kb2_[1], qr[1], P1); AT_KRD(kb2_, kb_, 3); __builtin_amdgcn_sched_barrier(0); \
            P0 = AT_MFMA(ka_[0], qr[2], P0); P1 = AT_MFMA(ka_[1], qr[2], P1); __builtin_amdgcn_sched_barrier(0); \
            P0 = AT_MFMA(kb2_[0], qr[3], P0); P1 = AT_MFMA(kb2_[1], qr[3], P1); __builtin_amdgcn_sched_barrier(0); } while (0)
#define AT_VRD(i, ks0) do { const s16x4 lo_ = vtr(vb_ + ((i) & 3) * 4096 + ((ks0) + ((i) >> 2)) * 1024), hh_ = vtr(vb_ + ((i) & 3) * 4096 + ((ks0) + ((i) >> 2)) * 1024 + 512); \
            F_[i] = (bf16x8){lo_[0], lo_[1], lo_[2], lo_[3], hh_[0], hh_[1], hh_[2], hh_[3]}; } while (0)
#define AT_MX3(a, b, c) at_max3(a, b, c)
#define AT_STEP(PC0, PC1, PN0, PN1, T) do { \
            asm volatile("s_waitcnt vmcnt(0) lgkmcnt(0)\n\ts_barrier" ::: "memory");     \
            const int s1_ = (s == 2) ? 0 : s + 1, s2_ = (s1_ == 2) ? 0 : s1_ + 1; \
            if ((T) + 2 < NT) AT_DMA((T) + 2, s2_); \
            if (VAR != 1 && (T) <= my_last) { \
                float ra_ = AT_MX3(PC0[0], PC0[1], PC1[0]), rb_ = AT_MX3(PC0[2], PC0[3], PC1[1]); ra_ = AT_MX3(ra_, PC1[2], PC1[3]); \
                _Pragma("unroll") for (int r = 4; r < 16; r += 4) { ra_ = AT_MX3(ra_, PC0[r], PC0[r + 1]); rb_ = AT_MX3(rb_, PC0[r + 2], PC0[r + 3]); ra_ = AT_MX3(ra_, PC1[r], PC1[r + 1]); rb_ = AT_MX3(rb_, PC1[r + 2], PC1[r + 3]); } \
                float rm_ = swap_max(fmaxf(ra_, rb_));                   \
                if ((T) == 0 || __any(rm_ > THRL)) {                      \
                    const float dl_ = ((T) == 0) ? rm_ : fmaxf(rm_, 0.f); \
                    mrow += dl_; \
                    _Pragma("unroll") for (int r = 0; r < 16; ++r) { PC0[r] -= dl_; PC1[r] -= dl_; negm[r] = -mrow; } \
                    if ((T) != 0) { const float al_ = __builtin_amdgcn_exp2f(-dl_); lsum *= al_; \
                        if (hi == 0) wsf[r32] = al_; \
                        asm volatile("s_waitcnt lgkmcnt(0)" ::: "memory"); \
                        _Pragma("unroll") for (int r = 0; r < 16; ++r) { const float f_ = wsf[crow(r, hi)]; \
                            _Pragma("unroll") for (int d0 = 0; d0 < 4; ++d0) o[d0][r] *= f_; } } } \
                __builtin_amdgcn_sched_barrier(0); \
                if ((T) + 1 <= my_last) AT_QK(PN0, PN1, s1_);             \
                if (VAR == 2) { asm volatile("" :: "v"(PC0), "v"(PC1)); } else { \
                const lds_cptr vb_ = vp0 + s * VSLOT; v4u pw_[4]; bf16x8 F_[8]; float sacc_ = 0.f; \
                if (VAR != 3) { AT_VRD(0, 0); AT_VRD(1, 0); AT_VRD(2, 0); AT_VRD(3, 0); AT_VRD(4, 0); AT_VRD(5, 0); AT_VRD(6, 0); AT_VRD(7, 0); }     \
                __builtin_amdgcn_sched_barrier(0); \
                _Pragma("unroll") for (int r = 0; r < 16; ++r) { PC0[r] = __builtin_amdgcn_exp2f(PC0[r]); sacc_ += PC0[r]; } \
                _Pragma("unroll") for (int i = 0; i < 4; ++i) { pw_[0][i] = cvtpk(PC0[2 * i], PC0[2 * i + 1]); pw_[1][i] = cvtpk(PC0[8 + 2 * i], PC0[9 + 2 * i]); } \
                __builtin_amdgcn_sched_barrier(0); \
                  \
                AT_GAP1(PC1, 0); AT_GAP1(PC1, 1); AT_GAP1(PC1, 2); AT_GAP1(PC1, 3); AT_GAP1(PC1, 4); AT_GAP1(PC1, 5); AT_GAP1(PC1, 6); AT_GAP1(PC1, 7); \
                _Pragma("unroll") for (int i = 0; i < 4; ++i) { pw_[2][i] = cvtpk(PC1[2 * i], PC1[2 * i + 1]); pw_[3][i] = cvtpk(PC1[8 + 2 * i], PC1[9 + 2 * i]); } \
                lsum += sacc_; \
                __builtin_amdgcn_sched_barrier(0); \
                if (VAR != 3) { _Pragma("unroll") for (int i = 0; i < 8; ++i) o[i & 3] = AT_MFMA(__builtin_bit_cast(bf16x8, pw_[2 + (i >> 2)]), F_[i], o[i & 3]); } else { asm volatile("" :: "v"(pw_[0]), "v"(pw_[1]), "v"(pw_[2]), "v"(pw_[3])); } \
                __builtin_amdgcn_sched_barrier(0); \
            } } \
            s = s1_; } while (0)
#define AT_GAP1(P1, i) do { if (VAR != 3) { o[(i) & 3] = AT_MFMA(__builtin_bit_cast(bf16x8, pw_[(i) >> 2]), F_[i], o[(i) & 3]); AT_VRD(i, 2); } \
            P1[2 * (i)] = __builtin_amdgcn_exp2f(P1[2 * (i)]); P1[2 * (i) + 1] = __builtin_amdgcn_exp2f(P1[2 * (i) + 1]); sacc_ += P1[2 * (i)]; sacc_ += P1[2 * (i) + 1]; \
            asm volatile("" : "+v"(P1), "+v"(sacc_)); __builtin_amdgcn_sched_barrier(0); } while (0)
        asm volatile("s_waitcnt vmcnt(3)\n\ts_barrier" ::: "memory");
#pragma unroll
        for (int r = 0; r < 16; ++r) {
#pragma unroll
            for (int d0 = 0; d0 < 4; ++d0) o[d0][r] = 0.f; }
        if (VAR != 1) AT_QK(pA0, pA1, 0);
        asm volatile("s_nop 7\n\ts_nop 7" ::: "memory");
#pragma unroll 1
        for (int t = 0; t < NT; t += 2) {
            AT_STEP(pA0, pA1, pB0, pB1, t);
            AT_STEP(pB0, pB1, pA0, pA1, t + 1);
        }
        asm volatile("s_waitcnt lgkmcnt(0)\n\ts_barrier" ::: "memory");
#undef AT_STEP
#undef AT_GAP1
#undef AT_MX3
#undef AT_VRD
#undef AT_QK
#undef AT_KRD
        int le_ = lane; asm volatile("" : "+v"(le_)); const int r32e = le_ & 31, hie = le_ >> 5;
        LAS unsigned short* const stge = (LAS unsigned short*)(lds + L_ST + wid * 8192) + r32e;
        lsum = swap_sum(lsum);
        if (hie == 0) wsf[32 + r32e] = 1.f / lsum;
        asm volatile("s_waitcnt lgkmcnt(0)" ::: "memory");
        float rli[16];
#pragma unroll
        for (int r = 0; r < 16; ++r) rli[r] = wsf[32 + crow(r, hie)];
        asm volatile("s_waitcnt lgkmcnt(0)" ::: "memory");
        if (mp == 0) {
#pragma unroll
            for (int r = 0; r < 16; ++r) { const int q = crow(r, hie);
#pragma unroll
                for (int d0 = 0; d0 < 4; ++d0) stge[q * 128 + 32 * d0] = (unsigned short)f2bf(o[d0][r] * rli[r]); }
            asm volatile("s_waitcnt lgkmcnt(0)" ::: "memory");
        } else {
            float ssq[16];
#pragma unroll
            for (int r = 0; r < 16; ++r) { ssq[r] = 0.f; const int q = crow(r, hie);
#pragma unroll
                for (int d0 = 0; d0 < 4; ++d0) { const float a0 = __uint_as_float((unsigned)stge[q * 128 + 32 * d0] << 16); const float v0 = a0 - lam * (o[d0][r] * rli[r]); o[d0][r] = v0; ssq[r] += v0 * v0; } }
            asm volatile("s_waitcnt lgkmcnt(0)" ::: "memory");
#pragma unroll
            for (int off = 1; off < 32; off <<= 1)
#pragma unroll
                for (int r = 0; r < 16; ++r) ssq[r] += __shfl_xor(ssq[r], off);
#pragma unroll
            for (int r = 0; r < 16; ++r) { const float rs = (1.f / sqrtf(ssq[r] * (1.f / 128.f) + EPS)) * 0.8f; const int q = crow(r, hie);
#pragma unroll
                for (int d0 = 0; d0 < 4; ++d0) { stge[q * 128 + 32 * d0] = (unsigned short)f2bf(o[d0][r] * rs * P_g_sub[r32e + 32 * d0]); } }
            asm volatile("s_waitcnt lgkmcnt(0)" ::: "memory");
            bf16* ow = AMo + (rowbase + q0) * 1536 + h * 128;
#pragma unroll
            for (int i = 0; i < 8; ++i) { const int row = i * 4 + (le_ >> 4), ch = le_ & 15; const v4u v = *(const LAS v4u*)(stge - r32e + row * 128 + ch * 8); *(GAS v4u*)(ow + (size_t)row * 1536 + ch * 8) = v; }
        }
#undef AT_DMA
    }
}
}
template <int VAR = 0>
__device__ __forceinline__ void attn_phase(const Params& p, LAS unsigned char* lds, int tid, int vcu, int G) {
    const float lam = lam_value(p);
    bf16* AMo = VAR == 0 ? P_AM : P_ACT;
    for (int pr = vcu; pr < 256; pr += G) {
        const int bh = pr >> 2, s = pr & 3, b = bh >> 3, h = bh & 7;
#pragma unroll 1
        for (int u = 0; u < 2; ++u) at::attn_unit<VAR>(p, lds, tid, b, h, u ? 7 - s : s, lam, AMo);
    }
}
}

namespace mk {
constexpr int NPH = 10;
#ifndef MK_SKIP
#define MK_SKIP 0
#endif
#ifndef MK_REPEAT
#define MK_REPEAT 0
#endif
#ifndef MK_PROFILE_PREFIX
#define MK_PROFILE_PREFIX 0
#endif
__global__ void __launch_bounds__(NTHR, 2) mega(Params p) {
    extern __shared__ __attribute__((aligned(16))) unsigned char lds_raw[];
    LAS unsigned char* lds = (LAS unsigned char*)lds_raw;
    volatile LAS unsigned* MISC = (volatile LAS unsigned*)(lds + MISC_OFF);
    const int tid0 = threadIdx.x;
    typedef __attribute__((address_space(4))) const Params CParams;
    CParams* const kp0 = (CParams*)__builtin_amdgcn_kernarg_segment_ptr();
#define FRESH int tid = tid0; asm volatile("" : "+v"(tid)); const int lane = tid & 63, wave = __builtin_amdgcn_readfirstlane(tid >> 6); (void)lane; (void)wave; \
              CParams* kp_ = kp0; asm volatile("" : "+s"(kp_)); Params p; { typedef __attribute__((address_space(4))) const unsigned long long cu64_; cu64_* s_ = (cu64_*)kp_; unsigned long long* d_ = (unsigned long long*)&p; \
              _Pragma("unroll") for (int i_ = 0; i_ < (int)(sizeof(Params) / 8); ++i_) d_[i_] = s_[i_]; }
    const int G = gridDim.x; const int bx = blockIdx.x; const int vcu = (G % 8 == 0) ? (bx % 8) * (G / 8) + bx / 8 : bx;
    if (tid0 < 64) MISC[tid0] = 0u;
    __syncthreads();
    XcdBarrier bar = xcd_barrier_post(P_ctl + CW_BAR + p.li * XCD_BAR_WORDS, MISC + 8);
    LAS int* pre = (LAS int*)(lds + TAB_OFF); LAS int* idx = (LAS int*)(lds + TAB_OFF + 512);
#ifdef MK_DOUBLE_BAR
#define SEAM(k) do { if (IN(k) && IN((k) + 1)) { xcd_barrier(bar); xcd_barrier(bar); } } while (0)
#else
#define SEAM(k) do { if (IN(k) && IN((k) + 1)) xcd_barrier(bar); } while (0)
#endif
#ifndef MK_ATTN_VAR
#define MK_ATTN_VAR 0
#endif
#define PHASE(k, ...) if (IN(k) && !(MK_SKIP & (1 << (k)))) { { FRESH; __VA_ARGS__ } if (MK_REPEAT & (1 << (k))) { __syncthreads(); FRESH; __VA_ARGS__ } } SEAM(k);
#ifdef MK_P2_NULL
#define PHASE_P2NULL if (IN(2)) { FRESH; pg8::Gemm g{P_U, D}; pg8::StaticOrder S; S.init(T, INW, D, D, P_Wt_in, G, bx); EpiNull E{}; pg8::gemm_phase<EpiNull, pg8::StaticOrder, true>(lds + RING_OFF, g, S, E, tid); xcd_barrier(bar); }
#else
#define PHASE_P2NULL
#endif
#define PROGRAM \
    PHASE(0, p0_prologue(p, lds, tid, wave, lane, vcu, G);) \
    PHASE(1, p1_rows(p, lds, tid, wave, lane, vcu, G);) \
    PHASE(2, pg8::Gemm g{P_U, D}; pg8::StaticOrder S; S.init(T, INW, D, D, P_Wt_in, G, bx); \
             EpiZ E{P_QKV, P_PB, P_GR, P_SGP, P_rope}; \
             pg8::gemm_phase<EpiZ, pg8::StaticOrder, true>(lds + RING_OFF, g, S, E, tid);) \
    PHASE_P2NULL \
    PHASE(3, if (!(p.flags & 2)) attn_phase<0>(p, lds, tid, vcu, G); \
             pool_phase(p, lds, tid, wave, lane, vcu, G); \
             if (MK_ATTN_VAR) { __syncthreads(); attn_phase<MK_ATTN_VAR>(p, lds, tid, vcu, G); }) \
    PHASE(4, pg8::Gemm g{P_AM, 1536}; pg8::StaticOrder S; S.init(T, D, 1536, 1536, P_Wt_mix, G, bx); \
             EpiMerge E{P_GR, P_SGP, P_MERGED}; \
             pg8::gemm_phase<EpiMerge, pg8::StaticOrder, true>(lds + RING_OFF, g, S, E, tid);) \
    PHASE(5, if (MK_PROFILE_PREFIX && bx == 0 && tid < NE) __hip_atomic_store(P_ctl + CW_CNT + 64 * tid, 0u, __ATOMIC_RELAXED, __HIP_MEMORY_SCOPE_AGENT); \
             pg8::Gemm g{P_MERGED, D}; pg8::StaticOrder S; S.init(T, D, D, D, P_Wt_out, G, bx); \
             EpiStore E{P_MIXOUT, D}; \
             pg8::gemm_phase<EpiStore, pg8::StaticOrder, true>(lds + RING_OFF, g, S, E, tid);) \
    PHASE(6, p6_rows(p, lds, tid, wave, lane, vcu, G);) \
    PHASE(7, MoeSched S{P_Wt_gu, (size_t)2 * DFF * D / 2, D / 2, 8, 2, D / 2, G, bx, 0, nullptr, nullptr, nullptr};     \
             moe_setup(p, S, pre, idx, tid); \
             pg8::Gemm g{P_U, D / 2}; EpiAct E{P_ACT, P_b_gu, idx}; \
             pg8::gemm_phase<EpiAct, MoeSched, true, true>(lds + RING_OFF, g, S, E, tid);) \
    PHASE(8, MoeSched S{P_Wt_dn, (size_t)D * DFF / 2, DFF / 2, 4, 0, DFF / 2, G, bx, 0, nullptr, nullptr, nullptr}; \
             moe_setup(p, S, pre, idx, tid); \
             pg8::Gemm g{P_ACT, DFF / 2}; EpiY E{P_Y, P_b_dn, idx}; \
             pg8::gemm_phase<EpiY, MoeSched, true, true>(lds + RING_OFF, g, S, E, tid);) \
    PHASE(9, p9_rows(p, wave, lane, vcu, G);)
#if MK_PROFILE_PREFIX
    {
#define IN(k) ((k) < MK_PROFILE_PREFIX)
        PROGRAM
#undef IN
        xcd_barrier(bar);
    }
#endif
    {
        const int lo = p.ph_lo, hi = p.ph_hi;
#define IN(k) (lo <= (k) && (k) < hi)
        PROGRAM
#undef IN
    }
#undef PROGRAM
#undef SEAM
#undef PHASE
#undef FRESH
}
}

static int g_grid = 0;
static int mk_setup() {
    if (g_grid) return g_grid;
    int dev = 0, cus = 0;
    if (hipGetDevice(&dev) != hipSuccess || hipDeviceGetAttribute(&cus, hipDeviceAttributeMultiprocessorCount, dev) != hipSuccess) { g_grid = -1; return -1; }
    if (hipFuncSetAttribute((const void*)mk::mega, hipFuncAttributeMaxDynamicSharedMemorySize, mk::LDS_BYTES) != hipSuccess) { g_grid = -1; return -1; }
    int per_cu = 0;
    if (hipOccupancyMaxActiveBlocksPerMultiprocessor(&per_cu, (const void*)mk::mega, mk::NTHR, mk::LDS_BYTES) != hipSuccess || per_cu < 1) { fprintf(stderr, "kernel_launch: occupancy query reports %d workgroups per CU\n", per_cu); }
    (void)hipGetLastError();
    g_grid = cus;
    return g_grid;
}
extern "C" void kernel_launch(void* const* d_in, const int* in_sizes, int n_in, void* d_out, int out_size, void* d_ws, size_t ws_size, hipStream_t stream) {
    if (mk_setup() < 0 || n_in != 26) return;
    unsigned char* wsb = (unsigned char*)d_ws;
    const size_t MiB = 1u << 20;
    mk::Params p{};
    p.x = (const GAS float*)d_in[0]; p.c = (const GAS float*)d_in[1]; p.pos = (const GAS int*)d_in[2]; p.w_mod = (const GAS float*)d_in[3]; p.b_mod = (const GAS float*)d_in[4]; p.g_pre_mix = (const GAS float*)d_in[5];
    p.w_in = (const GAS float*)d_in[6]; p.lq1 = (const GAS float*)d_in[7]; p.lk1 = (const GAS float*)d_in[8]; p.lq2 = (const GAS float*)d_in[9]; p.lk2 = (const GAS float*)d_in[10]; p.g_sub = (const GAS float*)d_in[11];
    p.w_pg = (const GAS float*)d_in[12]; p.pool_scale = (const GAS float*)d_in[13]; p.w_att = (const GAS float*)d_in[14]; p.w_pb = (const GAS float*)d_in[15]; p.w_out = (const GAS float*)d_in[16];
    p.g_post_mix = (const GAS float*)d_in[17]; p.g_pre_ffn = (const GAS float*)d_in[18]; p.w_router = (const GAS float*)d_in[19]; p.b_router = (const GAS float*)d_in[20];
    p.w_gu = (const GAS float*)d_in[21]; p.b_gu = (const GAS float*)d_in[22]; p.w_dn = (const GAS float*)d_in[23]; p.b_dn = (const GAS float*)d_in[24]; p.g_post_ffn = (const GAS float*)d_in[25];
    p.out = (GAS float*)d_out;
    size_t off = 0;
    auto carve = [&](size_t mib) { unsigned char* r = wsb + off; off += mib * MiB; return r; };
    p.ctl = (GAS unsigned*)carve(1); p.modp = (GAS float*)carve(2); p.rope = (GAS float*)carve(1);
    p.Wt_in = (GAS bf16*)carve(11); p.Wt_mix = (GAS bf16*)carve(3); p.Wt_out = (GAS bf16*)carve(2); p.Wt_pg = (GAS bf16*)carve(1);
    p.prob = (GAS float*)carve(1); p.lists = (GAS int*)carve(2);
    p.U = (GAS bf16*)carve(32); p.QKV = (GAS bf16*)carve(96); p.PB = (GAS bf16*)carve(16); p.GR = (GAS bf16*)carve(32); p.SGP = (GAS bf16*)carve(32);
    p.AM = (GAS bf16*)carve(48); p.MERGED = (GAS bf16*)carve(32); p.MIXOUT = (GAS bf16*)carve(32);
    p.Wt_gu = (GAS bf16*)carve(128); p.Wt_dn = (GAS bf16*)carve(64); p.ACT = (GAS bf16*)carve(128); p.Y = (GAS bf16*)carve(128);
    if (off > ws_size) { fprintf(stderr, "kernel_launch: workspace too small: need %zu, have %zu\n", off, ws_size); return; }
    p.flags = 0; p.ph_lo = 0; p.ph_hi = mk::NPH; p.li = 0;
    if (hipMemsetAsync(wsb, 0, 1 * MiB, stream) != hipSuccess) return;
    hipLaunchKernelGGL(mk::mega, dim3(g_grid), dim3(mk::NTHR), mk::LDS_BYTES, stream, p);
}
```

```cpp
#include <hip/hip_runtime.h>
#include <hip/hip_bf16.h>
#include <cstdio>
#include <cstdint>
#include <cmath>
#define GAS __attribute__((address_space(1)))
#define LAS __attribute__((address_space(3)))
typedef unsigned short bf16;
typedef unsigned v4u __attribute__((ext_vector_type(4)));
typedef float f32x4 __attribute__((ext_vector_type(4)));
typedef short bf16x8 __attribute__((ext_vector_type(8)));
typedef GAS unsigned gu32;
typedef GAS unsigned long long gu64;
#define RLX_AGENT __ATOMIC_RELAXED, __HIP_MEMORY_SCOPE_AGENT
#define LDS_WAIT() asm volatile("s_waitcnt lgkmcnt(0)" ::: "memory")
#define VM_WAIT() asm volatile("s_waitcnt vmcnt(0)" ::: "memory")
__device__ __forceinline__ unsigned long long rt() { return __builtin_amdgcn_s_memrealtime(); }
__device__ __forceinline__ unsigned f2bf(float f) { unsigned u = __builtin_bit_cast(unsigned, f); return (u + 0x7fffu + ((u >> 16) & 1u)) >> 16; }
__device__ __forceinline__ unsigned pk2(float lo, float hi) { return f2bf(lo) | (f2bf(hi) << 16); }

#define XB_TMO      128
#define XB_XCNT(j)  (256  + 64 * (j))
#define XB_XSUB(j)  (1280 + 64 * (j))
#define XB_XGEN(j)  (2304 + 64 * (j))
#define XB_TOP      3328
#define XB_TOPGEN   3392
#define XCD_BAR_WORDS 3456
#define XB_SPIN_CAP (1u << 18)

__device__ __forceinline__ unsigned xb_ld(unsigned* p)              { return __hip_atomic_load(p, __ATOMIC_RELAXED, __HIP_MEMORY_SCOPE_AGENT); }
__device__ __forceinline__ unsigned xb_add(unsigned* p, unsigned v) { return __hip_atomic_fetch_add(p, v, __ATOMIC_RELAXED, __HIP_MEMORY_SCOPE_AGENT); }
__device__ __forceinline__ unsigned xb_xcc_id() { return (unsigned)__builtin_amdgcn_s_getreg((3 << 11) | 20) & 0xFu; }
#define XB_SPIN(cond, bar) do { unsigned _sp = 0; while (cond) { __builtin_amdgcn_s_sleep(1); \
    if ((++_sp & 255u) == 0u) { if (xb_ld(&(bar)[XB_TMO])) break; if (_sp > XB_SPIN_CAP) { atomicAdd(&(bar)[XB_TMO], 1u); break; } } } } while (0)

struct XcdBarrier {
    unsigned* bar; unsigned x;
    volatile LAS unsigned* st;
};

__device__ __forceinline__ XcdBarrier xcd_barrier_post(unsigned* bar, volatile LAS unsigned* st) {
    XcdBarrier b; b.bar = bar; b.x = xb_xcc_id(); b.st = st;
    if (threadIdx.x == 0) (void)xb_add(&bar[XB_XCNT(b.x)], 1u);
    return b;
}
__device__ __forceinline__ void xcd_barrier_complete(unsigned* bar, unsigned x, unsigned& nloc, unsigned& nx) {
    const unsigned G = gridDim.x * gridDim.y * gridDim.z;
    unsigned sum, cnt, mine, sp = 0u;
    for (;;) {
        sum = 0u; cnt = 0u; mine = 0u;
#pragma unroll
        for (unsigned j = 0; j < 16; ++j) { const unsigned c = xb_ld(&bar[XB_XCNT(j)]); sum += c; cnt += (c > 0u) ? 1u : 0u; mine = (j == x) ? c : mine; }
        if (sum == G) break;
        __builtin_amdgcn_s_sleep(1);
        if ((++sp & 255u) == 0u) { if (xb_ld(&bar[XB_TMO])) break; if (sp > XB_SPIN_CAP) { atomicAdd(&bar[XB_TMO], 1u); break; } }
    }
    nloc = mine > 0u ? mine : 1u; nx = cnt > 0u ? cnt : 1u;
}

__device__ __forceinline__ void xcd_barrier(const XcdBarrier& b) {
    asm volatile("s_waitcnt vmcnt(0)" ::: "memory");
    __syncthreads();
    if (threadIdx.x == 0) {
        unsigned* bar = b.bar;
        __builtin_amdgcn_s_waitcnt(0);
        unsigned nloc = b.st[0], nx = b.st[1];
        if (nloc == 0u) { xcd_barrier_complete(bar, b.x, nloc, nx); b.st[0] = nloc; b.st[1] = nx; }
        const unsigned old = xb_add(&bar[XB_XSUB(b.x)], 1u);
        const unsigned gen = old / nloc;
        if (old + 1u == (gen + 1u) * nloc) {
            __builtin_amdgcn_fence(__ATOMIC_RELEASE, "agent");
            asm volatile("s_waitcnt vmcnt(0)" ::: "memory");
            const unsigned og = xb_add(&bar[XB_TOP], 1u);
            const unsigned tg = og / nx;
            if (og + 1u == (tg + 1u) * nx) xb_add(&bar[XB_TOPGEN], 1u);
            else XB_SPIN(xb_ld(&bar[XB_TOPGEN]) == tg, bar);
            __builtin_amdgcn_fence(__ATOMIC_ACQUIRE, "agent");
            xb_add(&bar[XB_XGEN(b.x)], 1u);
            asm volatile("s_waitcnt vmcnt(0)" ::: "memory");
        } else {
            XB_SPIN(xb_ld(&bar[XB_XGEN(b.x)]) == gen, bar);
            __builtin_amdgcn_fence(__ATOMIC_ACQUIRE, "agent");
            asm volatile("s_waitcnt vmcnt(0)" ::: "memory");
        }
    }
    __syncthreads();
}


namespace pg8 {
#define PG8_LAS __attribute__((address_space(3)))
typedef unsigned short bf16_t;
typedef short bf16x8 __attribute__((ext_vector_type(8)));
typedef float f32x4 __attribute__((ext_vector_type(4)));
typedef unsigned u32x4 __attribute__((ext_vector_type(4)));
typedef unsigned u32x2 __attribute__((ext_vector_type(2)));
constexpr int BM = 256, BK = 64, HALF = 128, HTB = HALF * BK * 2  , STAGE_BYTES = 8 * HTB, NXCD = 8, WGM = 8;

__host__ __device__ __forceinline__ int lds_byte(int r, int c) { const int st = (r >> 4) * 2 + (c >> 5), rr = r & 15, cc = c & 31, ob = rr * 64 + cc * 2; return st * 1024 + (ob ^ (((ob >> 9) & 1) << 5)); }
__host__ __device__ __forceinline__ void stage_rc(int b, int& R, int& C) { const int st = b / 1024, sb = b % 1024, swz = sb ^ (((sb >> 9) & 1) << 5); R = (st >> 1) * 16 + swz / 64; C = (st & 1) * 32 + (swz % 64) / 2; }
__host__ __device__ __forceinline__ int perm32(int rho) { const int n = rho >> 4, i = rho & 15; return 8 * (i >> 2) + 4 * n + (i & 3); }

struct Unit { int pm, pn, e, ui; };
struct Gemm { const bf16_t* A; int K; };

struct StaticOrder {
    int nM, nN, nwg, G, c, lda; const bf16_t* Bt; int K;
    __device__ void init(int M, int N, int K_, int lda_, const bf16_t* Bt_, int G_, int c_) { nM = M / BM; nN = N / BM; nwg = nM * nN; G = G_; c = c_; lda = lda_; Bt = Bt_; K = K_; }
    __device__ bool next(int i, Unit& u) const {
        const long L = (long)i * G + c; if (L >= nwg) return false;
        int wgid = (int)L; { const int q = nwg / NXCD, r = nwg % NXCD, xcd = wgid % NXCD, off = wgid / NXCD; wgid = (xcd < r ? xcd * (q + 1) : r * (q + 1) + (xcd - r) * q) + off; }
        const int nig = WGM * nN, gid = wgid / nig, fm = gid * WGM;
        u.pm = fm + ((wgid % nig) % WGM); u.pn = (wgid % nig) / WGM; u.e = 0; u.ui = i; return true;
    }
    __device__ __forceinline__ unsigned a_off(const Unit& u, int r, int C) const { return (unsigned)(((size_t)(u.pm * BM + r) * lda + C) * 2u); }
    __device__ __forceinline__ const char* b_base(const Unit& u) const { return (const char*)Bt + (size_t)u.pn * BM * K * 2; }
    __device__ __forceinline__ void a_ready(const Unit&) const {}
    __device__ __forceinline__ void done(const Unit&) const {}
};

typedef int v8i_t __attribute__((ext_vector_type(8))); typedef int v4i_t __attribute__((ext_vector_type(4)));
__device__ __forceinline__ v8i_t cat8(bf16x8 a, bf16x8 b) { const v4i_t x = __builtin_bit_cast(v4i_t, a), y = __builtin_bit_cast(v4i_t, b); return __builtin_shufflevector(x, y, 0, 1, 2, 3, 4, 5, 6, 7); }
__device__ __forceinline__ unsigned cvt_pk_bf16(float lo, float hi) { unsigned r; asm volatile("v_cvt_pk_bf16_f32 %0, %1, %2" : "=v"(r) : "v"(lo), "v"(hi)); return r; }

template <class Epi, class Sched, bool ALIGN_EPI = true, bool FP8 = false>
__device__ __forceinline__ void gemm_phase(PG8_LAS unsigned char* lds, const Gemm g, const Sched& S, const Epi& E, const int tid) {
    const int wid = __builtin_amdgcn_readfirstlane(tid >> 6), lane = tid & 63, wr = wid >> 2, wc = wid & 3, fr = lane & 15, fq = lane >> 4;
    const int K = g.K, nt = K / BK;
    unsigned voffB[2];
#pragma unroll
    for (int i = 0; i < 2; ++i) { int R, C; stage_rc(tid * 16 + i * 8192, R, C); const int Rb = Epi::PERM ? ((R & ~31) + perm32(R & 31)) : R; voffB[i] = (unsigned)(Rb * K + C) * 2u; }
#define PG8_AOFF(dst, unit) do { _Pragma("unroll") for (int _i = 0; _i < 2; ++_i) { int _R, _C; stage_rc(tid * 16 + _i * 8192, _R, _C); dst[0][_i] = S.a_off(unit, _R, _C); dst[1][_i] = S.a_off(unit, HALF + _R, _C); } } while (0)
    const size_t kstep = (size_t)(BK * 2);
    const size_t hstepB = (size_t)HALF * K * 2;
    const unsigned ldsw = (unsigned)wid * 1024u;
    const int aoff = lds_byte(wr * 64 + fr, fq * 8), boff = lds_byte(wc * 32 + fr, fq * 8);
#define PG8_SA(b, h) (((b) * 2 + (h)) * HTB)
#define PG8_SB(b, h) ((4 + (b) * 2 + (h)) * HTB)
#define PG8_STAGE(bufoff, gbase, voff) do { _Pragma("unroll") for (int _i = 0; _i < 2; ++_i) { unsigned _o = (voff)[_i]; asm volatile("" : "+v"(_o));     \
        __builtin_amdgcn_global_load_lds((const unsigned*)((const char*)(gbase) + _o), (PG8_LAS unsigned*)(lds + (bufoff) + ldsw + _i * 8192), 16, 0, 0); } } while (0)
#define PG8_LDA(dst, b, h) do { _Pragma("unroll") for (int m = 0; m < 4; ++m) { const v4i_t _lo = *(const PG8_LAS v4i_t*)(lds + PG8_SA(b, h) + aoff + m * 2048), _hi = *(const PG8_LAS v4i_t*)(lds + PG8_SA(b, h) + aoff + m * 2048 + 1024); \
        dst[m] = __builtin_shufflevector(_lo, _hi, 0, 1, 2, 3, 4, 5, 6, 7); } } while (0)
#define PG8_LDB(dst, b, h) do { _Pragma("unroll") for (int n = 0; n < 2; ++n) { const v4i_t _lo = *(const PG8_LAS v4i_t*)(lds + PG8_SB(b, h) + boff + n * 2048), _hi = *(const PG8_LAS v4i_t*)(lds + PG8_SB(b, h) + boff + n * 2048 + 1024); \
        dst[n] = __builtin_shufflevector(_lo, _hi, 0, 1, 2, 3, 4, 5, 6, 7); } } while (0)
#define PG8_LO(v) __builtin_bit_cast(bf16x8, __builtin_shufflevector(v, v, 0, 1, 2, 3))
#define PG8_HI(v) __builtin_bit_cast(bf16x8, __builtin_shufflevector(v, v, 4, 5, 6, 7))
#define PG8_MMA(ai, bj, At, Bt) do { __builtin_amdgcn_s_setprio(1); \
        if constexpr (FP8) { _Pragma("unroll") for (int m = 0; m < 4; ++m) _Pragma("unroll") for (int n = 0; n < 2; ++n) \
            asm volatile("v_mfma_scale_f32_16x16x128_f8f6f4 %0, %1, %2, %0, %3, %3 op_sel_hi:[0,0,0]" : "+v"(acc[ai][bj][m][n]) : "v"(Bt[n]), "v"(At[m]), "v"(sc1)); } \
        else { _Pragma("unroll") for (int m = 0; m < 4; ++m) _Pragma("unroll") for (int n = 0; n < 2; ++n) { \
            acc[ai][bj][m][n] = __builtin_amdgcn_mfma_f32_16x16x32_bf16(PG8_LO(Bt[n]), PG8_LO(At[m]), acc[ai][bj][m][n], 0, 0, 0); \
            acc[ai][bj][m][n] = __builtin_amdgcn_mfma_f32_16x16x32_bf16(PG8_HI(Bt[n]), PG8_HI(At[m]), acc[ai][bj][m][n], 0, 0, 0); } } \
        __builtin_amdgcn_s_setprio(0); } while (0)
#define PG8_WAIT_V(n) asm volatile("s_waitcnt vmcnt(" #n ")" ::: "memory")
#define PG8_WAIT_L(n) asm volatile("s_waitcnt lgkmcnt(" #n ")" ::: "memory")
#define PG8_BAR __builtin_amdgcn_s_barrier()
#define PG8_SCHED __builtin_amdgcn_sched_barrier(0)
    Unit cur, nxt; int ui = 0;
    if (!S.next(0, cur)) return;
    f32x4 acc[2][2][4][2];
    int sc1 = 0x7F7F7F7F; asm volatile("" : "+v"(sc1));
    typename Epi::Pre pre{};
    v8i_t At[4], B0[2], B1[2];
    const char* const Ab = (const char*)g.A;
    unsigned aoc[2][2];
    PG8_AOFF(aoc, cur);
    const char* cB = S.b_base(cur);
    S.a_ready(cur);
    PG8_STAGE(PG8_SB(0, 0), cB, voffB); PG8_STAGE(PG8_SB(0, 1), cB + hstepB, voffB); PG8_STAGE(PG8_SA(0, 0), Ab, aoc[0]); PG8_STAGE(PG8_SA(0, 1), Ab, aoc[1]);
    if (wr == 1) PG8_BAR;
    PG8_WAIT_V(2); PG8_BAR;
    PG8_STAGE(PG8_SB(1, 0), cB + kstep, voffB); PG8_STAGE(PG8_SA(1, 0), Ab + kstep, aoc[0]); PG8_STAGE(PG8_SB(1, 1), cB + hstepB + kstep, voffB);
    PG8_WAIT_V(6); PG8_BAR;
#pragma unroll
    for (int a = 0; a < 2; ++a)
#pragma unroll
        for (int b = 0; b < 2; ++b)
#pragma unroll
            for (int m = 0; m < 4; ++m)
#pragma unroll
                for (int n = 0; n < 2; ++n) acc[a][b][m][n] = (f32x4){0.f, 0.f, 0.f, 0.f};
    for (;;) {
        const bool has_next = S.next(ui + 1, nxt);
        const char* nB = has_next ? S.b_base(nxt) : cB;
        int t = 0;
#pragma unroll 1
        for (int seg = 0; seg < (Epi::MID_T >= 0 ? 2 : 1); ++seg) {
        const int tend = (Epi::MID_T >= 0 && seg == 0) ? Epi::MID_T : nt;
#pragma unroll 1
        for (; t < tend; t += 2) {
            const bool last = (t == nt - 2);
            if (last) pre = E.pre(cur, wr, wc, fr, fq);
            const char* a1 = Ab + (size_t)(t + 1) * kstep;
            const char* a2 = last ? Ab : Ab + (size_t)(t + 2) * kstep; const char* b2 = last ? nB : cB + (size_t)(t + 2) * kstep;
            const char* a3 = a2 + kstep; const char* b3 = b2 + kstep;
            unsigned o2[2][2];
#pragma unroll
            for (int h = 0; h < 2; ++h)
#pragma unroll
                for (int i = 0; i < 2; ++i) o2[h][i] = aoc[h][i];
            if (last && has_next) PG8_AOFF(o2, nxt);
            if (last && has_next) S.a_ready(nxt);
            PG8_LDB(B0, 0, 0); PG8_LDB(B1, 0, 1); PG8_SCHED; PG8_LDA(At, 0, 0); PG8_STAGE(PG8_SA(1, 1), a1, aoc[1]);
            PG8_WAIT_V(8); PG8_WAIT_L(0); PG8_BAR; PG8_MMA(0, 0, At, B0); PG8_MMA(0, 1, At, B1); PG8_BAR; PG8_SCHED;
            PG8_LDA(At, 0, 1); PG8_STAGE(PG8_SB(0, 0), b2, voffB); PG8_STAGE(PG8_SB(0, 1), b2 + hstepB, voffB); PG8_STAGE(PG8_SA(0, 0), a2, o2[0]);
            PG8_WAIT_V(8); PG8_WAIT_L(0); PG8_BAR; PG8_MMA(1, 0, At, B0); PG8_MMA(1, 1, At, B1); PG8_BAR; PG8_SCHED;
            PG8_LDB(B0, 1, 0); PG8_LDB(B1, 1, 1); PG8_SCHED; PG8_LDA(At, 1, 0); PG8_STAGE(PG8_SA(0, 1), a2, o2[1]);
            PG8_WAIT_V(8); PG8_WAIT_L(0); PG8_BAR; PG8_MMA(0, 0, At, B0); PG8_MMA(0, 1, At, B1); PG8_BAR; PG8_SCHED;
            PG8_LDA(At, 1, 1); PG8_STAGE(PG8_SB(1, 0), b3, voffB); PG8_STAGE(PG8_SB(1, 1), b3 + hstepB, voffB); PG8_STAGE(PG8_SA(1, 0), a3, o2[0]);
            PG8_WAIT_V(8); PG8_WAIT_L(0); PG8_BAR; PG8_MMA(1, 0, At, B0); PG8_MMA(1, 1, At, B1); PG8_BAR; PG8_SCHED;
        }
        if (Epi::MID_T >= 0) { if (seg == 0) E.mid(acc, cur, wr, wc, fr, fq); }
        }
        if constexpr (FP8) asm volatile("s_nop 15\n\ts_nop 7" ::: "memory");
        if constexpr (ALIGN_EPI) { if (wr == 0) PG8_BAR; }
        cur.pm = __builtin_amdgcn_readfirstlane(cur.pm); cur.pn = __builtin_amdgcn_readfirstlane(cur.pn); cur.e = __builtin_amdgcn_readfirstlane(cur.e); cur.ui = __builtin_amdgcn_readfirstlane(cur.ui);
        asm volatile("" : "+s"(cur.pm), "+s"(cur.pn), "+s"(cur.e), "+s"(cur.ui));
        { int t_ = tid; asm volatile("" : "+v"(t_)); const int fr_ = t_ & 15, fq_ = (t_ & 63) >> 4;
          E(acc, cur, wr, wc, fr_, fq_, pre); } S.done(cur);
        if (!has_next) break;
#pragma unroll
        for (int a = 0; a < 2; ++a)
#pragma unroll
            for (int b = 0; b < 2; ++b)
#pragma unroll
                for (int m = 0; m < 4; ++m)
#pragma unroll
                    for (int n = 0; n < 2; ++n) acc[a][b][m][n] = (f32x4){0.f, 0.f, 0.f, 0.f};
        cur = nxt; cB = nB; ++ui;
        PG8_AOFF(aoc, cur);
        if constexpr (ALIGN_EPI) { if (wr == 1) PG8_BAR; }
    }
    PG8_WAIT_V(0);
    if constexpr (!ALIGN_EPI) { if (wr == 0) PG8_BAR; }
    PG8_BAR;
#undef PG8_AOFF
#undef PG8_SA
#undef PG8_SB
#undef PG8_STAGE
#undef PG8_LDA
#undef PG8_LDB
#undef PG8_MMA
#undef PG8_LO
#undef PG8_HI
#undef PG8_WAIT_V
#undef PG8_WAIT_L
#undef PG8_BAR
#undef PG8_SCHED
}
}

namespace mk {
constexpr int T = 16384, D = 1024, SEQ = 2048, NB = 8, INW = 5632, NE = 32, DFF = 1024, NMOD = 6144;
constexpr int NW = 8, NTHR = 512;
constexpr float EPS = 1e-6f;
constexpr float W8_SCALE = 64.f, A8_SCALE = 8.f, MOE_DESCALE = 1.f / 512.f;
constexpr float C2 = 0.18033688011112042f;
constexpr int LDS_BYTES = 155648;
constexpr int RING_OFF = 0, TAB_OFF = 131072, MISC_OFF = 155648 - 256;

struct Params {
    const GAS float *x, *c; const GAS int* pos;
    const GAS float *w_mod, *b_mod, *g_pre_mix, *w_in, *lq1, *lk1, *lq2, *lk2, *g_sub, *w_pg, *pool_scale, *w_att, *w_pb, *w_out, *g_post_mix, *g_pre_ffn, *w_router, *b_router, *w_gu, *b_gu, *w_dn, *b_dn, *g_post_ffn;
    GAS float* out;
    GAS unsigned* ctl; GAS float* modp; GAS float* rope;
    GAS bf16 *Wt_in, *Wt_mix, *Wt_out, *Wt_pg, *Wt_gu, *Wt_dn;
    GAS bf16 *U, *QKV, *PB, *GR, *SGP, *AM, *MERGED, *MIXOUT, *ACT, *Y;
    GAS float* prob; GAS int* lists;
    int ph_lo, ph_hi, li, flags;
};
#define P_x ((const float*)p.x)
#define P_c ((const float*)p.c)
#define P_w_mod ((const float*)p.w_mod)
#define P_b_mod ((const float*)p.b_mod)
#define P_g_pre_mix ((const float*)p.g_pre_mix)
#define P_w_in ((const float*)p.w_in)
#define P_lq1 ((const float*)p.lq1)
#define P_lk1 ((const float*)p.lk1)
#define P_lq2 ((const float*)p.lq2)
#define P_lk2 ((const float*)p.lk2)
#define P_g_sub ((const float*)p.g_sub)
#define P_w_pg ((const float*)p.w_pg)
#define P_pool_scale ((const float*)p.pool_scale)
#define P_w_att ((const float*)p.w_att)
#define P_w_pb ((const float*)p.w_pb)
#define P_w_out ((const float*)p.w_out)
#define P_g_post_mix ((const float*)p.g_post_mix)
#define P_g_pre_ffn ((const float*)p.g_pre_ffn)
#define P_w_router ((const float*)p.w_router)
#define P_b_router ((const float*)p.b_router)
#define P_w_gu ((const float*)p.w_gu)
#define P_b_gu ((const float*)p.b_gu)
#define P_w_dn ((const float*)p.w_dn)
#define P_b_dn ((const float*)p.b_dn)
#define P_g_post_ffn ((const float*)p.g_post_ffn)
#define P_pos ((const int*)p.pos)
#define P_out ((float*)p.out)
#define P_ctl ((unsigned*)p.ctl)
#define P_modp ((float*)p.modp)
#define P_rope ((float*)p.rope)
#define P_prob ((float*)p.prob)
#define P_lists ((int*)p.lists)
#define P_Wt_in ((bf16*)p.Wt_in)
#define P_Wt_mix ((bf16*)p.Wt_mix)
#define P_Wt_out ((bf16*)p.Wt_out)
#define P_Wt_pg ((bf16*)p.Wt_pg)
#define P_Wt_gu ((bf16*)p.Wt_gu)
#define P_Wt_dn ((bf16*)p.Wt_dn)
#define P_U ((bf16*)p.U)
#define P_QKV ((bf16*)p.QKV)
#define P_PB ((bf16*)p.PB)
#define P_GR ((bf16*)p.GR)
#define P_SGP ((bf16*)p.SGP)
#define P_AM ((bf16*)p.AM)
#define P_MERGED ((bf16*)p.MERGED)
#define P_MIXOUT ((bf16*)p.MIXOUT)
#define P_ACT ((bf16*)p.ACT)
#define P_Y ((bf16*)p.Y)
constexpr int CW_TMO = 0, CW_CNT = 64  , CW_BAR = 4096  ;

__device__ __forceinline__ float wave_sum(float v) {
#pragma unroll
    for (int o = 1; o < 64; o <<= 1) v += __shfl_xor(v, o);
    return v;
}
__device__ __forceinline__ void tr_item(const float* W, int ldw, int k0, int n0, bf16* WT, int ldt, int drow0, int kcol0, LAS float* scr, int lane) {
#pragma unroll 8
    for (int i = 0; i < 32; ++i) { const int kk = 2 * i + (lane >> 5); scr[kk * 33 + (lane & 31)] = __builtin_nontemporal_load(&W[(size_t)(k0 + kk) * ldw + n0 + (lane & 31)]); }
    LDS_WAIT(); asm volatile("" ::: "memory");
    const int c = lane & 7;
#pragma unroll
    for (int j = 0; j < 4; ++j) { const int n = (lane >> 3) + 8 * j; const LAS float* s = scr + (8 * c) * 33 + n;
        v4u o; o.x = pk2(s[0 * 33], s[1 * 33]); o.y = pk2(s[2 * 33], s[3 * 33]); o.z = pk2(s[4 * 33], s[5 * 33]); o.w = pk2(s[6 * 33], s[7 * 33]);
        *(GAS v4u*)(WT + (size_t)(drow0 + n) * ldt + kcol0 + k0 + 8 * c) = o; }
    LDS_WAIT(); asm volatile("" ::: "memory");
}
__device__ __forceinline__ unsigned pk4_fp8(float a, float b, float c, float d) {
    a = fminf(fmaxf(a, -448.f), 448.f); b = fminf(fmaxf(b, -448.f), 448.f); c = fminf(fmaxf(c, -448.f), 448.f); d = fminf(fmaxf(d, -448.f), 448.f);
    int w = __builtin_amdgcn_cvt_pk_fp8_f32(a, b, 0, false); w = __builtin_amdgcn_cvt_pk_fp8_f32(c, d, w, true); return (unsigned)w; }
__device__ __forceinline__ void tr_item8(const float* W, int ldw, int k0, int n0, unsigned char* WT, int ldt, int drow0, LAS float* scr, int lane, float scale) {
#pragma unroll 8
    for (int i = 0; i < 64; ++i) { const int kk = 2 * i + (lane >> 5); scr[kk * 33 + (lane & 31)] = __builtin_nontemporal_load(&W[(size_t)(k0 + kk) * ldw + n0 + (lane & 31)]); }
    LDS_WAIT(); asm volatile("" ::: "memory");
    const int c = lane & 7;
#pragma unroll
    for (int j = 0; j < 4; ++j) { const int n = (lane >> 3) + 8 * j; const LAS float* s = scr + (16 * c) * 33 + n;
        v4u o; o.x = pk4_fp8(s[0 * 33] * scale, s[1 * 33] * scale, s[2 * 33] * scale, s[3 * 33] * scale); o.y = pk4_fp8(s[4 * 33] * scale, s[5 * 33] * scale, s[6 * 33] * scale, s[7 * 33] * scale);
        o.z = pk4_fp8(s[8 * 33] * scale, s[9 * 33] * scale, s[10 * 33] * scale, s[11 * 33] * scale); o.w = pk4_fp8(s[12 * 33] * scale, s[13 * 33] * scale, s[14 * 33] * scale, s[15 * 33] * scale);
        *(GAS v4u*)(WT + (size_t)(drow0 + n) * ldt + k0 + 16 * c) = o; }
    LDS_WAIT(); asm volatile("" ::: "memory");
}
__device__ __forceinline__ int ilv_row(int n, int H) { const int w = n >= H ? 1 : 0, c = n - w * H; return 256 * (c >> 7) + 128 * w + (c & 127); }

__device__ __forceinline__ void p0_prologue(const Params& p, LAS unsigned char* lds, int tid, int wave, int lane, int vcu, int G) {
    LAS float* sc = (LAS float*)lds;
    for (int i = tid; i < NB * D; i += NTHR) { const float cv = P_c[i]; sc[i] = cv / (1.f + expf(-cv)); }
    __syncthreads();
    const int gw = vcu * NW + wave, NGW = G * NW;
    for (int task = (wave < 3 ? vcu * 3 + wave : 96 * 8); task < 96 * 8; task += G * 3) {
        const int cg = task >> 3, ks = task & 7, col = cg * 64 + lane;
        float acc[NB];
#pragma unroll
        for (int b = 0; b < NB; ++b) acc[b] = 0.f;
#pragma unroll 4
        for (int k = ks * 128; k < ks * 128 + 128; ++k) { const float wv = __builtin_nontemporal_load(&P_w_mod[(size_t)k * NMOD + col]);
#pragma unroll
            for (int b = 0; b < NB; ++b) acc[b] += sc[b * D + k] * wv; }
#pragma unroll
        for (int b = 0; b < NB; ++b) P_modp[(size_t)(ks * NB + b) * NMOD + col] = acc[b];
    }
    __syncthreads();
    LAS float* scr = (LAS float*)(lds + wave * 17408);
    constexpr int I1 = 16 * 176, I2 = 16 * 32, I3 = 8 * 32, I4 = 16 * 32, I5 = 32, I6E = 8 * 64, I7E = 8 * 32;
    const int nitems = (p.flags & 1) ? (I1 + I2 + I3 + I4 + I5) : (I1 + I2 + I3 + I4 + I5 + NE * I6E + NE * I7E);
    for (int it = gw; it < nitems; it += NGW) {
        int r = it;
        if (r < I1) { const int kb = r / 176, nb = r % 176, n0 = nb * 32; const int dr = n0 < 3584 ? n0 : 3584 + ilv_row(n0 - 3584, 1024);
            tr_item(P_w_in, INW, kb * 64, n0, P_Wt_in, D, dr, 0, scr, lane); continue; } r -= I1;
        if (r < I2) { const int kb = r / 32, nb = r % 32; tr_item(P_w_att, D, kb * 64, nb * 32, P_Wt_mix, 1536, nb * 32, 0, scr, lane); continue; } r -= I2;
        if (r < I3) { const int kb = r / 32, nb = r % 32; tr_item(P_w_pb, D, kb * 64, nb * 32, P_Wt_mix, 1536, nb * 32, 1024, scr, lane); continue; } r -= I3;
        if (r < I4) { const int kb = r / 32, nb = r % 32; tr_item(P_w_out, D, kb * 64, nb * 32, P_Wt_out, D, nb * 32, 0, scr, lane); continue; } r -= I4;
        if (r < I5) { const int g = r >> 3, q = r & 7, kb = q >> 2, nb = q & 3; tr_item(P_w_pg + (size_t)g * 128 * 128, 128, kb * 64, nb * 32, P_Wt_pg + (size_t)g * 128 * 128, 128, nb * 32, 0, scr, lane); continue; } r -= I5;
        if (r < NE * I6E) { const int e = r / I6E, q = r % I6E, kb = q / 64, nb = q % 64, n0 = nb * 32;
            tr_item8(P_w_gu + (size_t)e * D * 2 * DFF, 2 * DFF, kb * 128, n0, (unsigned char*)P_Wt_gu + (size_t)e * 2 * DFF * D, D, ilv_row(n0, DFF), scr, lane, W8_SCALE); continue; } r -= NE * I6E;
        { const int e = r / I7E, q = r % I7E, kb = q / 32, nb = q % 32; tr_item8(P_w_dn + (size_t)e * DFF * D, D, kb * 128, nb * 32, (unsigned char*)P_Wt_dn + (size_t)e * D * DFF, DFF, nb * 32, scr, lane, W8_SCALE); }
    }
}
__device__ __forceinline__ double rope_invf(int i) {
    return i == 0 ? 1.0 : i == 1 ? 0.19392274474868576 : i == 2 ? 0.03760603093086393 : i == 3 ? 0.007292664737217109 : i == 4 ? 0.001414213562373095 : i == 5 ? 0.0002742481756762073 : i == 6 ? 5.318295896944988e-05 : 1.031338537721246e-05;
}
__device__ __forceinline__ f32x4 mod4(const Params& p, int b, int off, int k) {
    const float* base = P_modp + (size_t)b * NMOD + off + k;
    f32x4 t[9]; t[8] = *(const f32x4*)(P_b_mod + off + k);
#pragma unroll
    for (int ks = 0; ks < 8; ++ks) t[ks] = *(const f32x4*)(base + (size_t)ks * NB * NMOD);
    asm volatile("" : "+v"(t[0]), "+v"(t[1]), "+v"(t[2]), "+v"(t[3]), "+v"(t[4]), "+v"(t[5]), "+v"(t[6]), "+v"(t[7]), "+v"(t[8]));
    return t[8] + (((t[0] + t[1]) + (t[2] + t[3])) + ((t[4] + t[5]) + (t[6] + t[7])));
}
constexpr int MODF_OFF = 8 * NB * NMOD;
__device__ __forceinline__ void p1_rows(const Params& p, LAS unsigned char* lds, int tid, int wave, int lane, int vcu, int G) {
    LAS float* av = (LAS float*)lds; LAS float* sv = av + D;
    for (int grp = vcu; grp < T / 64; grp += G) {
        const int row0 = grp * 64 + wave * 8, b = row0 / SEQ;
        __syncthreads();
        { const int k = 4 * (tid & 255);
          if (tid < 256) *(LAS f32x4*)(av + k) = *(const f32x4*)(P_g_pre_mix + k) * (1.f + mod4(p, b, 1024, k)); else *(LAS f32x4*)(sv + k) = mod4(p, b, 0, k);
          if ((grp & 31) == 0) {
#pragma unroll
              for (int q = 0; q < 2; ++q) { const int vi = (tid >> 8) * 2 + q; const int off = vi == 0 ? 2048 : vi == 1 ? 3072 : vi == 2 ? 4096 : 5120;
                  *(f32x4*)(P_modp + MODF_OFF + (size_t)(b * 4 + vi) * D + k) = mod4(p, b, off, k); } } }
        __syncthreads();
        f32x4 a[4], sh[4];
#pragma unroll
        for (int j = 0; j < 4; ++j) { const int k = 4 * lane + 256 * j; a[j] = *(const LAS f32x4*)(av + k); sh[j] = *(const LAS f32x4*)(sv + k); }
#pragma unroll 1
        for (int rb = 0; rb < 8; rb += 4) {
            f32x4 v[4][4]; float ss[4];
#pragma unroll
            for (int r = 0; r < 4; ++r) { const GAS f32x4* xr = (const GAS f32x4*)(P_x + (size_t)(row0 + rb + r) * D) + lane;
#pragma unroll
                for (int j = 0; j < 4; ++j) v[r][j] = __builtin_nontemporal_load(xr + 64 * j); }
#pragma unroll
            for (int r = 0; r < 4; ++r) { float s = 0.f;
#pragma unroll
                for (int j = 0; j < 4; ++j) s += (v[r][j].x * v[r][j].x + v[r][j].y * v[r][j].y) + (v[r][j].z * v[r][j].z + v[r][j].w * v[r][j].w);
                ss[r] = s; }
#pragma unroll
            for (int o = 1; o < 64; o <<= 1) {
#pragma unroll
                for (int r = 0; r < 4; ++r) ss[r] += __shfl_xor(ss[r], o); }
#pragma unroll
            for (int r = 0; r < 4; ++r) { const int m = row0 + rb + r; const float rstd = 1.f / sqrtf(ss[r] * (1.f / D) + EPS);
                GAS unsigned long long* o8 = (GAS unsigned long long*)(P_U + (size_t)m * D) + lane;
#pragma unroll
                for (int j = 0; j < 4; ++j) { const f32x4 u = v[r][j] * rstd * a[j] + sh[j]; o8[64 * j] = (unsigned long long)pk2(u.x, u.y) | ((unsigned long long)pk2(u.z, u.w) << 32); } }
        }
        if (lane < 8) {
            const double invf = rope_invf(lane);
#pragma unroll 1
            for (int r = 0; r < 8; ++r) { const int m = row0 + r; const double ang = (double)P_pos[m] * invf; const double kk = __builtin_rint(ang * 0.15915494309189535);
                const float rr = (float)(ang - kk * 6.283185307179586); P_rope[(size_t)m * 16 + lane] = cosf(rr); P_rope[(size_t)m * 16 + 8 + lane] = sinf(rr); }
        }
    }
}
struct EpiZ {
    static constexpr bool PERM = true; static constexpr int MID_T = -1;
    bf16 *QKV, *PB, *GR, *SGP; const float* rope;
    struct Pre {}; __device__ __forceinline__ Pre pre(const pg8::Unit&, int, int, int, int) const { return Pre{}; }
    __device__ __forceinline__ void mid(pg8::f32x4 (&)[2][2][4][2], const pg8::Unit&, int, int, int, int) const {}
    __device__ __forceinline__ void operator()(const pg8::f32x4 (&acc)[2][2][4][2], const pg8::Unit& u, int wr, int wc, int fr, int fq, const Pre&) const {
        const int row0 = u.pm * 256 + wr * 64 + fr, pn = u.pn, cw = wc * 32 + 8 * fq;
        if (pn < 14) {
            const bool rp = pn < 8 && (wc & 1) == 0; const float sc = pn < 4 ? C2 : 1.f;
            bf16* base = pn < 12 ? QKV : PB; const int ld = pn < 12 ? 3072 : 512; const int colt = (pn < 12 ? pn : pn - 12) * 256 + cw;
#pragma unroll
            for (int ai = 0; ai < 2; ++ai)
#pragma unroll
                for (int m = 0; m < 4; ++m) {
                    const int row = row0 + ai * 128 + m * 16;
                    f32x4 c0 = {1.f, 1.f, 1.f, 1.f}, c1 = c0, s0 = {0.f, 0.f, 0.f, 0.f}, s1 = s0;
                    if (rp) { const f32x4* rt = (const f32x4*)(rope + (size_t)row * 16); c0 = rt[0]; c1 = rt[1]; s0 = rt[2]; s1 = rt[3]; }
#pragma unroll
                    for (int bj = 0; bj < 2; ++bj) {
                        f32x4 v0 = acc[ai][bj][m][0], v1 = acc[ai][bj][m][1];
                        if (rp) {
                            f32x4 p0, p1;
#pragma unroll
                            for (int j = 0; j < 4; ++j) { p0[j] = __shfl_xor(v0[j], 16); p1[j] = __shfl_xor(v1[j], 16); }
                            if (fq == 0) { v0 = v0 * c0 - p0 * s0; v1 = v1 * c1 - p1 * s1; }
                            else if (fq == 1) { v0 = v0 * c0 + p0 * s0; v1 = v1 * c1 + p1 * s1; }
                        }
                        v0 = v0 * sc; v1 = v1 * sc;
                        pg8::u32x4 w; w.x = pg8::cvt_pk_bf16(v0[0], v0[1]); w.y = pg8::cvt_pk_bf16(v0[2], v0[3]); w.z = pg8::cvt_pk_bf16(v1[0], v1[1]); w.w = pg8::cvt_pk_bf16(v1[2], v1[3]);
                        *(pg8::u32x4*)(base + (size_t)row * ld + colt + bj * 128) = w;
                    }
                }
        } else {
            const int colt = (pn - 14) * 128 + cw;
#pragma unroll
            for (int ai = 0; ai < 2; ++ai)
#pragma unroll
                for (int m = 0; m < 4; ++m) {
                    const int row = row0 + ai * 128 + m * 16;
                    float r[8], g[8];
#pragma unroll
                    for (int n = 0; n < 2; ++n)
#pragma unroll
                        for (int j = 0; j < 4; ++j) { const float a = fminf(fmaxf(acc[ai][0][m][n][j], -30.f), 30.f), b = fminf(fmaxf(acc[ai][1][m][n][j], -30.f), 30.f);
                            const float ea = __builtin_amdgcn_exp2f(-1.4426950408889634f * a), eb = __builtin_amdgcn_exp2f(-1.4426950408889634f * b); r[n * 4 + j] = (1.f + eb) * __builtin_amdgcn_rcpf(1.f + ea); g[n * 4 + j] = __builtin_amdgcn_rcpf(1.f + eb); }
                    pg8::u32x4 w; w.x = pg8::cvt_pk_bf16(r[0], r[1]); w.y = pg8::cvt_pk_bf16(r[2], r[3]); w.z = pg8::cvt_pk_bf16(r[4], r[5]); w.w = pg8::cvt_pk_bf16(r[6], r[7]);
                    *(pg8::u32x4*)(GR + (size_t)row * D + colt) = w;
                    w.x = pg8::cvt_pk_bf16(g[0], g[1]); w.y = pg8::cvt_pk_bf16(g[2], g[3]); w.z = pg8::cvt_pk_bf16(g[4], g[5]); w.w = pg8::cvt_pk_bf16(g[6], g[7]);
                    *(pg8::u32x4*)(SGP + (size_t)row * D + colt) = w;
                }
        }
    }
};
}

namespace mk {
__device__ __forceinline__ float bf2f(unsigned short v) { return __uint_as_float((unsigned)v << 16); }
__device__ __forceinline__ float lam_value(const Params& p) {
    float d1 = 0.f, d2 = 0.f;
    for (int i = 0; i < 64; ++i) { d1 += P_lq1[i] * P_lk1[i]; d2 += P_lq2[i] * P_lk2[i]; }
    return expf(d1) - expf(d2) + 0.2f;
}
__device__ __forceinline__ void attn_interim(const Params& p, LAS unsigned char* lds, int tid, int vcu, int G) {
    const float lam = lam_value(p);
    const int sub = tid >> 8, t = tid & 255, r = t >> 2, j = t & 3;
    LAS float* Ks1 = (LAS float*)(lds + sub * 65536); LAS float* Ks2 = Ks1 + 4096; LAS float* Vs = Ks2 + 4096;
    for (int it = 0;; ++it) {
        const int pi = vcu + G * it; if (pi >= 1024) break;
        const int cc = pi & 31, c = (it & 1) ? 31 - cc : cc;
        const int bh = 2 * (pi >> 5) + sub, b = bh >> 3, h = bh & 7;
        const size_t m = (size_t)b * SEQ + c * 64 + r;
        float q1[16], q2[16];
#pragma unroll
        for (int i = 0; i < 16; ++i) { q1[i] = bf2f(P_QKV[m * 3072 + (2 * h) * 64 + j * 16 + i]); q2[i] = bf2f(P_QKV[m * 3072 + (2 * h + 1) * 64 + j * 16 + i]); }
        float m1 = -INFINITY, l1 = 0.f, m2 = -INFINITY, l2 = 0.f, a1[32], a2[32];
#pragma unroll
        for (int d = 0; d < 32; ++d) { a1[d] = 0.f; a2[d] = 0.f; }
        for (int kt = 0; kt <= c; ++kt) {
            __syncthreads();
            for (int e = t; e < 64 * 64; e += 256) { const int kr = e >> 6, kc = e & 63; const size_t km = (size_t)b * SEQ + kt * 64 + kr;
                Ks1[e] = bf2f(P_QKV[km * 3072 + 1024 + (2 * h) * 64 + kc]); Ks2[e] = bf2f(P_QKV[km * 3072 + 1024 + (2 * h + 1) * 64 + kc]); }
            for (int e = t; e < 64 * 128; e += 256) { const int kr = e >> 7, kc = e & 127; const size_t km = (size_t)b * SEQ + kt * 64 + kr; Vs[e] = bf2f(P_QKV[km * 3072 + 2048 + h * 128 + kc]); }
            __syncthreads();
            for (int kk = 0; kk < 64; ++kk) {
                float s1 = 0.f, s2 = 0.f;
#pragma unroll
                for (int i = 0; i < 16; ++i) { s1 += q1[i] * Ks1[kk * 64 + j * 16 + i]; s2 += q2[i] * Ks2[kk * 64 + j * 16 + i]; }
                s1 += __shfl_xor(s1, 1); s1 += __shfl_xor(s1, 2); s2 += __shfl_xor(s2, 1); s2 += __shfl_xor(s2, 2);
                { const float mn = fmaxf(m1, s1), al = exp2f(m1 - mn), pp = exp2f(s1 - mn); l1 = l1 * al + pp; m1 = mn;
#pragma unroll
                  for (int d = 0; d < 32; ++d) a1[d] = a1[d] * al + pp * Vs[kk * 128 + j * 32 + d]; }
                { const float mn = fmaxf(m2, s2), al = exp2f(m2 - mn), pp = exp2f(s2 - mn); l2 = l2 * al + pp; m2 = mn;
#pragma unroll
                  for (int d = 0; d < 32; ++d) a2[d] = a2[d] * al + pp * Vs[kk * 128 + j * 32 + d]; }
            }
        }
        float ss = 0.f; const float i1 = 1.f / l1, i2 = lam / l2;
#pragma unroll
        for (int d = 0; d < 32; ++d) { a1[d] = a1[d] * i1 - a2[d] * i2; ss += a1[d] * a1[d]; }
        ss += __shfl_xor(ss, 1); ss += __shfl_xor(ss, 2);
        const float rstd = (1.f / sqrtf(ss * (1.f / 128.f) + EPS)) * 0.8f;
#pragma unroll
        for (int d = 0; d < 32; d += 2) { const float o0 = a1[d] * rstd * P_g_sub[j * 32 + d], o1 = a1[d + 1] * rstd * P_g_sub[j * 32 + d + 1];
            *(unsigned*)(P_AM + m * 1536 + h * 128 + j * 32 + d) = pk2(o0, o1); }
    }
    __syncthreads();
}
__device__ __forceinline__ void pool_phase(const Params& p, LAS unsigned char* lds, int tid, int wave, int lane, int vcu, int G) {
    LAS float* Pf = (LAS float*)lds;
    LAS unsigned short* Mx = (LAS unsigned short*)(lds + 144 * 128 * 4);
    const int fr = lane & 15, fq = lane >> 4;
    for (int unit = vcu; unit < 512; unit += G) {
        const int rt = unit >> 2, g = unit & 3, w = 2 << g, row0 = rt * 128, s0 = row0 & (SEQ - 1);
        for (int ch = tid; ch < 144 * 16; ch += NTHR) { const int r = ch >> 4, c8 = (ch & 15) * 8, tt = s0 - 16 + r;
            v4u raw = {0u, 0u, 0u, 0u};
            if (tt >= 0) raw = *(const GAS v4u*)(P_PB + (size_t)(row0 - 16 + r) * 512 + g * 128 + c8);
            LAS float* d = Pf + r * 128 + c8;
            d[0] = __uint_as_float(raw.x << 16); d[1] = __uint_as_float(raw.x & 0xffff0000u); d[2] = __uint_as_float(raw.y << 16); d[3] = __uint_as_float(raw.y & 0xffff0000u);
            d[4] = __uint_as_float(raw.z << 16); d[5] = __uint_as_float(raw.z & 0xffff0000u); d[6] = __uint_as_float(raw.w << 16); d[7] = __uint_as_float(raw.w & 0xffff0000u); }
        __syncthreads();
        { const int c = tid & 127, rb = (tid >> 7) * 32;
          float ssum = 0.f;
          for (int q = 0; q < w; ++q) ssum += Pf[(rb + 16 - q) * 128 + c];
          for (int i = 0; i < 32; ++i) { const int r = rb + i, s = s0 + r; const int cnt = (s + 1) < w ? (s + 1) : w;
              const float pv = Pf[(r + 16) * 128 + c]; const float mx = ssum * __builtin_amdgcn_rcpf((float)cnt) - pv;
              Mx[r * 136 + c] = (unsigned short)f2bf(mx);
              if (i < 31) ssum += Pf[(r + 17) * 128 + c] - Pf[(r + 17 - w) * 128 + c]; } }
        __syncthreads();
        f32x4 acc[8];
#pragma unroll
        for (int nt = 0; nt < 8; ++nt) acc[nt] = (f32x4){0.f, 0.f, 0.f, 0.f};
        const bf16* Wg = P_Wt_pg + (size_t)g * 128 * 128;
#pragma unroll
        for (int ks = 0; ks < 4; ++ks) {
            const bf16x8 a = *(const LAS bf16x8*)(Mx + (16 * wave + fr) * 136 + 32 * ks + 8 * fq);
#pragma unroll
            for (int nt = 0; nt < 8; ++nt) { const bf16x8 bw = *(const GAS bf16x8*)(Wg + (size_t)(16 * nt + fr) * 128 + 32 * ks + 8 * fq);
                acc[nt] = __builtin_amdgcn_mfma_f32_16x16x32_bf16(bw, a, acc[nt], 0, 0, 0); }
        }
        bf16* orow = P_AM + (size_t)(row0 + 16 * wave + fr) * 1536 + 1024 + g * 128;
#pragma unroll
        for (int nt = 0; nt < 8; ++nt) { const int d = 16 * nt + 4 * fq; const f32x4 sc = *(const f32x4*)(P_pool_scale + g * 128 + d); const f32x4 v = acc[nt] * sc;
            *(GAS unsigned long long*)(orow + d) = (unsigned long long)pk2(v[0], v[1]) | ((unsigned long long)pk2(v[2], v[3]) << 32); }
        __syncthreads();
    }
}
struct EpiMerge {
    static constexpr bool PERM = true; static constexpr int MID_T = 16;
    const bf16 *GR, *SGP; bf16* O;
    struct Pre {}; __device__ __forceinline__ Pre pre(const pg8::Unit&, int, int, int, int) const { return Pre{}; }
    __device__ __forceinline__ void scale(pg8::f32x4 (&acc)[2][2][4][2], const bf16* Sm, const pg8::Unit& u, int wr, int wc, int fr, int fq) const {
        const __amdgpu_buffer_rsrc_t rs = __builtin_amdgcn_make_buffer_rsrc((void*)Sm, 0, T * D * 2, 0x00020000);
        const int voff = ((u.pm * 256 + wr * 64 + fr) * D + u.pn * 256 + wc * 32 + 8 * fq) * 2;
#pragma unroll
        for (int ai = 0; ai < 2; ++ai)
#pragma unroll
            for (int m = 0; m < 4; ++m) {
#pragma unroll
                for (int bj = 0; bj < 2; ++bj) { const pg8::u32x4 w = __builtin_amdgcn_raw_buffer_load_b128(rs, voff, ((ai * 128 + m * 16) * D + bj * 128) * 2, 0);
                    acc[ai][bj][m][0][0] *= __uint_as_float(w.x << 16); acc[ai][bj][m][0][1] *= __uint_as_float(w.x & 0xffff0000u); acc[ai][bj][m][0][2] *= __uint_as_float(w.y << 16); acc[ai][bj][m][0][3] *= __uint_as_float(w.y & 0xffff0000u);
                    acc[ai][bj][m][1][0] *= __uint_as_float(w.z << 16); acc[ai][bj][m][1][1] *= __uint_as_float(w.z & 0xffff0000u); acc[ai][bj][m][1][2] *= __uint_as_float(w.w << 16); acc[ai][bj][m][1][3] *= __uint_as_float(w.w & 0xffff0000u); }
                asm volatile("" : "+v"(acc[ai][0][m][0]), "+v"(acc[ai][0][m][1]), "+v"(acc[ai][1][m][0]), "+v"(acc[ai][1][m][1])); asm volatile("" ::: "memory");
            }
    }
    __device__ __forceinline__ void mid(pg8::f32x4 (&acc)[2][2][4][2], const pg8::Unit& u, int wr, int wc, int fr, int fq) const { scale(acc, GR, u, wr, wc, fr, fq); }
    __device__ __forceinline__ void operator()(pg8::f32x4 (&acc)[2][2][4][2], const pg8::Unit& u, int wr, int wc, int fr, int fq, const Pre&) const {
        scale(acc, SGP, u, wr, wc, fr, fq);
        const int row0 = u.pm * 256 + wr * 64 + fr, col0 = u.pn * 256 + wc * 32 + 8 * fq;
#pragma unroll
        for (int ai = 0; ai < 2; ++ai)
#pragma unroll
            for (int m = 0; m < 4; ++m)
#pragma unroll
                for (int bj = 0; bj < 2; ++bj) { const pg8::f32x4 v0 = acc[ai][bj][m][0], v1 = acc[ai][bj][m][1];
                    pg8::u32x4 w; w.x = pg8::cvt_pk_bf16(v0[0], v0[1]); w.y = pg8::cvt_pk_bf16(v0[2], v0[3]); w.z = pg8::cvt_pk_bf16(v1[0], v1[1]); w.w = pg8::cvt_pk_bf16(v1[2], v1[3]);
                    *(pg8::u32x4*)(O + (size_t)(row0 + ai * 128 + m * 16) * D + col0 + bj * 128) = w; }
    }
};
struct EpiNull {
    static constexpr bool PERM = true; static constexpr int MID_T = -1;
    struct Pre {}; __device__ __forceinline__ Pre pre(const pg8::Unit&, int, int, int, int) const { return Pre{}; }
    __device__ __forceinline__ void mid(pg8::f32x4 (&)[2][2][4][2], const pg8::Unit&, int, int, int, int) const {}
    __device__ __forceinline__ void operator()(pg8::f32x4 (&acc)[2][2][4][2], const pg8::Unit&, int, int, int, int, const Pre&) const {
#pragma unroll
        for (int ai = 0; ai < 2; ++ai)
#pragma unroll
            for (int bj = 0; bj < 2; ++bj)
#pragma unroll
                for (int m = 0; m < 4; ++m) asm volatile("" :: "v"(acc[ai][bj][m][0]), "v"(acc[ai][bj][m][1]));
    }
};
struct EpiStore {
    static constexpr bool PERM = true; static constexpr int MID_T = -1;
    bf16* O; int ldc;
    struct Pre {}; __device__ __forceinline__ Pre pre(const pg8::Unit&, int, int, int, int) const { return Pre{}; }
    __device__ __forceinline__ void mid(pg8::f32x4 (&)[2][2][4][2], const pg8::Unit&, int, int, int, int) const {}
    __device__ __forceinline__ void operator()(pg8::f32x4 (&acc)[2][2][4][2], const pg8::Unit& u, int wr, int wc, int fr, int fq, const Pre&) const {
        const int row0 = u.pm * 256 + wr * 64 + fr, col0 = u.pn * 256 + wc * 32 + 8 * fq;
#pragma unroll
        for (int ai = 0; ai < 2; ++ai)
#pragma unroll
            for (int m = 0; m < 4; ++m)
#pragma unroll
                for (int bj = 0; bj < 2; ++bj) { const pg8::f32x4 v0 = acc[ai][bj][m][0], v1 = acc[ai][bj][m][1];
                    pg8::u32x4 w; w.x = pg8::cvt_pk_bf16(v0[0], v0[1]); w.y = pg8::cvt_pk_bf16(v0[2], v0[3]); w.z = pg8::cvt_pk_bf16(v1[0], v1[1]); w.w = pg8::cvt_pk_bf16(v1[2], v1[3]);
                    *(pg8::u32x4*)(O + (size_t)(row0 + ai * 128 + m * 16) * ldc + col0 + bj * 128) = w; }
    }
};
typedef float f32x16 __attribute__((ext_vector_type(16)));
__device__ __forceinline__ void p6_rows(const Params& p, LAS unsigned char* lds, int tid, int wave, int lane, int vcu, int G) {
    LAS float* tile = (LAS float*)lds;
    constexpr int RB = 1;
    float wreg[64];
#pragma unroll
    for (int i = 0; i < 64; ++i) wreg[i] = P_w_router[(size_t)(128 * wave + 2 * i + (lane >> 5)) * NE + (lane & 31)];
    for (int grp = vcu; grp < T / 64; grp += G) {
        const int b = (grp * 64) / SEQ;
        LAS float* vec = (LAS float*)(lds + TAB_OFF + 256);
        LAS int* lcnt = (LAS int*)(lds + TAB_OFF + 256 + 16384); LAS int* gbase = lcnt + 32; LAS int* pel = lcnt + 64;
        __syncthreads();
        if (tid < NE) lcnt[tid] = 0;
        if (tid < 256) { const int k = 4 * tid; const float* mf = P_modp + MODF_OFF + (size_t)b * 4 * D + k;
            const f32x4 a = *(const f32x4*)mf, g1 = *(const f32x4*)(P_g_post_mix + k), c = *(const f32x4*)(P_g_pre_ffn + k) * (1.f + *(const f32x4*)(mf + 2 * D)), d = *(const f32x4*)(mf + D);
            *(LAS f32x4*)(vec + k) = a; *(LAS f32x4*)(vec + 1024 + k) = g1; *(LAS f32x4*)(vec + 2048 + k) = c; *(LAS f32x4*)(vec + 3072 + k) = d; }
        __syncthreads();
#pragma unroll 1
        for (int half = 0; half < 2; ++half) {
#pragma unroll 1
            for (int sb = 0; sb < 4; sb += RB) {
                const int tr0 = wave * 4 + sb, m0 = grp * 64 + half * 32 + tr0;
                unsigned long long mw[RB][4]; f32x4 xv[RB][4]; float ss[RB];
#pragma unroll
                for (int rr = 0; rr < RB; ++rr)
#pragma unroll
                    for (int j = 0; j < 4; ++j) { mw[rr][j] = __builtin_nontemporal_load((const GAS unsigned long long*)(P_MIXOUT + (size_t)(m0 + rr) * D) + lane + 64 * j); xv[rr][j] = __builtin_nontemporal_load((const GAS f32x4*)(P_x + (size_t)(m0 + rr) * D) + lane + 64 * j); }
#define P6_UNPK(w) ((f32x4){__uint_as_float((unsigned)(w) << 16), __uint_as_float((unsigned)(w) & 0xffff0000u), __uint_as_float((unsigned)((w) >> 32) << 16), __uint_as_float((unsigned)((w) >> 32) & 0xffff0000u)})
#pragma unroll
                for (int rr = 0; rr < RB; ++rr) { float s = 0.f;
#pragma unroll
                    for (int j = 0; j < 4; ++j) { const f32x4 v = P6_UNPK(mw[rr][j]); s += (v.x * v.x + v.y * v.y) + (v.z * v.z + v.w * v.w); }
                    ss[rr] = s; }
#pragma unroll
                for (int o = 1; o < 64; o <<= 1) {
#pragma unroll
                    for (int rr = 0; rr < RB; ++rr) ss[rr] += __shfl_xor(ss[rr], o); }
#pragma unroll
                for (int rr = 0; rr < RB; ++rr) { const float rstd = 1.f / sqrtf(ss[rr] * (1.f / D) + EPS); GAS f32x4* orow = (GAS f32x4*)(P_out + (size_t)(m0 + rr) * D) + lane; float s = 0.f;
#pragma unroll
                    for (int j = 0; j < 4; ++j) { const int k = 4 * lane + 256 * j; const f32x4 v = P6_UNPK(mw[rr][j]);
                        const f32x4 x1 = xv[rr][j] + *(const LAS f32x4*)(vec + k) * (v * rstd * *(const LAS f32x4*)(vec + 1024 + k)); xv[rr][j] = x1; orow[64 * j] = x1; s += (x1.x * x1.x + x1.y * x1.y) + (x1.z * x1.z + x1.w * x1.w); }
                    ss[rr] = s; }
#undef P6_UNPK
#pragma unroll
                for (int o = 1; o < 64; o <<= 1) {
#pragma unroll
                    for (int rr = 0; rr < RB; ++rr) ss[rr] += __shfl_xor(ss[rr], o); }
#pragma unroll
                for (int rr = 0; rr < RB; ++rr) { const float rstd = 1.f / sqrtf(ss[rr] * (1.f / D) + EPS);
#pragma unroll
                    for (int j = 0; j < 4; ++j) { const int k = 4 * lane + 256 * j; const f32x4 u = xv[rr][j] * rstd * *(const LAS f32x4*)(vec + 2048 + k) + *(const LAS f32x4*)(vec + 3072 + k);
                        *((GAS unsigned*)((unsigned char*)P_U + (size_t)(m0 + rr) * D) + lane + 64 * j) = pk4_fp8(u.x * A8_SCALE, u.y * A8_SCALE, u.z * A8_SCALE, u.w * A8_SCALE);
                        LAS float* tp = tile + (tr0 + rr) * 1025 + k; tp[0] = u.x; tp[1] = u.y; tp[2] = u.z; tp[3] = u.w; } }
            }
            __syncthreads();
            f32x16 acc;
#pragma unroll
            for (int r = 0; r < 16; ++r) acc[r] = 0.f;
            { const LAS float* ap = tile + (lane & 31) * 1025 + 128 * wave + (lane >> 5);
#pragma unroll
              for (int i = 0; i < 64; ++i) acc = __builtin_amdgcn_mfma_f32_32x32x2f32(ap[2 * i], wreg[i], acc, 0, 0, 0); }
            __syncthreads();
            LAS float* part = (LAS float*)lds;
#pragma unroll
            for (int r = 0; r < 16; ++r) part[(wave * 32 + (r & 3) + 8 * (r >> 2) + 4 * (lane >> 5)) * 32 + (lane & 31)] = acc[r];
            __syncthreads();
#pragma unroll 1
            for (int rr = 0; rr < 4; ++rr) {
                const int tr = wave * 4 + rr, m = grp * 64 + half * 32 + tr;
                float mylg = -INFINITY;
                if (lane < 32) { float s = P_b_router[lane];
#pragma unroll
                    for (int w8 = 0; w8 < 8; ++w8) s += part[(w8 * 32 + tr) * 32 + lane];
                    mylg = s; }
                int sel[4]; float sv[4];
#pragma unroll
                for (int k = 0; k < 4; ++k) { float bv = mylg; int bi = lane;
#pragma unroll
                    for (int off = 1; off < 64; off <<= 1) { const float ov = __shfl_xor(bv, off); const int oi = __shfl_xor(bi, off);
                        if (ov > bv || (ov == bv && oi < bi)) { bv = ov; bi = oi; } }
                    sel[k] = bi; sv[k] = bv; if (lane == bi) mylg = -INFINITY; }
                float den = 0.f, pe[4];
#pragma unroll
                for (int k = 0; k < 4; ++k) { pe[k] = __expf(sv[k] - sv[0]); den += pe[k]; }
                if (lane == 0) {
#pragma unroll
                    for (int k = 0; k < 4; ++k) { P_prob[m * 4 + k] = pe[k] / den; const int loc = __hip_atomic_fetch_add(lcnt + sel[k], 1, __ATOMIC_RELAXED, __HIP_MEMORY_SCOPE_WORKGROUP);
                        pel[(half * 32 + tr) * 4 + k] = (sel[k] << 16) | loc; }
                }
            }
            __syncthreads();
        }
        if (tid < NE) { const int c = lcnt[tid]; gbase[tid] = c ? (int)__hip_atomic_fetch_add(P_ctl + CW_CNT + 64 * tid, (unsigned)c, __ATOMIC_RELAXED, __HIP_MEMORY_SCOPE_AGENT) : 0; }
        __syncthreads();
        if (tid < 256) { const int v = pel[tid], e = v >> 16, loc = v & 0xffff; P_lists[(size_t)e * T + gbase[e] + loc] = grp * 256 + tid; }
        __syncthreads();
    }
}
constexpr int MOE_MAXU = 10;
struct MoeSched {
    const bf16* Bt_all; size_t bstride; int K, ncol, a_shift, lda, G, c, total;
    const LAS int* pre;
    const LAS int* idx;
    const LAS int* utab;
    __device__ __forceinline__ bool locate(int i, pg8::Unit& u) const {
        const int L = (G == 256) ? ((i * 8 + (c & 7)) * 32 + (c >> 3)) : (i * G + c);
        if (L >= total || i >= MOE_MAXU) return false;
        const int RT = L / ncol; u.pn = L - RT * ncol;
        int e = 0;
#pragma unroll 1
        for (int q = 1; q < NE; ++q) e += (pre[q] <= RT) ? 1 : 0;
        u.e = e; u.pm = RT - pre[e]; u.ui = i; return true;
    }
    __device__ __forceinline__ bool next(int i, pg8::Unit& u) const {
        if (i >= MOE_MAXU) return false;
        const pg8::v4i_t t = *(const LAS pg8::v4i_t*)(utab + 4 * i);
        u.e = t[0]; u.pm = t[1]; u.pn = t[2]; u.ui = i; return t[3] != 0;
    }
    __device__ __forceinline__ unsigned a_off(const pg8::Unit& u, int r, int C) const {
        int pair = idx[u.ui * 256 + r]; if (pair < 0) pair = idx[u.ui * 256];
        return (unsigned)(((size_t)(pair >> a_shift) * lda + C) * 2u);
    }
    __device__ __forceinline__ const char* b_base(const pg8::Unit& u) const { return (const char*)(Bt_all + (size_t)u.e * bstride + (size_t)u.pn * 256 * K); }
    __device__ __forceinline__ void a_ready(const pg8::Unit&) const {}
    __device__ __forceinline__ void done(const pg8::Unit&) const {}
};
__device__ __forceinline__ void moe_setup(const Params& p, MoeSched& S, LAS int* pre, LAS int* idx, int tid) {
    LAS int* utab = pre + 48;
    if (tid == 0) { int acc = 0; for (int e = 0; e < NE; ++e) { pre[e] = acc; const int c = (int)__hip_atomic_load(P_ctl + CW_CNT + 64 * e, __ATOMIC_RELAXED, __HIP_MEMORY_SCOPE_AGENT); acc += (c + 255) >> 8; } pre[NE] = acc; }
    __syncthreads();
    S.pre = pre; S.idx = idx; S.utab = utab; S.total = pre[NE] * S.ncol;
    for (int i = 0; i < MOE_MAXU; ++i) { pg8::Unit u; const bool ok = S.locate(i, u);
        if (tid == 0) { utab[4 * i] = ok ? u.e : 0; utab[4 * i + 1] = ok ? u.pm : 0; utab[4 * i + 2] = ok ? u.pn : 0; utab[4 * i + 3] = ok ? 1 : 0; }
        if (!ok) continue;
        if (tid < 256) { const int cnt = (int)__hip_atomic_load(P_ctl + CW_CNT + 64 * u.e, __ATOMIC_RELAXED, __HIP_MEMORY_SCOPE_AGENT); const int r = u.pm * 256 + tid;
            idx[i * 256 + tid] = r < cnt ? P_lists[(size_t)u.e * T + r] : -1; } }
    __syncthreads();
}
struct EpiAct {
    static constexpr bool PERM = true; static constexpr int MID_T = -1;
    bf16* ACT; const float* b_gu; const LAS int* idx;
    struct Pre { f32x4 bg0, bg1, bu0, bu1; };
    __device__ __forceinline__ Pre pre(const pg8::Unit& u, int, int wc, int, int fq) const { const float* bg = b_gu + (size_t)u.e * 2 * DFF + u.pn * 128 + wc * 32 + 8 * fq;
        return Pre{*(const f32x4*)bg, *(const f32x4*)(bg + 4), *(const f32x4*)(bg + DFF), *(const f32x4*)(bg + DFF + 4)}; }
    __device__ __forceinline__ void mid(pg8::f32x4 (&)[2][2][4][2], const pg8::Unit&, int, int, int, int) const {}
    __device__ __forceinline__ void operator()(pg8::f32x4 (&acc)[2][2][4][2], const pg8::Unit& u, int wr, int wc, int fr, int fq, const Pre& q) const {
        const int col = u.pn * 128 + wc * 32 + 8 * fq;
        const f32x4 bg0 = q.bg0, bg1 = q.bg1, bu0 = q.bu0, bu1 = q.bu1;
#pragma unroll
        for (int ai = 0; ai < 2; ++ai)
#pragma unroll
            for (int m = 0; m < 4; ++m) {
                const int pair = idx[u.ui * 256 + ai * 128 + wr * 64 + m * 16 + fr];
                float o[8];
#pragma unroll
                for (int n = 0; n < 2; ++n)
#pragma unroll
                    for (int j = 0; j < 4; ++j) { float g = acc[ai][0][m][n][j] * MOE_DESCALE + (n ? bg1[j] : bg0[j]); float up = acc[ai][1][m][n][j] * MOE_DESCALE + (n ? bu1[j] : bu0[j]);
                        g = fminf(g, 7.f); up = fminf(fmaxf(up, -7.f), 7.f);
                        o[n * 4 + j] = (up * A8_SCALE + A8_SCALE) * (g * __builtin_amdgcn_rcpf(1.f + __builtin_amdgcn_exp2f(-2.4554669595930156f * g))); }
                if (pair >= 0) { pg8::u32x2 w; int w0 = __builtin_amdgcn_cvt_pk_fp8_f32(o[0], o[1], 0, false); w0 = __builtin_amdgcn_cvt_pk_fp8_f32(o[2], o[3], w0, true);
                    int w1 = __builtin_amdgcn_cvt_pk_fp8_f32(o[4], o[5], 0, false); w1 = __builtin_amdgcn_cvt_pk_fp8_f32(o[6], o[7], w1, true); w.x = (unsigned)w0; w.y = (unsigned)w1;
                    *(pg8::u32x2*)((unsigned char*)ACT + (size_t)pair * DFF + col) = w; }
            }
    }
};
struct EpiY {
    static constexpr bool PERM = true; static constexpr int MID_T = -1;
    bf16* Y; const float* b_dn; const LAS int* idx;
    struct Pre { f32x4 b00, b01, b10, b11; };
    __device__ __forceinline__ Pre pre(const pg8::Unit& u, int, int wc, int, int fq) const { const float* bb = b_dn + (size_t)u.e * D + u.pn * 256 + wc * 32 + 8 * fq;
        return Pre{*(const f32x4*)bb, *(const f32x4*)(bb + 4), *(const f32x4*)(bb + 128), *(const f32x4*)(bb + 132)}; }
    __device__ __forceinline__ void mid(pg8::f32x4 (&)[2][2][4][2], const pg8::Unit&, int, int, int, int) const {}
    __device__ __forceinline__ void operator()(pg8::f32x4 (&acc)[2][2][4][2], const pg8::Unit& u, int wr, int wc, int fr, int fq, const Pre& q) const {
        const int col0 = u.pn * 256 + wc * 32 + 8 * fq;
        f32x4 bv[2][2]; bv[0][0] = q.b00; bv[0][1] = q.b01; bv[1][0] = q.b10; bv[1][1] = q.b11;
#pragma unroll
        for (int ai = 0; ai < 2; ++ai)
#pragma unroll
            for (int m = 0; m < 4; ++m) {
                const int pair = idx[u.ui * 256 + ai * 128 + wr * 64 + m * 16 + fr];
                if (pair >= 0) {
#pragma unroll
                    for (int bj = 0; bj < 2; ++bj) { const pg8::f32x4 v0 = acc[ai][bj][m][0] * MOE_DESCALE + bv[bj][0], v1 = acc[ai][bj][m][1] * MOE_DESCALE + bv[bj][1];
                        pg8::u32x4 w; w.x = pg8::cvt_pk_bf16(v0[0], v0[1]); w.y = pg8::cvt_pk_bf16(v0[2], v0[3]); w.z = pg8::cvt_pk_bf16(v1[0], v1[1]); w.w = pg8::cvt_pk_bf16(v1[2], v1[3]);
                        *(pg8::u32x4*)(Y + (size_t)pair * D + col0 + bj * 128) = w; }
                }
            }
    }
};
__device__ __forceinline__ void p9_rows(const Params& p, int wave, int lane, int vcu, int G) {
    for (int grp = vcu; grp < T / 64; grp += G) {
        const int row0 = grp * 64 + wave * 8, b = row0 / SEQ;
        f32x4 gf[2][2];
#pragma unroll
        for (int j = 0; j < 2; ++j)
#pragma unroll
            for (int q = 0; q < 2; ++q) { const int k = 8 * lane + 512 * j + 4 * q; gf[j][q] = *(const f32x4*)(P_modp + MODF_OFF + (size_t)(b * 4 + 3) * D + k) * *(const f32x4*)(P_g_post_ffn + k); }
#pragma unroll 1
        for (int rb = 0; rb < 8; rb += 2) {
            v4u yw[2][4][2]; f32x4 xv[2][2][2]; f32x4 pr[2];
#pragma unroll
            for (int r = 0; r < 2; ++r) { const int m = row0 + rb + r; pr[r] = *(const f32x4*)(P_prob + (size_t)m * 4);
#pragma unroll
                for (int kk = 0; kk < 4; ++kk)
#pragma unroll
                    for (int j = 0; j < 2; ++j) yw[r][kk][j] = __builtin_nontemporal_load((const GAS v4u*)(P_Y + ((size_t)m * 4 + kk) * D) + lane + 64 * j);
#pragma unroll
                for (int j = 0; j < 2; ++j)
#pragma unroll
                    for (int q = 0; q < 2; ++q) xv[r][j][q] = *((const GAS f32x4*)(P_out + (size_t)m * D) + 2 * lane + 128 * j + q); }
            f32x4 f[2][2][2]; float ss[2];
#pragma unroll
            for (int r = 0; r < 2; ++r) { float s = 0.f;
#pragma unroll
                for (int j = 0; j < 2; ++j) { f32x4 f0 = {0.f, 0.f, 0.f, 0.f}, f1 = f0;
#pragma unroll
                    for (int kk = 0; kk < 4; ++kk) { const v4u w = yw[r][kk][j]; const float pk = pr[r][kk];
                        f0 += (f32x4){__uint_as_float(w.x << 16), __uint_as_float(w.x & 0xffff0000u), __uint_as_float(w.y << 16), __uint_as_float(w.y & 0xffff0000u)} * pk;
                        f1 += (f32x4){__uint_as_float(w.z << 16), __uint_as_float(w.z & 0xffff0000u), __uint_as_float(w.w << 16), __uint_as_float(w.w & 0xffff0000u)} * pk; }
                    f[r][j][0] = f0; f[r][j][1] = f1; s += (f0.x * f0.x + f0.y * f0.y) + (f0.z * f0.z + f0.w * f0.w) + (f1.x * f1.x + f1.y * f1.y) + (f1.z * f1.z + f1.w * f1.w); }
                ss[r] = s; }
#pragma unroll
            for (int o = 1; o < 64; o <<= 1) {
#pragma unroll
                for (int r = 0; r < 2; ++r) ss[r] += __shfl_xor(ss[r], o); }
#pragma unroll
            for (int r = 0; r < 2; ++r) { const int m = row0 + rb + r; const float rstd = 1.f / sqrtf(ss[r] * (1.f / D) + EPS);
#pragma unroll
                for (int j = 0; j < 2; ++j)
#pragma unroll
                    for (int q = 0; q < 2; ++q) __builtin_nontemporal_store(xv[r][j][q] + gf[j][q] * (f[r][j][q] * rstd), (GAS f32x4*)(P_out + (size_t)m * D) + 2 * lane + 128 * j + q); }
        }
    }
}
}

namespace mk {
namespace at {
typedef float f32x16 __attribute__((ext_vector_type(16)));
typedef short s16x4 __attribute__((ext_vector_type(4)));
typedef short v4i16_t __attribute__((ext_vector_type(4)));
typedef LAS const char* lds_cptr;
constexpr int KSLOT = 8192, VSLOT = 16384;
constexpr int L_K = 0, L_V = 3 * KSLOT, L_WS = L_V + 3 * VSLOT, L_ST = L_WS + NW * 256, L_END = L_ST + NW * 8192;
static_assert(L_END <= MISC_OFF, "attention LDS map");
__device__ __forceinline__ int crow(int r, int hi) { return (r & 3) + 8 * (r >> 2) + 4 * hi; }
__device__ __forceinline__ void glds16(const void* gsrc, unsigned lds_dst) { unsigned keep;
    asm volatile("s_mov_b32 %0, m0\n\ts_mov_b32 m0, %2\n\ts_nop 0\n\tglobal_load_lds_dwordx4 %1, off\n\ts_mov_b32 m0, %0" : "=&s"(keep) : "v"(gsrc), "s"(lds_dst) : "memory"); }
__device__ __forceinline__ void glds16s(const void* sbase, unsigned voff, unsigned lds_dst) { unsigned keep;
    asm volatile("s_mov_b32 %0, m0\n\ts_mov_b32 m0, %3\n\ts_nop 0\n\tglobal_load_lds_dwordx4 %1, %2\n\ts_mov_b32 m0, %0" : "=&s"(keep) : "v"(voff), "s"(sbase), "s"(lds_dst) : "memory"); }
__device__ __forceinline__ unsigned cvtpk(float lo, float hi) { typedef float f2 __attribute__((ext_vector_type(2))); typedef __bf16 b2 __attribute__((ext_vector_type(2))); f2 v = {lo, hi}; b2 b = __builtin_convertvector(v, b2); return __builtin_bit_cast(unsigned, b); }
__device__ __forceinline__ s16x4 vtr(lds_cptr p) { return __builtin_bit_cast(s16x4, __builtin_amdgcn_ds_read_tr16_b64_v4i16((LAS v4i16_t*)p)); }
__device__ __forceinline__ float swap_max(float m) { auto rr = __builtin_amdgcn_permlane32_swap(__float_as_uint(m), __float_as_uint(m), false, false); return fmaxf(__uint_as_float(rr[0]), __uint_as_float(rr[1])); }
__device__ __forceinline__ float swap_sum(float m) { auto rr = __builtin_amdgcn_permlane32_swap(__float_as_uint(m), __float_as_uint(m), false, false); return __uint_as_float(rr[0]) + __uint_as_float(rr[1]); }
#define AT_MFMA(a, b, c) __builtin_amdgcn_mfma_f32_32x32x16_bf16(a, b, c, 0, 0, 0)
__device__ __forceinline__ float at_max3(float a, float b, float c) { float r; asm("v_max3_f32 %0, %1, %2, %3" : "=v"(r) : "v"(a), "v"(b), "v"(c)); return r; }

constexpr float THRL = 8.f;
template <int VAR>
__device__ __forceinline__ void attn_unit(const Params& p, LAS unsigned char* lds, int tid, int b, int h, int qb, float lam, bf16* AMo) {
    const int lane = tid & 63, r32 = lane & 31, hi = lane >> 5; const int wid = __builtin_amdgcn_readfirstlane(tid >> 6);
    const size_t rowbase = (size_t)b * SEQ;
    const int q0 = qb * 256 + wid * 32;
    const int NT = 4 * qb + 4;
    const int my_last = 4 * qb + (wid >> 1);
    const unsigned lds0 = (unsigned)(uintptr_t)lds;
    LAS float* wsf = (LAS float*)(lds + L_WS) + wid * 64;
    const lds_cptr kp0 = (lds_cptr)(lds + L_K) + hi * 1024 + r32 * 16;
    const lds_cptr vp0 = (lds_cptr)(lds + L_V) + ((lane >> 4) & 1) * 32 + (lane & 3) * 8 + (4 * hi + ((lane & 15) >> 2)) * 64;
    LAS unsigned short* const stg = (LAS unsigned short*)(lds + L_ST + wid * 8192);
#pragma unroll 1
    for (int mp = 0; mp < 2; ++mp) {
        const int n = 2 * h + mp;
        bf16x8 qr[4];
        { const bf16* qw = P_QKV + (rowbase + q0 + r32) * 3072 + n * 64 + hi * 8;
#pragma unroll
          for (int d0 = 0; d0 < 4; ++d0) qr[d0] = *(const GAS bf16x8*)(qw + d0 * 16); }
        asm volatile("" : "+v"(qr[0]), "+v"(qr[1]), "+v"(qr[2]), "+v"(qr[3]));
        const char* kbase = (const char*)(P_QKV + rowbase * 3072 + 1024 + n * 64 + wid * 8);
        const char* vbase = (const char*)(P_QKV + (rowbase + 16 * (wid & 3)) * 3072 + 2048 + h * 128 + (wid >> 2) * 32);
        const unsigned klo = (unsigned)lane * 6144u, vlo = (unsigned)(lane >> 2) * 6144u + (unsigned)(lane & 3) * 16u;
#define AT_DMA(t, s) do { const size_t to_ = (size_t)(t) * 64 * 6144; \
                          glds16s(kbase + to_, klo, (unsigned)__builtin_amdgcn_readfirstlane(lds0 + L_K + (s) * KSLOT + wid * 1024)); \
                          glds16s(vbase + to_, vlo, (unsigned)__builtin_amdgcn_readfirstlane(lds0 + L_V + (s) * VSLOT + wid * 1024)); \
                          glds16s(vbase + to_ + 128, vlo, (unsigned)__builtin_amdgcn_readfirstlane(lds0 + L_V + (s) * VSLOT + (wid + 8) * 1024)); } while (0)
        AT_DMA(0, 0); AT_DMA(1, 1);
        f32x16 o[4];
        float mrow = 0.f, lsum = 0.f;
        int s = 0;
        f32x16 pA0, pA1, pB0, pB1;
        f32x16 negm = {0.f, 0.f, 0.f, 0.f, 0.f, 0.f, 0.f, 0.f, 0.f, 0.f, 0.f, 0.f, 0.f, 0.f, 0.f, 0.f};
#define AT_KRD(dst, kb, d0) do { dst[0] = *(const LAS bf16x8*)((kb) + (d0) * 2048); dst[1] = *(const LAS bf16x8*)((kb) + (d0) * 2048 + 512); } while (0)
#define AT_QK(P0, P1, sl) do { const lds_cptr kb_ = kp0 + (sl) * KSLOT; bf16x8 ka_[2], kb2_[2]; \
            AT_KRD(ka_, kb_, 0); AT_KRD(kb2_, kb_, 1); __builtin_amdgcn_sched_barrier(0); \
            P0 = AT_MFMA(ka_[0], qr[0], negm); P1 = AT_MFMA(ka_[1], qr[0], negm); AT_KRD(ka_, kb_, 2); __builtin_amdgcn_sched_barrier(0); \
            P0 = AT_MFMA(kb2_[0], qr[1], P0); P1 = AT_MFMA(kb2_[1], qr[1], P1); AT_KRD(kb2_, kb_, 3); __builtin_amdgcn_sched_barrier(0); \
            P0 = AT_MFMA(ka_[0], qr[2], P0); P1 = AT_MFMA(ka_[1], qr[2], P1); __builtin_amdgcn_sched_barrier(0); \
            P0 = AT_MFMA(kb2_[0], qr[3], P0); P1 = AT_MFMA(kb2_[1], qr[3], P1); __builtin_amdgcn_sched_barrier(0); } while (0)
#define AT_VRD(i, ks0) do { const s16x4 lo_ = vtr(vb_ + ((i) & 3) * 4096 + ((ks0) + ((i) >> 2)) * 1024), hh_ = vtr(vb_ + ((i) & 3) * 4096 + ((ks0) + ((i) >> 2)) * 1024 + 512); \
            F_[i] = (bf16x8){lo_[0], lo_[1], lo_[2], lo_[3], hh_[0], hh_[1], hh_[2], hh_[3]}; } while (0)
#define AT_MX3(a, b, c) at_max3(a, b, c)
#define AT_STEP(PC0, PC1, PN0, PN1, T) do { \
            asm volatile("s_waitcnt vmcnt(0) lgkmcnt(0)\n\ts_barrier" ::: "memory");     \
            const int s1_ = (s == 2) ? 0 : s + 1, s2_ = (s1_ == 2) ? 0 : s1_ + 1; \
            if ((T) + 2 < NT) AT_DMA((T) + 2, s2_); \
            if (VAR != 1 && (T) <= my_last) { \
                float ra_ = AT_MX3(PC0[0], PC0[1], PC1[0]), rb_ = AT_MX3(PC0[2], PC0[3], PC1[1]); ra_ = AT_MX3(ra_, PC1[2], PC1[3]); \
                _Pragma("unroll") for (int r = 4; r < 16; r += 4) { ra_ = AT_MX3(ra_, PC0[r], PC0[r + 1]); rb_ = AT_MX3(rb_, PC0[r + 2], PC0[r + 3]); ra_ = AT_MX3(ra_, PC1[r], PC1[r + 1]); rb_ = AT_MX3(rb_, PC1[r + 2], PC1[r + 3]); } \
                float rm_ = swap_max(fmaxf(ra_, rb_));                   \
                if ((T) == 0 || __any(rm_ > THRL)) {                      \
                    const float dl_ = ((T) == 0) ? rm_ : fmaxf(rm_, 0.f); \
                    mrow += dl_; \
                    _Pragma("unroll") for (int r = 0; r < 16; ++r) { PC0[r] -= dl_; PC1[r] -= dl_; negm[r] = -mrow; } \
                    if ((T) != 0) { const float al_ = __builtin_amdgcn_exp2f(-dl_); lsum *= al_; \
                        if (hi == 0) wsf[r32] = al_; \
                        asm volatile("s_waitcnt lgkmcnt(0)" ::: "memory"); \
                        _Pragma("unroll") for (int r = 0; r < 16; ++r) { const float f_ = wsf[crow(r, hi)]; \
                            _Pragma("unroll") for (int d0 = 0; d0 < 4; ++d0) o[d0][r] *= f_; } } } \
                __builtin_amdgcn_sched_barrier(0); \
                if ((T) + 1 <= my_last) AT_QK(PN0, PN1, s1_);             \
                if (VAR == 2) { asm volatile("" :: "v"(PC0), "v"(PC1)); } else { \
                const lds_cptr vb_ = vp0 + s * VSLOT; v4u pw_[4]; bf16x8 F_[8]; float sacc_ = 0.f; \
                if (VAR != 3) { AT_VRD(0, 0); AT_VRD(1, 0); AT_VRD(2, 0); AT_VRD(3, 0); AT_VRD(4, 0); AT_VRD(5, 0); AT_VRD(6, 0); AT_VRD(7, 0); }     \
                __builtin_amdgcn_sched_barrier(0); \
                _Pragma("unroll") for (int r = 0; r < 16; ++r) { PC0[r] = __builtin_amdgcn_exp2f(PC0[r]); sacc_ += PC0[r]; } \
                _Pragma("unroll") for (int i = 0; i < 4; ++i) { pw_[0][i] = cvtpk(PC0[2 * i], PC0[2 * i + 1]); pw_[1][i] = cvtpk(PC0[8 + 2 * i], PC0[9 + 2 * i]); } \
                __builtin_amdgcn_sched_barrier(0); \
                  \
                AT_GAP1(PC1, 0); AT_GAP1(PC1, 1); AT_GAP1(PC1, 2); AT_GAP1(PC1, 3); AT_GAP1(PC1, 4); AT_GAP1(PC1, 5); AT_GAP1(PC1, 6); AT_GAP1(PC1, 7); \
                _Pragma("unroll") for (int i = 0; i < 4; ++i) { pw_[2][i] = cvtpk(PC1[2 * i], PC1[2 * i + 1]); pw_[3][i] = cvtpk(PC1[8 + 2 * i], PC1[9 + 2 * i]); } \
                lsum += sacc_; \
                __builtin_amdgcn_sched_barrier(0); \
                if (VAR != 3) { _Pragma("unroll") for (int i = 0; i < 8; ++i) o[i & 3] = AT_MFMA(__builtin_bit_cast(bf16x8, pw_[2 + (i >> 2)]), F_[i], o[i & 3]); } else { asm volatile("" :: "v"(pw_[0]), "v"(pw_[1]), "v"(pw_[2]), "v"(pw_[3])); } \
                __builtin_amdgcn_sched_barrier(0); \
            } } \
            s = s1_; } while (0)
#define AT_GAP1(P1, i) do { if (VAR != 3) { o[(i) & 3] = AT_MFMA(__builtin_bit_cast(bf16x8, pw_[(i) >> 2]), F_[i], o[(i) & 3]); AT_VRD(i, 2); } \
            P1[2 * (i)] = __builtin_amdgcn_exp2f(P1[2 * (i)]); P1[2 * (i) + 1] = __builtin_amdgcn_exp2f(P1[2 * (i) + 1]); sacc_ += P1[2 * (i)]; sacc_ += P1[2 * (i) + 1]; \
            asm volatile("" : "+v"(P1), "+v"(sacc_)); __builtin_amdgcn_sched_barrier(0); } while (0)
        asm volatile("s_waitcnt vmcnt(3)\n\ts_barrier" ::: "memory");
#pragma unroll
        for (int r = 0; r < 16; ++r) {
#pragma unroll
            for (int d0 = 0; d0 < 4; ++d0) o[d0][r] = 0.f; }
        if (VAR != 1) AT_QK(pA0, pA1, 0);
        asm volatile("s_nop 7\n\ts_nop 7" ::: "memory");
#pragma unroll 1
        for (int t = 0; t < NT; t += 2) {
            AT_STEP(pA0, pA1, pB0, pB1, t);
            AT_STEP(pB0, pB1, pA0, pA1, t + 1);
        }
        asm volatile("s_waitcnt lgkmcnt(0)\n\ts_barrier" ::: "memory");
#undef AT_STEP
#undef AT_GAP1
#undef AT_MX3
#undef AT_VRD
#undef AT_QK
#undef AT_KRD
        int le_ = lane; asm volatile("" : "+v"(le_)); const int r32e = le_ & 31, hie = le_ >> 5;
        LAS unsigned short* const stge = (LAS unsigned short*)(lds + L_ST + wid * 8192) + r32e;
        lsum = swap_sum(lsum);
        if (hie == 0) wsf[32 + r32e] = 1.f / lsum;
        asm volatile("s_waitcnt lgkmcnt(0)" ::: "memory");
        float rli[16];
#pragma unroll
        for (int r = 0; r < 16; ++r) rli[r] = wsf[32 + crow(r, hie)];
        asm volatile("s_waitcnt lgkmcnt(0)" ::: "memory");
        if (mp == 0) {
#pragma unroll
            for (int r = 0; r < 16; ++r) { const int q = crow(r, hie);
#pragma unroll
                for (int d0 = 0; d0 < 4; ++d0) stge[q * 128 + 32 * d0] = (unsigned short)f2bf(o[d0][r] * rli[r]); }
            asm volatile("s_waitcnt lgkmcnt(0)" ::: "memory");
        } else {
            float ssq[16];
#pragma unroll
            for (int r = 0; r < 16; ++r) { ssq[r] = 0.f; const int q = crow(r, hie);
#pragma unroll
                for (int d0 = 0; d0 < 4; ++d0) { const float a0 = __uint_as_float((unsigned)stge[q * 128 + 32 * d0] << 16); const float v0 = a0 - lam * (o[d0][r] * rli[r]); o[d0][r] = v0; ssq[r] += v0 * v0; } }
            asm volatile("s_waitcnt lgkmcnt(0)" ::: "memory");
#pragma unroll
            for (int off = 1; off < 32; off <<= 1)
#pragma unroll
                for (int r = 0; r < 16; ++r) ssq[r] += __shfl_xor(ssq[r], off);
#pragma unroll
            for (int r = 0; r < 16; ++r) { const float rs = (1.f / sqrtf(ssq[r] * (1.f / 128.f) + EPS)) * 0.8f; const int q = crow(r, hie);
#pragma unroll
                for (int d0 = 0; d0 < 4; ++d0) { stge[q * 128 + 32 * d0] = (unsigned short)f2bf(o[d0][r] * rs * P_g_sub[r32e + 32 * d0]); } }
            asm volatile("s_waitcnt lgkmcnt(0)" ::: "memory");
            bf16* ow = AMo + (rowbase + q0) * 1536 + h * 128;
#pragma unroll
            for (int i = 0; i < 8; ++i) { const int row = i * 4 + (le_ >> 4), ch = le_ & 15; const v4u v = *(const LAS v4u*)(stge - r32e + row * 128 + ch * 8); *(GAS v4u*)(ow + (size_t)row * 1536 + ch * 8) = v; }
        }
#undef AT_DMA
    }
}
}
template <int VAR = 0>
__device__ __forceinline__ void attn_phase(const Params& p, LAS unsigned char* lds, int tid, int vcu, int G) {
    const float lam = lam_value(p);
    bf16* AMo = VAR == 0 ? P_AM : P_ACT;
    for (int pr = vcu; pr < 256; pr += G) {
        const int bh = pr >> 2, s = pr & 3, b = bh >> 3, h = bh & 7;
#pragma unroll 1
        for (int u = 0; u < 2; ++u) at::attn_unit<VAR>(p, lds, tid, b, h, u ? 7 - s : s, lam, AMo);
    }
}
}

namespace mk {
constexpr int NPH = 10;
#ifndef MK_SKIP
#define MK_SKIP 0
#endif
#ifndef MK_REPEAT
#define MK_REPEAT 0
#endif
#ifndef MK_PROFILE_PREFIX
#define MK_PROFILE_PREFIX 0
#endif
__global__ void __launch_bounds__(NTHR, 2) mega(Params p) {
    extern __shared__ __attribute__((aligned(16))) unsigned char lds_raw[];
    LAS unsigned char* lds = (LAS unsigned char*)lds_raw;
    volatile LAS unsigned* MISC = (volatile LAS unsigned*)(lds + MISC_OFF);
    const int tid0 = threadIdx.x;
    typedef __attribute__((address_space(4))) const Params CParams;
    CParams* const kp0 = (CParams*)__builtin_amdgcn_kernarg_segment_ptr();
#define FRESH int tid = tid0; asm volatile("" : "+v"(tid)); const int lane = tid & 63, wave = __builtin_amdgcn_readfirstlane(tid >> 6); (void)lane; (void)wave; \
              CParams* kp_ = kp0; asm volatile("" : "+s"(kp_)); Params p; { typedef __attribute__((address_space(4))) const unsigned long long cu64_; cu64_* s_ = (cu64_*)kp_; unsigned long long* d_ = (unsigned long long*)&p; \
              _Pragma("unroll") for (int i_ = 0; i_ < (int)(sizeof(Params) / 8); ++i_) d_[i_] = s_[i_]; }
    const int G = gridDim.x; const int bx = blockIdx.x; const int vcu = (G % 8 == 0) ? (bx % 8) * (G / 8) + bx / 8 : bx;
    if (tid0 < 64) MISC[tid0] = 0u;
    __syncthreads();
    XcdBarrier bar = xcd_barrier_post(P_ctl + CW_BAR + p.li * XCD_BAR_WORDS, MISC + 8);
    LAS int* pre = (LAS int*)(lds + TAB_OFF); LAS int* idx = (LAS int*)(lds + TAB_OFF + 512);
#ifdef MK_DOUBLE_BAR
#define SEAM(k) do { if (IN(k) && IN((k) + 1)) { xcd_barrier(bar); xcd_barrier(bar); } } while (0)
#else
#define SEAM(k) do { if (IN(k) && IN((k) + 1)) xcd_barrier(bar); } while (0)
#endif
#ifndef MK_ATTN_VAR
#define MK_ATTN_VAR 0
#endif
#define PHASE(k, ...) if (IN(k) && !(MK_SKIP & (1 << (k)))) { { FRESH; __VA_ARGS__ } if (MK_REPEAT & (1 << (k))) { __syncthreads(); FRESH; __VA_ARGS__ } } SEAM(k);
#ifdef MK_P2_NULL
#define PHASE_P2NULL if (IN(2)) { FRESH; pg8::Gemm g{P_U, D}; pg8::StaticOrder S; S.init(T, INW, D, D, P_Wt_in, G, bx); EpiNull E{}; pg8::gemm_phase<EpiNull, pg8::StaticOrder, true>(lds + RING_OFF, g, S, E, tid); xcd_barrier(bar); }
#else
#define PHASE_P2NULL
#endif
#define PROGRAM \
    PHASE(0, p0_prologue(p, lds, tid, wave, lane, vcu, G);) \
    PHASE(1, p1_rows(p, lds, tid, wave, lane, vcu, G);) \
    PHASE(2, pg8::Gemm g{P_U, D}; pg8::StaticOrder S; S.init(T, INW, D, D, P_Wt_in, G, bx); \
             EpiZ E{P_QKV, P_PB, P_GR, P_SGP, P_rope}; \
             pg8::gemm_phase<EpiZ, pg8::StaticOrder, true>(lds + RING_OFF, g, S, E, tid);) \
    PHASE_P2NULL \
    PHASE(3, if (!(p.flags & 2)) attn_phase<0>(p, lds, tid, vcu, G); \
             pool_phase(p, lds, tid, wave, lane, vcu, G); \
             if (MK_ATTN_VAR) { __syncthreads(); attn_phase<MK_ATTN_VAR>(p, lds, tid, vcu, G); }) \
    PHASE(4, pg8::Gemm g{P_AM, 1536}; pg8::StaticOrder S; S.init(T, D, 1536, 1536, P_Wt_mix, G, bx); \
             EpiMerge E{P_GR, P_SGP, P_MERGED}; \
             pg8::gemm_phase<EpiMerge, pg8::StaticOrder, true>(lds + RING_OFF, g, S, E, tid);) \
    PHASE(5, if (MK_PROFILE_PREFIX && bx == 0 && tid < NE) __hip_atomic_store(P_ctl + CW_CNT + 64 * tid, 0u, __ATOMIC_RELAXED, __HIP_MEMORY_SCOPE_AGENT); \
             pg8::Gemm g{P_MERGED, D}; pg8::StaticOrder S; S.init(T, D, D, D, P_Wt_out, G, bx); \
             EpiStore E{P_MIXOUT, D}; \
             pg8::gemm_phase<EpiStore, pg8::StaticOrder, true>(lds + RING_OFF, g, S, E, tid);) \
    PHASE(6, p6_rows(p, lds, tid, wave, lane, vcu, G);) \
    PHASE(7, MoeSched S{P_Wt_gu, (size_t)2 * DFF * D / 2, D / 2, 8, 2, D / 2, G, bx, 0, nullptr, nullptr, nullptr};     \
             moe_setup(p, S, pre, idx, tid); \
             pg8::Gemm g{P_U, D / 2}; EpiAct E{P_ACT, P_b_gu, idx}; \
             pg8::gemm_phase<EpiAct, MoeSched, true, true>(lds + RING_OFF, g, S, E, tid);) \
    PHASE(8, MoeSched S{P_Wt_dn, (size_t)D * DFF / 2, DFF / 2, 4, 0, DFF / 2, G, bx, 0, nullptr, nullptr, nullptr}; \
             moe_setup(p, S, pre, idx, tid); \
             pg8::Gemm g{P_ACT, DFF / 2}; EpiY E{P_Y, P_b_dn, idx}; \
             pg8::gemm_phase<EpiY, MoeSched, true, true>(lds + RING_OFF, g, S, E, tid);) \
    PHASE(9, p9_rows(p, wave, lane, vcu, G);)
#if MK_PROFILE_PREFIX
    {
#define IN(k) ((k) < MK_PROFILE_PREFIX)
        PROGRAM
#undef IN
        xcd_barrier(bar);
    }
#endif
    {
        const int lo = p.ph_lo, hi = p.ph_hi;
#define IN(k) (lo <= (k) && (k) < hi)
        PROGRAM
#undef IN
    }
#undef PROGRAM
#undef SEAM
#undef PHASE
#undef FRESH
}
}

static int g_grid = 0;
static int mk_setup() {
    if (g_grid) return g_grid;
    int dev = 0, cus = 0;
    if (hipGetDevice(&dev) != hipSuccess || hipDeviceGetAttribute(&cus, hipDeviceAttributeMultiprocessorCount, dev) != hipSuccess) { g_grid = -1; return -1; }
    if (hipFuncSetAttribute((const void*)mk::mega, hipFuncAttributeMaxDynamicSharedMemorySize, mk::LDS_BYTES) != hipSuccess) { g_grid = -1; return -1; }
    int per_cu = 0;
    if (hipOccupancyMaxActiveBlocksPerMultiprocessor(&per_cu, (const void*)mk::mega, mk::NTHR, mk::LDS_BYTES) != hipSuccess || per_cu < 1) { fprintf(stderr, "kernel_launch: occupancy query reports %d workgroups per CU\n", per_cu); }
    (void)hipGetLastError();
    g_grid = cus;
    return g_grid;
}
extern "C" void kernel_launch(void* const* d_in, const int* in_sizes, int n_in, void* d_out, int out_size, void* d_ws, size_t ws_size, hipStream_t stream) {
    if (mk_setup() < 0 || n_in != 26) return;
    unsigned char* wsb = (unsigned char*)d_ws;
    const size_t MiB = 1u << 20;
    mk::Params p{};
    p.x = (const GAS float*)d_in[0]; p.c = (const GAS float*)d_in[1]; p.pos = (const GAS int*)d_in[2]; p.w_mod = (const GAS float*)d_in[3]; p.b_mod = (const GAS float*)d_in[4]; p.g_pre_mix = (const GAS float*)d_in[5];
    p.w_in = (const GAS float*)d_in[6]; p.lq1 = (const GAS float*)d_in[7]; p.lk1 = (const GAS float*)d_in[8]; p.lq2 = (const GAS float*)d_in[9]; p.lk2 = (const GAS float*)d_in[10]; p.g_sub = (const GAS float*)d_in[11];
    p.w_pg = (const GAS float*)d_in[12]; p.pool_scale = (const GAS float*)d_in[13]; p.w_att = (const GAS float*)d_in[14]; p.w_pb = (const GAS float*)d_in[15]; p.w_out = (const GAS float*)d_in[16];
    p.g_post_mix = (const GAS float*)d_in[17]; p.g_pre_ffn = (const GAS float*)d_in[18]; p.w_router = (const GAS float*)d_in[19]; p.b_router = (const GAS float*)d_in[20];
    p.w_gu = (const GAS float*)d_in[21]; p.b_gu = (const GAS float*)d_in[22]; p.w_dn = (const GAS float*)d_in[23]; p.b_dn = (const GAS float*)d_in[24]; p.g_post_ffn = (const GAS float*)d_in[25];
    p.out = (GAS float*)d_out;
    size_t off = 0;
    auto carve = [&](size_t mib) { unsigned char* r = wsb + off; off += mib * MiB; return r; };
    p.ctl = (GAS unsigned*)carve(1); p.modp = (GAS float*)carve(2); p.rope = (GAS float*)carve(1);
    p.Wt_in = (GAS bf16*)carve(11); p.Wt_mix = (GAS bf16*)carve(3); p.Wt_out = (GAS bf16*)carve(2); p.Wt_pg = (GAS bf16*)carve(1);
    p.prob = (GAS float*)carve(1); p.lists = (GAS int*)carve(2);
    p.U = (GAS bf16*)carve(32); p.QKV = (GAS bf16*)carve(96); p.PB = (GAS bf16*)carve(16); p.GR = (GAS bf16*)carve(32); p.SGP = (GAS bf16*)carve(32);
    p.AM = (GAS bf16*)carve(48); p.MERGED = (GAS bf16*)carve(32); p.MIXOUT = (GAS bf16*)carve(32);
    p.Wt_gu = (GAS bf16*)carve(128); p.Wt_dn = (GAS bf16*)carve(64); p.ACT = (GAS bf16*)carve(128); p.Y = (GAS bf16*)carve(128);
    if (off > ws_size) { fprintf(stderr, "kernel_launch: workspace too small: need %zu, have %zu\n", off, ws_size); return; }
    p.flags = 0; p.ph_lo = 0; p.ph_hi = mk::NPH; p.li = 0;
    if (hipMemsetAsync(wsb, 0, 1 * MiB, stream) != hipSuccess) return;
    hipLaunchKernelGGL(mk::mega, dim3(g_grid), dim3(mk::NTHR), mk::LDS_BYTES, stream, p);
}
```

```cpp
#include <hip/hip_runtime.h>
#include <hip/hip_bf16.h>
#include <cstdio>
#include <cstdint>
#include <cmath>
#define GAS __attribute__((address_space(1)))
#define LAS __attribute__((address_space(3)))
typedef unsigned short bf16;
typedef unsigned v4u __attribute__((ext_vector_type(4)));
typedef float f32x4 __attribute__((ext_vector_type(4)));
typedef short bf16x8 __attribute__((ext_vector_type(8)));
typedef GAS unsigned gu32;
typedef GAS unsigned long long gu64;
#define RLX_AGENT __ATOMIC_RELAXED, __HIP_MEMORY_SCOPE_AGENT
#define LDS_WAIT() asm volatile("s_waitcnt lgkmcnt(0)" ::: "memory")
#define VM_WAIT() asm volatile("s_waitcnt vmcnt(0)" ::: "memory")
__device__ __forceinline__ unsigned long long rt() { return __builtin_amdgcn_s_memrealtime(); }
__device__ __forceinline__ unsigned f2bf(float f) { unsigned u = __builtin_bit_cast(unsigned, f); return (u + 0x7fffu + ((u >> 16) & 1u)) >> 16; }
__device__ __forceinline__ unsigned pk2(float lo, float hi) { return f2bf(lo) | (f2bf(hi) << 16); }

#define XB_TMO      128
#define XB_XCNT(j)  (256  + 64 * (j))
#define XB_XSUB(j)  (1280 + 64 * (j))
#define XB_XGEN(j)  (2304 + 64 * (j))
#define XB_TOP      3328
#define XB_TOPGEN   3392
#define XCD_BAR_WORDS 3456
#define XB_SPIN_CAP (1u << 18)

__device__ __forceinline__ unsigned xb_ld(unsigned* p)              { return __hip_atomic_load(p, __ATOMIC_RELAXED, __HIP_MEMORY_SCOPE_AGENT); }
__device__ __forceinline__ unsigned xb_add(unsigned* p, unsigned v) { return __hip_atomic_fetch_add(p, v, __ATOMIC_RELAXED, __HIP_MEMORY_SCOPE_AGENT); }
__device__ __forceinline__ unsigned xb_xcc_id() { return (unsigned)__builtin_amdgcn_s_getreg((3 << 11) | 20) & 0xFu; }
#define XB_SPIN(cond, bar) do { unsigned _sp = 0; while (cond) { __builtin_amdgcn_s_sleep(1); \
    if ((++_sp & 255u) == 0u) { if (xb_ld(&(bar)[XB_TMO])) break; if (_sp > XB_SPIN_CAP) { atomicAdd(&(bar)[XB_TMO], 1u); break; } } } } while (0)

struct XcdBarrier {
    unsigned* bar; unsigned x;
    volatile LAS unsigned* st;
};

__device__ __forceinline__ XcdBarrier xcd_barrier_post(unsigned* bar, volatile LAS unsigned* st) {
    XcdBarrier b; b.bar = bar; b.x = xb_xcc_id(); b.st = st;
    if (threadIdx.x == 0) (void)xb_add(&bar[XB_XCNT(b.x)], 1u);
    return b;
}
__device__ __forceinline__ void xcd_barrier_complete(unsigned* bar, unsigned x, unsigned& nloc, unsigned& nx) {
    const unsigned G = gridDim.x * gridDim.y * gridDim.z;
    unsigned sum, cnt, mine, sp = 0u;
    for (;;) {
        sum = 0u; cnt = 0u; mine = 0u;
#pragma unroll
        for (unsigned j = 0; j < 16; ++j) { const unsigned c = xb_ld(&bar[XB_XCNT(j)]); sum += c; cnt += (c > 0u) ? 1u : 0u; mine = (j == x) ? c : mine; }
        if (sum == G) break;
        __builtin_amdgcn_s_sleep(1);
        if ((++sp & 255u) == 0u) { if (xb_ld(&bar[XB_TMO])) break; if (sp > XB_SPIN_CAP) { atomicAdd(&bar[XB_TMO], 1u); break; } }
    }
    nloc = mine > 0u ? mine : 1u; nx = cnt > 0u ? cnt : 1u;
}

__device__ __forceinline__ void xcd_barrier(const XcdBarrier& b) {
    asm volatile("s_waitcnt vmcnt(0)" ::: "memory");
    __syncthreads();
    if (threadIdx.x == 0) {
        unsigned* bar = b.bar;
        __builtin_amdgcn_s_waitcnt(0);
        unsigned nloc = b.st[0], nx = b.st[1];
        if (nloc == 0u) { xcd_barrier_complete(bar, b.x, nloc, nx); b.st[0] = nloc; b.st[1] = nx; }
        const unsigned old = xb_add(&bar[XB_XSUB(b.x)], 1u);
        const unsigned gen = old / nloc;
        if (old + 1u == (gen + 1u) * nloc) {
            __builtin_amdgcn_fence(__ATOMIC_RELEASE, "agent");
            asm volatile("s_waitcnt vmcnt(0)" ::: "memory");
            const unsigned og = xb_add(&bar[XB_TOP], 1u);
            const unsigned tg = og / nx;
            if (og + 1u == (tg + 1u) * nx) xb_add(&bar[XB_TOPGEN], 1u);
            else XB_SPIN(xb_ld(&bar[XB_TOPGEN]) == tg, bar);
            __builtin_amdgcn_fence(__ATOMIC_ACQUIRE, "agent");
            xb_add(&bar[XB_XGEN(b.x)], 1u);
            asm volatile("s_waitcnt vmcnt(0)" ::: "memory");
        } else {
            XB_SPIN(xb_ld(&bar[XB_XGEN(b.x)]) == gen, bar);
            __builtin_amdgcn_fence(__ATOMIC_ACQUIRE, "agent");
            asm volatile("s_waitcnt vmcnt(0)" ::: "memory");
        }
    }
    __syncthreads();
}


namespace pg8 {
#define PG8_LAS __attribute__((address_space(3)))
typedef unsigned short bf16_t;
typedef short bf16x8 __attribute__((ext_vector_type(8)));
typedef float f32x4 __attribute__((ext_vector_type(4)));
typedef unsigned u32x4 __attribute__((ext_vector_type(4)));
typedef unsigned u32x2 __attribute__((ext_vector_type(2)));
constexpr int BM = 256, BK = 64, HALF = 128, HTB = HALF * BK * 2  , STAGE_BYTES = 8 * HTB, NXCD = 8, WGM = 8;

__host__ __device__ __forceinline__ int lds_byte(int r, int c) { const int st = (r >> 4) * 2 + (c >> 5), rr = r & 15, cc = c & 31, ob = rr * 64 + cc * 2; return st * 1024 + (ob ^ (((ob >> 9) & 1) << 5)); }
__host__ __device__ __forceinline__ void stage_rc(int b, int& R, int& C) { const int st = b / 1024, sb = b % 1024, swz = sb ^ (((sb >> 9) & 1) << 5); R = (st >> 1) * 16 + swz / 64; C = (st & 1) * 32 + (swz % 64) / 2; }
__host__ __device__ __forceinline__ int perm32(int rho) { const int n = rho >> 4, i = rho & 15; return 8 * (i >> 2) + 4 * n + (i & 3); }

struct Unit { int pm, pn, e, ui; };
struct Gemm { const bf16_t* A; int K; };

struct StaticOrder {
    int nM, nN, nwg, G, c, lda; const bf16_t* Bt; int K;
    __device__ void init(int M, int N, int K_, int lda_, const bf16_t* Bt_, int G_, int c_) { nM = M / BM; nN = N / BM; nwg = nM * nN; G = G_; c = c_; lda = lda_; Bt = Bt_; K = K_; }
    __device__ bool next(int i, Unit& u) const {
        const long L = (long)i * G + c; if (L >= nwg) return false;
        int wgid = (int)L; { const int q = nwg / NXCD, r = nwg % NXCD, xcd = wgid % NXCD, off = wgid / NXCD; wgid = (xcd < r ? xcd * (q + 1) : r * (q + 1) + (xcd - r) * q) + off; }
        const int nig = WGM * nN, gid = wgid / nig, fm = gid * WGM;
        u.pm = fm + ((wgid % nig) % WGM); u.pn = (wgid % nig) / WGM; u.e = 0; u.ui = i; return true;
    }
    __device__ __forceinline__ unsigned a_off(const Unit& u, int r, int C) const { return (unsigned)(((size_t)(u.pm * BM + r) * lda + C) * 2u); }
    __device__ __forceinline__ const char* b_base(const Unit& u) const { return (const char*)Bt + (size_t)u.pn * BM * K * 2; }
    __device__ __forceinline__ void a_ready(const Unit&) const {}
    __device__ __forceinline__ void done(const Unit&) const {}
};

typedef int v8i_t __attribute__((ext_vector_type(8))); typedef int v4i_t __attribute__((ext_vector_type(4)));
__device__ __forceinline__ v8i_t cat8(bf16x8 a, bf16x8 b) { const v4i_t x = __builtin_bit_cast(v4i_t, a), y = __builtin_bit_cast(v4i_t, b); return __builtin_shufflevector(x, y, 0, 1, 2, 3, 4, 5, 6, 7); }
__device__ __forceinline__ unsigned cvt_pk_bf16(float lo, float hi) { unsigned r; asm volatile("v_cvt_pk_bf16_f32 %0, %1, %2" : "=v"(r) : "v"(lo), "v"(hi)); return r; }

template <class Epi, class Sched, bool ALIGN_EPI = true, bool FP8 = false>
__device__ __forceinline__ void gemm_phase(PG8_LAS unsigned char* lds, const Gemm g, const Sched& S, const Epi& E, const int tid) {
    const int wid = __builtin_amdgcn_readfirstlane(tid >> 6), lane = tid & 63, wr = wid >> 2, wc = wid & 3, fr = lane & 15, fq = lane >> 4;
    const int K = g.K, nt = K / BK;
    unsigned voffB[2];
#pragma unroll
    for (int i = 0; i < 2; ++i) { int R, C; stage_rc(tid * 16 + i * 8192, R, C); const int Rb = Epi::PERM ? ((R & ~31) + perm32(R & 31)) : R; voffB[i] = (unsigned)(Rb * K + C) * 2u; }
#define PG8_AOFF(dst, unit) do { _Pragma("unroll") for (int _i = 0; _i < 2; ++_i) { int _R, _C; stage_rc(tid * 16 + _i * 8192, _R, _C); dst[0][_i] = S.a_off(unit, _R, _C); dst[1][_i] = S.a_off(unit, HALF + _R, _C); } } while (0)
    const size_t kstep = (size_t)(BK * 2);
    const size_t hstepB = (size_t)HALF * K * 2;
    const unsigned ldsw = (unsigned)wid * 1024u;
    const int aoff = lds_byte(wr * 64 + fr, fq * 8), boff = lds_byte(wc * 32 + fr, fq * 8);
#define PG8_SA(b, h) (((b) * 2 + (h)) * HTB)
#define PG8_SB(b, h) ((4 + (b) * 2 + (h)) * HTB)
#define PG8_STAGE(bufoff, gbase, voff) do { _Pragma("unroll") for (int _i = 0; _i < 2; ++_i) { unsigned _o = (voff)[_i]; asm volatile("" : "+v"(_o));     \
        __builtin_amdgcn_global_load_lds((const unsigned*)((const char*)(gbase) + _o), (PG8_LAS unsigned*)(lds + (bufoff) + ldsw + _i * 8192), 16, 0, 0); } } while (0)
#define PG8_LDA(dst, b, h) do { _Pragma("unroll") for (int m = 0; m < 4; ++m) { const v4i_t _lo = *(const PG8_LAS v4i_t*)(lds + PG8_SA(b, h) + aoff + m * 2048), _hi = *(const PG8_LAS v4i_t*)(lds + PG8_SA(b, h) + aoff + m * 2048 + 1024); \
        dst[m] = __builtin_shufflevector(_lo, _hi, 0, 1, 2, 3, 4, 5, 6, 7); } } while (0)
#define PG8_LDB(dst, b, h) do { _Pragma("unroll") for (int n = 0; n < 2; ++n) { const v4i_t _lo = *(const PG8_LAS v4i_t*)(lds + PG8_SB(b, h) + boff + n * 2048), _hi = *(const PG8_LAS v4i_t*)(lds + PG8_SB(b, h) + boff + n * 2048 + 1024); \
        dst[n] = __builtin_shufflevector(_lo, _hi, 0, 1, 2, 3, 4, 5, 6, 7); } } while (0)
#define PG8_LO(v) __builtin_bit_cast(bf16x8, __builtin_shufflevector(v, v, 0, 1, 2, 3))
#define PG8_HI(v) __builtin_bit_cast(bf16x8, __builtin_shufflevector(v, v, 4, 5, 6, 7))
#define PG8_MMA(ai, bj, At, Bt) do { __builtin_amdgcn_s_setprio(1); \
        if constexpr (FP8) { _Pragma("unroll") for (int m = 0; m < 4; ++m) _Pragma("unroll") for (int n = 0; n < 2; ++n) \
            asm volatile("v_mfma_scale_f32_16x16x128_f8f6f4 %0, %1, %2, %0, %3, %3 op_sel_hi:[0,0,0]" : "+v"(acc[ai][bj][m][n]) : "v"(Bt[n]), "v"(At[m]), "v"(sc1)); } \
        else { _Pragma("unroll") for (int m = 0; m < 4; ++m) _Pragma("unroll") for (int n = 0; n < 2; ++n) { \
            acc[ai][bj][m][n] = __builtin_amdgcn_mfma_f32_16x16x32_bf16(PG8_LO(Bt[n]), PG8_LO(At[m]), acc[ai][bj][m][n], 0, 0, 0); \
            acc[ai][bj][m][n] = __builtin_amdgcn_mfma_f32_16x16x32_bf16(PG8_HI(Bt[n]), PG8_HI(At[m]), acc[ai][bj][m][n], 0, 0, 0); } } \
        __builtin_amdgcn_s_setprio(0); } while (0)
#define PG8_WAIT_V(n) asm volatile("s_waitcnt vmcnt(" #n ")" ::: "memory")
#define PG8_WAIT_L(n) asm volatile("s_waitcnt lgkmcnt(" #n ")" ::: "memory")
#define PG8_BAR __builtin_amdgcn_s_barrier()
#define PG8_SCHED __builtin_amdgcn_sched_barrier(0)
    Unit cur, nxt; int ui = 0;
    if (!S.next(0, cur)) return;
    f32x4 acc[2][2][4][2];
    int sc1 = 0x7F7F7F7F; asm volatile("" : "+v"(sc1));
    typename Epi::Pre pre{};
    v8i_t At[4], B0[2], B1[2];
    const char* const Ab = (const char*)g.A;
    unsigned aoc[2][2];
    PG8_AOFF(aoc, cur);
    const char* cB = S.b_base(cur);
    S.a_ready(cur);
    PG8_STAGE(PG8_SB(0, 0), cB, voffB); PG8_STAGE(PG8_SB(0, 1), cB + hstepB, voffB); PG8_STAGE(PG8_SA(0, 0), Ab, aoc[0]); PG8_STAGE(PG8_SA(0, 1), Ab, aoc[1]);
    if (wr == 1) PG8_BAR;
    PG8_WAIT_V(2); PG8_BAR;
    PG8_STAGE(PG8_SB(1, 0), cB + kstep, voffB); PG8_STAGE(PG8_SA(1, 0), Ab + kstep, aoc[0]); PG8_STAGE(PG8_SB(1, 1), cB + hstepB + kstep, voffB);
    PG8_WAIT_V(6); PG8_BAR;
#pragma unroll
    for (int a = 0; a < 2; ++a)
#pragma unroll
        for (int b = 0; b < 2; ++b)
#pragma unroll
            for (int m = 0; m < 4; ++m)
#pragma unroll
                for (int n = 0; n < 2; ++n) acc[a][b][m][n] = (f32x4){0.f, 0.f, 0.f, 0.f};
    for (;;) {
        const bool has_next = S.next(ui + 1, nxt);
        const char* nB = has_next ? S.b_base(nxt) : cB;
        int t = 0;
#pragma unroll 1
        for (int seg = 0; seg < (Epi::MID_T >= 0 ? 2 : 1); ++seg) {
        const int tend = (Epi::MID_T >= 0 && seg == 0) ? Epi::MID_T : nt;
#pragma unroll 1
        for (; t < tend; t += 2) {
            const bool last = (t == nt - 2);
            if (last) pre = E.pre(cur, wr, wc, fr, fq);
            const char* a1 = Ab + (size_t)(t + 1) * kstep;
            const char* a2 = last ? Ab : Ab + (size_t)(t + 2) * kstep; const char* b2 = last ? nB : cB + (size_t)(t + 2) * kstep;
            const char* a3 = a2 + kstep; const char* b3 = b2 + kstep;
            unsigned o2[2][2];
#pragma unroll
            for (int h = 0; h < 2; ++h)
#pragma unroll
                for (int i = 0; i < 2; ++i) o2[h][i] = aoc[h][i];
            if (last && has_next) PG8_AOFF(o2, nxt);
            if (last && has_next) S.a_ready(nxt);
            PG8_LDB(B0, 0, 0); PG8_LDB(B1, 0, 1); PG8_SCHED; PG8_LDA(At, 0, 0); PG8_STAGE(PG8_SA(1, 1), a1, aoc[1]);
            PG8_WAIT_V(8); PG8_WAIT_L(0); PG8_BAR; PG8_MMA(0, 0, At, B0); PG8_MMA(0, 1, At, B1); PG8_BAR; PG8_SCHED;
            PG8_LDA(At, 0, 1); PG8_STAGE(PG8_SB(0, 0), b2, voffB); PG8_STAGE(PG8_SB(0, 1), b2 + hstepB, voffB); PG8_STAGE(PG8_SA(0, 0), a2, o2[0]);
            PG8_WAIT_V(8); PG8_WAIT_L(0); PG8_BAR; PG8_MMA(1, 0, At, B0); PG8_MMA(1, 1, At, B1); PG8_BAR; PG8_SCHED;
            PG8_LDB(B0, 1, 0); PG8_LDB(B1, 1, 1); PG8_SCHED; PG8_LDA(At, 1, 0); PG8_STAGE(PG8_SA(0, 1), a2, o2[1]);
            PG8_WAIT_V(8); PG8_WAIT_L(0); PG8_BAR; PG8_MMA(0, 0, At, B0); PG8_MMA(0, 1, At, B1); PG8_BAR; PG8_SCHED;
            PG8_LDA(At, 1, 1); PG8_STAGE(PG8_SB(1, 0), b3, voffB); PG8_STAGE(PG8_SB(1, 1), b3 + hstepB, voffB); PG8_STAGE(PG8_SA(1, 0), a3, o2[0]);
            PG8_WAIT_V(8); PG8_WAIT_L(0); PG8_BAR; PG8_MMA(1, 0, At, B0); PG8_MMA(1, 1, At, B1); PG8_BAR; PG8_SCHED;
        }
        if (Epi::MID_T >= 0) { if (seg == 0) E.mid(acc, cur, wr, wc, fr, fq); }
        }
        if constexpr (FP8) asm volatile("s_nop 15\n\ts_nop 7" ::: "memory");
        if constexpr (ALIGN_EPI) { if (wr == 0) PG8_BAR; }
        cur.pm = __builtin_amdgcn_readfirstlane(cur.pm); cur.pn = __builtin_amdgcn_readfirstlane(cur.pn); cur.e = __builtin_amdgcn_readfirstlane(cur.e); cur.ui = __builtin_amdgcn_readfirstlane(cur.ui);
        asm volatile("" : "+s"(cur.pm), "+s"(cur.pn), "+s"(cur.e), "+s"(cur.ui));
        { int t_ = tid; asm volatile("" : "+v"(t_)); const int fr_ = t_ & 15, fq_ = (t_ & 63) >> 4;
          E(acc, cur, wr, wc, fr_, fq_, pre); } S.done(cur);
        if (!has_next) break;
#pragma unroll
        for (int a = 0; a < 2; ++a)
#pragma unroll
            for (int b = 0; b < 2; ++b)
#pragma unroll
                for (int m = 0; m < 4; ++m)
#pragma unroll
                    for (int n = 0; n < 2; ++n) acc[a][b][m][n] = (f32x4){0.f, 0.f, 0.f, 0.f};
        cur = nxt; cB = nB; ++ui;
        PG8_AOFF(aoc, cur);
        if constexpr (ALIGN_EPI) { if (wr == 1) PG8_BAR; }
    }
    PG8_WAIT_V(0);
    if constexpr (!ALIGN_EPI) { if (wr == 0) PG8_BAR; }
    PG8_BAR;
#undef PG8_AOFF
#undef PG8_SA
#undef PG8_SB
#undef PG8_STAGE
#undef PG8_LDA
#undef PG8_LDB
#undef PG8_MMA
#undef PG8_LO
#undef PG8_HI
#undef PG8_WAIT_V
#undef PG8_WAIT_L
#undef PG8_BAR
#undef PG8_SCHED
}
}

namespace mk {
constexpr int T = 16384, D = 1024, SEQ = 2048, NB = 8, INW = 5632, NE = 32, DFF = 1024, NMOD = 6144;
constexpr int NW = 8, NTHR = 512;
constexpr float EPS = 1e-6f;
constexpr float W8_SCALE = 64.f, A8_SCALE = 8.f, MOE_DESCALE = 1.f / 512.f;
constexpr float C2 = 0.18033688011112042f;
constexpr int LDS_BYTES = 155648;
constexpr int RING_OFF = 0, TAB_OFF = 131072, MISC_OFF = 155648 - 256;

struct Params {
    const GAS float *x, *c; const GAS int* pos;
    const GAS float *w_mod, *b_mod, *g_pre_mix, *w_in, *lq1, *lk1, *lq2, *lk2, *g_sub, *w_pg, *pool_scale, *w_att, *w_pb, *w_out, *g_post_mix, *g_pre_ffn, *w_router, *b_router, *w_gu, *b_gu, *w_dn, *b_dn, *g_post_ffn;
    GAS float* out;
    GAS unsigned* ctl; GAS float* modp; GAS float* rope;
    GAS bf16 *Wt_in, *Wt_mix, *Wt_out, *Wt_pg, *Wt_gu, *Wt_dn;
    GAS bf16 *U, *QKV, *PB, *GR, *SGP, *AM, *MERGED, *MIXOUT, *ACT, *Y;
    GAS float* prob; GAS int* lists;
    int ph_lo, ph_hi, li, flags;
};
#define P_x ((const float*)p.x)
#define P_c ((const float*)p.c)
#define P_w_mod ((const float*)p.w_mod)
#define P_b_mod ((const float*)p.b_mod)
#define P_g_pre_mix ((const float*)p.g_pre_mix)
#define P_w_in ((const float*)p.w_in)
#define P_lq1 ((const float*)p.lq1)
#define P_lk1 ((const float*)p.lk1)
#define P_lq2 ((const float*)p.lq2)
#define P_lk2 ((const float*)p.lk2)
#define P_g_sub ((const float*)p.g_sub)
#define P_w_pg ((const float*)p.w_pg)
#define P_pool_scale ((const float*)p.pool_scale)
#define P_w_att ((const float*)p.w_att)
#define P_w_pb ((const float*)p.w_pb)
#define P_w_out ((const float*)p.w_out)
#define P_g_post_mix ((const float*)p.g_post_mix)
#define P_g_pre_ffn ((const float*)p.g_pre_ffn)
#define P_w_router ((const float*)p.w_router)
#define P_b_router ((const float*)p.b_router)
#define P_w_gu ((const float*)p.w_gu)
#define P_b_gu ((const float*)p.b_gu)
#define P_w_dn ((const float*)p.w_dn)
#define P_b_dn ((const float*)p.b_dn)
#define P_g_post_ffn ((const float*)p.g_post_ffn)
#define P_pos ((const int*)p.pos)
#define P_out ((float*)p.out)
#define P_ctl ((unsigned*)p.ctl)
#define P_modp ((float*)p.modp)
#define P_rope ((float*)p.rope)
#define P_prob ((float*)p.prob)
#define P_lists ((int*)p.lists)
#define P_Wt_in ((bf16*)p.Wt_in)
#define P_Wt_mix ((bf16*)p.Wt_mix)
#define P_Wt_out ((bf16*)p.Wt_out)
#define P_Wt_pg ((bf16*)p.Wt_pg)
#define P_Wt_gu ((bf16*)p.Wt_gu)
#define P_Wt_dn ((bf16*)p.Wt_dn)
#define P_U ((bf16*)p.U)
#define P_QKV ((bf16*)p.QKV)
#define P_PB ((bf16*)p.PB)
#define P_GR ((bf16*)p.GR)
#define P_SGP ((bf16*)p.SGP)
#define P_AM ((bf16*)p.AM)
#define P_MERGED ((bf16*)p.MERGED)
#define P_MIXOUT ((bf16*)p.MIXOUT)
#define P_ACT ((bf16*)p.ACT)
#define P_Y ((bf16*)p.Y)
constexpr int CW_TMO = 0, CW_CNT = 64  , CW_BAR = 4096  ;

__device__ __forceinline__ float wave_sum(float v) {
#pragma unroll
    for (int o = 1; o < 64; o <<= 1) v += __shfl_xor(v, o);
    return v;
}
__device__ __forceinline__ void tr_item(const float* W, int ldw, int k0, int n0, bf16* WT, int ldt, int drow0, int kcol0, LAS float* scr, int lane) {
#pragma unroll 8
    for (int i = 0; i < 32; ++i) { const int kk = 2 * i + (lane >> 5); scr[kk * 33 + (lane & 31)] = __builtin_nontemporal_load(&W[(size_t)(k0 + kk) * ldw + n0 + (lane & 31)]); }
    LDS_WAIT(); asm volatile("" ::: "memory");
    const int c = lane & 7;
#pragma unroll
    for (int j = 0; j < 4; ++j) { const int n = (lane >> 3) + 8 * j; const LAS float* s = scr + (8 * c) * 33 + n;
        v4u o; o.x = pk2(s[0 * 33], s[1 * 33]); o.y = pk2(s[2 * 33], s[3 * 33]); o.z = pk2(s[4 * 33], s[5 * 33]); o.w = pk2(s[6 * 33], s[7 * 33]);
        *(GAS v4u*)(WT + (size_t)(drow0 + n) * ldt + kcol0 + k0 + 8 * c) = o; }
    LDS_WAIT(); asm volatile("" ::: "memory");
}
__device__ __forceinline__ unsigned pk4_fp8(float a, float b, float c, float d) {
    a = fminf(fmaxf(a, -448.f), 448.f); b = fminf(fmaxf(b, -448.f), 448.f); c = fminf(fmaxf(c, -448.f), 448.f); d = fminf(fmaxf(d, -448.f), 448.f);
    int w = __builtin_amdgcn_cvt_pk_fp8_f32(a, b, 0, false); w = __builtin_amdgcn_cvt_pk_fp8_f32(c, d, w, true); return (unsigned)w; }
__device__ __forceinline__ void tr_item8(const float* W, int ldw, int k0, int n0, unsigned char* WT, int ldt, int drow0, LAS float* scr, int lane, float scale) {
#pragma unroll 8
    for (int i = 0; i < 64; ++i) { const int kk = 2 * i + (lane >> 5); scr[kk * 33 + (lane & 31)] = __builtin_nontemporal_load(&W[(size_t)(k0 + kk) * ldw + n0 + (lane & 31)]); }
    LDS_WAIT(); asm volatile("" ::: "memory");
    const int c = lane & 7;
#pragma unroll
    for (int j = 0; j < 4; ++j) { const int n = (lane >> 3) + 8 * j; const LAS float* s = scr + (16 * c) * 33 + n;
        v4u o; o.x = pk4_fp8(s[0 * 33] * scale, s[1 * 33] * scale, s[2 * 33] * scale, s[3 * 33] * scale); o.y = pk4_fp8(s[4 * 33] * scale, s[5 * 33] * scale, s[6 * 33] * scale, s[7 * 33] * scale);
        o.z = pk4_fp8(s[8 * 33] * scale, s[9 * 33] * scale, s[10 * 33] * scale, s[11 * 33] * scale); o.w = pk4_fp8(s[12 * 33] * scale, s[13 * 33] * scale, s[14 * 33] * scale, s[15 * 33] * scale);
        *(GAS v4u*)(WT + (size_t)(drow0 + n) * ldt + k0 + 16 * c) = o; }
    LDS_WAIT(); asm volatile("" ::: "memory");
}
__device__ __forceinline__ int ilv_row(int n, int H) { const int w = n >= H ? 1 : 0, c = n - w * H; return 256 * (c >> 7) + 128 * w + (c & 127); }

__device__ __forceinline__ void p0_prologue(const Params& p, LAS unsigned char* lds, int tid, int wave, int lane, int vcu, int G) {
    LAS float* sc = (LAS float*)lds;
    for (int i = tid; i < NB * D; i += NTHR) { const float cv = P_c[i]; sc[i] = cv / (1.f + expf(-cv)); }
    __syncthreads();
    const int gw = vcu * NW + wave, NGW = G * NW;
    for (int task = (wave < 3 ? vcu * 3 + wave : 96 * 8); task < 96 * 8; task += G * 3) {
        const int cg = task >> 3, ks = task & 7, col = cg * 64 + lane;
        float acc[NB];
#pragma unroll
        for (int b = 0; b < NB; ++b) acc[b] = 0.f;
#pragma unroll 4
        for (int k = ks * 128; k < ks * 128 + 128; ++k) { const float wv = __builtin_nontemporal_load(&P_w_mod[(size_t)k * NMOD + col]);
#pragma unroll
            for (int b = 0; b < NB; ++b) acc[b] += sc[b * D + k] * wv; }
#pragma unroll
        for (int b = 0; b < NB; ++b) P_modp[(size_t)(ks * NB + b) * NMOD + col] = acc[b];
    }
    __syncthreads();
    LAS float* scr = (LAS float*)(lds + wave * 17408);
    constexpr int I1 = 16 * 176, I2 = 16 * 32, I3 = 8 * 32, I4 = 16 * 32, I5 = 32, I6E = 8 * 64, I7E = 8 * 32;
    const int nitems = (p.flags & 1) ? (I1 + I2 + I3 + I4 + I5) : (I1 + I2 + I3 + I4 + I5 + NE * I6E + NE * I7E);
    for (int it = gw; it < nitems; it += NGW) {
        int r = it;
        if (r < I1) { const int kb = r / 176, nb = r % 176, n0 = nb * 32; const int dr = n0 < 3584 ? n0 : 3584 + ilv_row(n0 - 3584, 1024);
            tr_item(P_w_in, INW, kb * 64, n0, P_Wt_in, D, dr, 0, scr, lane); continue; } r -= I1;
        if (r < I2) { const int kb = r / 32, nb = r % 32; tr_item(P_w_att, D, kb * 64, nb * 32, P_Wt_mix, 1536, nb * 32, 0, scr, lane); continue; } r -= I2;
        if (r < I3) { const int kb = r / 32, nb = r % 32; tr_item(P_w_pb, D, kb * 64, nb * 32, P_Wt_mix, 1536, nb * 32, 1024, scr, lane); continue; } r -= I3;
        if (r < I4) { const int kb = r / 32, nb = r % 32; tr_item(P_w_out, D, kb * 64, nb * 32, P_Wt_out, D, nb * 32, 0, scr, lane); continue; } r -= I4;
        if (r < I5) { const int g = r >> 3, q = r & 7, kb = q >> 2, nb = q & 3; tr_item(P_w_pg + (size_t)g * 128 * 128, 128, kb * 64, nb * 32, P_Wt_pg + (size_t)g * 128 * 128, 128, nb * 32, 0, scr, lane); continue; } r -= I5;
        if (r < NE * I6E) { const int e = r / I6E, q = r % I6E, kb = q / 64, nb = q % 64, n0 = nb * 32;
            tr_item8(P_w_gu + (size_t)e * D * 2 * DFF, 2 * DFF, kb * 128, n0, (unsigned char*)P_Wt_gu + (size_t)e * 2 * DFF * D, D, ilv_row(n0, DFF), scr, lane, W8_SCALE); continue; } r -= NE * I6E;
        { const int e = r / I7E, q = r % I7E, kb = q / 32, nb = q % 32; tr_item8(P_w_dn + (size_t)e * DFF * D, D, kb * 128, nb * 32, (unsigned char*)P_Wt_dn + (size_t)e * D * DFF, DFF, nb * 32, scr, lane, W8_SCALE); }
    }
}
__device__ __forceinline__ double rope_invf(int i) {
    return i == 0 ? 1.0 : i == 1 ? 0.19392274474868576 : i == 2 ? 0.03760603093086393 : i == 3 ? 0.007292664737217109 : i == 4 ? 0.001414213562373095 : i == 5 ? 0.0002742481756762073 : i == 6 ? 5.318295896944988e-05 : 1.031338537721246e-05;
}
__device__ __forceinline__ f32x4 mod4(const Params& p, int b, int off, int k) {
    const float* base = P_modp + (size_t)b * NMOD + off + k;
    f32x4 t[9]; t[8] = *(const f32x4*)(P_b_mod + off + k);
#pragma unroll
    for (int ks = 0; ks < 8; ++ks) t[ks] = *(const f32x4*)(base + (size_t)ks * NB * NMOD);
    asm volatile("" : "+v"(t[0]), "+v"(t[1]), "+v"(t[2]), "+v"(t[3]), "+v"(t[4]), "+v"(t[5]), "+v"(t[6]), "+v"(t[7]), "+v"(t[8]));
    return t[8] + (((t[0] + t[1]) + (t[2] + t[3])) + ((t[4] + t[5]) + (t[6] + t[7])));
}
constexpr int MODF_OFF = 8 * NB * NMOD;
__device__ __forceinline__ void p1_rows(const Params& p, LAS unsigned char* lds, int tid, int wave, int lane, int vcu, int G) {
    LAS float* av = (LAS float*)lds; LAS float* sv = av + D;
    for (int grp = vcu; grp < T / 64; grp += G) {
        const int row0 = grp * 64 + wave * 8, b = row0 / SEQ;
        __syncthreads();
        { const int k = 4 * (tid & 255);
          if (tid < 256) *(LAS f32x4*)(av + k) = *(const f32x4*)(P_g_pre_mix + k) * (1.f + mod4(p, b, 1024, k)); else *(LAS f32x4*)(sv + k) = mod4(p, b, 0, k);
          if ((grp & 31) == 0) {
#pragma unroll
              for (int q = 0; q < 2; ++q) { const int vi = (tid >> 8) * 2 + q; const int off = vi == 0 ? 2048 : vi == 1 ? 3072 : vi == 2 ? 4096 : 5120;
                  *(f32x4*)(P_modp + MODF_OFF + (size_t)(b * 4 + vi) * D + k) = mod4(p, b, off, k); } } }
        __syncthreads();
        f32x4 a[4], sh[4];
#pragma unroll
        for (int j = 0; j < 4; ++j) { const int k = 4 * lane + 256 * j; a[j] = *(const LAS f32x4*)(av + k); sh[j] = *(const LAS f32x4*)(sv + k); }
#pragma unroll 1
        for (int rb = 0; rb < 8; rb += 4) {
            f32x4 v[4][4]; float ss[4];
#pragma unroll
            for (int r = 0; r < 4; ++r) { const GAS f32x4* xr = (const GAS f32x4*)(P_x + (size_t)(row0 + rb + r) * D) + lane;
#pragma unroll
                for (int j = 0; j < 4; ++j) v[r][j] = __builtin_nontemporal_load(xr + 64 * j); }
#pragma unroll
            for (int r = 0; r < 4; ++r) { float s = 0.f;
#pragma unroll
                for (int j = 0; j < 4; ++j) s += (v[r][j].x * v[r][j].x + v[r][j].y * v[r][j].y) + (v[r][j].z * v[r][j].z + v[r][j].w * v[r][j].w);
                ss[r] = s; }
#pragma unroll
            for (int o = 1; o < 64; o <<= 1) {
#pragma unroll
                for (int r = 0; r < 4; ++r) ss[r] += __shfl_xor(ss[r], o); }
#pragma unroll
            for (int r = 0; r < 4; ++r) { const int m = row0 + rb + r; const float rstd = 1.f / sqrtf(ss[r] * (1.f / D) + EPS);
                GAS unsigned long long* o8 = (GAS unsigned long long*)(P_U + (size_t)m * D) + lane;
#pragma unroll
                for (int j = 0; j < 4; ++j) { const f32x4 u = v[r][j] * rstd * a[j] + sh[j]; o8[64 * j] = (unsigned long long)pk2(u.x, u.y) | ((unsigned long long)pk2(u.z, u.w) << 32); } }
        }
        if (lane < 8) {
            const double invf = rope_invf(lane);
#pragma unroll 1
            for (int r = 0; r < 8; ++r) { const int m = row0 + r; const double ang = (double)P_pos[m] * invf; const double kk = __builtin_rint(ang * 0.15915494309189535);
                const float rr = (float)(ang - kk * 6.283185307179586); P_rope[(size_t)m * 16 + lane] = cosf(rr); P_rope[(size_t)m * 16 + 8 + lane] = sinf(rr); }
        }
    }
}
struct EpiZ {
    static constexpr bool PERM = true; static constexpr int MID_T = -1;
    bf16 *QKV, *PB, *GR, *SGP; const float* rope;
    struct Pre {}; __device__ __forceinline__ Pre pre(const pg8::Unit&, int, int, int, int) const { return Pre{}; }
    __device__ __forceinline__ void mid(pg8::f32x4 (&)[2][2][4][2], const pg8::Unit&, int, int, int, int) const {}
    __device__ __forceinline__ void operator()(const pg8::f32x4 (&acc)[2][2][4][2], const pg8::Unit& u, int wr, int wc, int fr, int fq, const Pre&) const {
        const int row0 = u.pm * 256 + wr * 64 + fr, pn = u.pn, cw = wc * 32 + 8 * fq;
        if (pn < 14) {
            const bool rp = pn < 8 && (wc & 1) == 0; const float sc = pn < 4 ? C2 : 1.f;
            bf16* base = pn < 12 ? QKV : PB; const int ld = pn < 12 ? 3072 : 512; const int colt = (pn < 12 ? pn : pn - 12) * 256 + cw;
#pragma unroll
            for (int ai = 0; ai < 2; ++ai)
#pragma unroll
                for (int m = 0; m < 4; ++m) {
                    const int row = row0 + ai * 128 + m * 16;
                    f32x4 c0 = {1.f, 1.f, 1.f, 1.f}, c1 = c0, s0 = {0.f, 0.f, 0.f, 0.f}, s1 = s0;
                    if (rp) { const f32x4* rt = (const f32x4*)(rope + (size_t)row * 16); c0 = rt[0]; c1 = rt[1]; s0 = rt[2]; s1 = rt[3]; }
#pragma unroll
                    for (int bj = 0; bj < 2; ++bj) {
                        f32x4 v0 = acc[ai][bj][m][0], v1 = acc[ai][bj][m][1];
                        if (rp) {
                            f32x4 p0, p1;
#pragma unroll
                            for (int j = 0; j < 4; ++j) { p0[j] = __shfl_xor(v0[j], 16); p1[j] = __shfl_xor(v1[j], 16); }
                            if (fq == 0) { v0 = v0 * c0 - p0 * s0; v1 = v1 * c1 - p1 * s1; }
                            else if (fq == 1) { v0 = v0 * c0 + p0 * s0; v1 = v1 * c1 + p1 * s1; }
                        }
                        v0 = v0 * sc; v1 = v1 * sc;
                        pg8::u32x4 w; w.x = pg8::cvt_pk_bf16(v0[0], v0[1]); w.y = pg8::cvt_pk_bf16(v0[2], v0[3]); w.z = pg8::cvt_pk_bf16(v1[0], v1[1]); w.w = pg8::cvt_pk_bf16(v1[2], v1[3]);
                        *(pg8::u32x4*)(base + (size_t)row * ld + colt + bj * 128) = w;
                    }
                }
        } else {
            const int colt = (pn - 14) * 128 + cw;
#pragma unroll
            for (int ai = 0; ai < 2; ++ai)
#pragma unroll
                for (int m = 0; m < 4; ++m) {
                    const int row = row0 + ai * 128 + m * 16;
                    float r[8], g[8];
#pragma unroll
                    for (int n = 0; n < 2; ++n)
#pragma unroll
                        for (int j = 0; j < 4; ++j) { const float a = fminf(fmaxf(acc[ai][0][m][n][j], -30.f), 30.f), b = fminf(fmaxf(acc[ai][1][m][n][j], -30.f), 30.f);
                            const float ea = __builtin_amdgcn_exp2f(-1.4426950408889634f * a), eb = __builtin_amdgcn_exp2f(-1.4426950408889634f * b); r[n * 4 + j] = (1.f + eb) * __builtin_amdgcn_rcpf(1.f + ea); g[n * 4 + j] = __builtin_amdgcn_rcpf(1.f + eb); }
                    pg8::u32x4 w; w.x = pg8::cvt_pk_bf16(r[0], r[1]); w.y = pg8::cvt_pk_bf16(r[2], r[3]); w.z = pg8::cvt_pk_bf16(r[4], r[5]); w.w = pg8::cvt_pk_bf16(r[6], r[7]);
                    *(pg8::u32x4*)(GR + (size_t)row * D + colt) = w;
                    w.x = pg8::cvt_pk_bf16(g[0], g[1]); w.y = pg8::cvt_pk_bf16(g[2], g[3]); w.z = pg8::cvt_pk_bf16(g[4], g[5]); w.w = pg8::cvt_pk_bf16(g[6], g[7]);
                    *(pg8::u32x4*)(SGP + (size_t)row * D + colt) = w;
                }
        }
    }
};
}

namespace mk {
__device__ __forceinline__ float bf2f(unsigned short v) { return __uint_as_float((unsigned)v << 16); }
__device__ __forceinline__ float lam_value(const Params& p) {
    float d1 = 0.f, d2 = 0.f;
    for (int i = 0; i < 64; ++i) { d1 += P_lq1[i] * P_lk1[i]; d2 += P_lq2[i] * P_lk2[i]; }
    return expf(d1) - expf(d2) + 0.2f;
}
__device__ __forceinline__ void attn_interim(const Params& p, LAS unsigned char* lds, int tid, int vcu, int G) {
    const float lam = lam_value(p);
    const int sub = tid >> 8, t = tid & 255, r = t >> 2, j = t & 3;
    LAS float* Ks1 = (LAS float*)(lds + sub * 65536); LAS float* Ks2 = Ks1 + 4096; LAS float* Vs = Ks2 + 4096;
    for (int it = 0;; ++it) {
        const int pi = vcu + G * it; if (pi >= 1024) break;
        const int cc = pi & 31, c = (it & 1) ? 31 - cc : cc;
        const int bh = 2 * (pi >> 5) + sub, b = bh >> 3, h = bh & 7;
        const size_t m = (size_t)b * SEQ + c * 64 + r;
        float q1[16], q2[16];
#pragma unroll
        for (int i = 0; i < 16; ++i) { q1[i] = bf2f(P_QKV[m * 3072 + (2 * h) * 64 + j * 16 + i]); q2[i] = bf2f(P_QKV[m * 3072 + (2 * h + 1) * 64 + j * 16 + i]); }
        float m1 = -INFINITY, l1 = 0.f, m2 = -INFINITY, l2 = 0.f, a1[32], a2[32];
#pragma unroll
        for (int d = 0; d < 32; ++d) { a1[d] = 0.f; a2[d] = 0.f; }
        for (int kt = 0; kt <= c; ++kt) {
            __syncthreads();
            for (int e = t; e < 64 * 64; e += 256) { const int kr = e >> 6, kc = e & 63; const size_t km = (size_t)b * SEQ + kt * 64 + kr;
                Ks1[e] = bf2f(P_QKV[km * 3072 + 1024 + (2 * h) * 64 + kc]); Ks2[e] = bf2f(P_QKV[km * 3072 + 1024 + (2 * h + 1) * 64 + kc]); }
            for (int e = t; e < 64 * 128; e += 256) { const int kr = e >> 7, kc = e & 127; const size_t km = (size_t)b * SEQ + kt * 64 + kr; Vs[e] = bf2f(P_QKV[km * 3072 + 2048 + h * 128 + kc]); }
            __syncthreads();
            for (int kk = 0; kk < 64; ++kk) {
                float s1 = 0.f, s2 = 0.f;
#pragma unroll
                for (int i = 0; i < 16; ++i) { s1 += q1[i] * Ks1[kk * 64 + j * 16 + i]; s2 += q2[i] * Ks2[kk * 64 + j * 16 + i]; }
                s1 += __shfl_xor(s1, 1); s1 += __shfl_xor(s1, 2); s2 += __shfl_xor(s2, 1); s2 += __shfl_xor(s2, 2);
                { const float mn = fmaxf(m1, s1), al = exp2f(m1 - mn), pp = exp2f(s1 - mn); l1 = l1 * al + pp; m1 = mn;
#pragma unroll
                  for (int d = 0; d < 32; ++d) a1[d] = a1[d] * al + pp * Vs[kk * 128 + j * 32 + d]; }
                { const float mn = fmaxf(m2, s2), al = exp2f(m2 - mn), pp = exp2f(s2 - mn); l2 = l2 * al + pp; m2 = mn;
#pragma unroll
                  for (int d = 0; d < 32; ++d) a2[d] = a2[d] * al + pp * Vs[kk * 128 + j * 32 + d]; }
            }
        }
        float ss = 0.f; const float i1 = 1.f / l1, i2 = lam / l2;
#pragma unroll
        for (int d = 0; d < 32; ++d) { a1[d] = a1[d] * i1 - a2[d] * i2; ss += a1[d] * a1[d]; }
        ss += __shfl_xor(ss, 1); ss += __shfl_xor(ss, 2);
        const float rstd = (1.f / sqrtf(ss * (1.f / 128.f) + EPS)) * 0.8f;
#pragma unroll
        for (int d = 0; d < 32; d += 2) { const float o0 = a1[d] * rstd * P_g_sub[j * 32 + d], o1 = a1[d + 1] * rstd * P_g_sub[j * 32 + d + 1];
            *(unsigned*)(P_AM + m * 1536 + h * 128 + j * 32 + d) = pk2(o0, o1); }
    }
    __syncthreads();
}
__device__ __forceinline__ void pool_phase(const Params& p, LAS unsigned char* lds, int tid, int wave, int lane, int vcu, int G) {
    LAS float* Pf = (LAS float*)lds;
    LAS unsigned short* Mx = (LAS unsigned short*)(lds + 144 * 128 * 4);
    const int fr = lane & 15, fq = lane >> 4;
    for (int unit = vcu; unit < 512; unit += G) {
        const int rt = unit >> 2, g = unit & 3, w = 2 << g, row0 = rt * 128, s0 = row0 & (SEQ - 1);
        for (int ch = tid; ch < 144 * 16; ch += NTHR) { const int r = ch >> 4, c8 = (ch & 15) * 8, tt = s0 - 16 + r;
            v4u raw = {0u, 0u, 0u, 0u};
            if (tt >= 0) raw = *(const GAS v4u*)(P_PB + (size_t)(row0 - 16 + r) * 512 + g * 128 + c8);
            LAS float* d = Pf + r * 128 + c8;
            d[0] = __uint_as_float(raw.x << 16); d[1] = __uint_as_float(raw.x & 0xffff0000u); d[2] = __uint_as_float(raw.y << 16); d[3] = __uint_as_float(raw.y & 0xffff0000u);
            d[4] = __uint_as_float(raw.z << 16); d[5] = __uint_as_float(raw.z & 0xffff0000u); d[6] = __uint_as_float(raw.w << 16); d[7] = __uint_as_float(raw.w & 0xffff0000u); }
        __syncthreads();
        { const int c = tid & 127, rb = (tid >> 7) * 32;
          float ssum = 0.f;
          for (int q = 0; q < w; ++q) ssum += Pf[(rb + 16 - q) * 128 + c];
          for (int i = 0; i < 32; ++i) { const int r = rb + i, s = s0 + r; const int cnt = (s + 1) < w ? (s + 1) : w;
              const float pv = Pf[(r + 16) * 128 + c]; const float mx = ssum * __builtin_amdgcn_rcpf((float)cnt) - pv;
              Mx[r * 136 + c] = (unsigned short)f2bf(mx);
              if (i < 31) ssum += Pf[(r + 17) * 128 + c] - Pf[(r + 17 - w) * 128 + c]; } }
        __syncthreads();
        f32x4 acc[8];
#pragma unroll
        for (int nt = 0; nt < 8; ++nt) acc[nt] = (f32x4){0.f, 0.f, 0.f, 0.f};
        const bf16* Wg = P_Wt_pg + (size_t)g * 128 * 128;
#pragma unroll
        for (int ks = 0; ks < 4; ++ks) {
            const bf16x8 a = *(const LAS bf16x8*)(Mx + (16 * wave + fr) * 136 + 32 * ks + 8 * fq);
#pragma unroll
            for (int nt = 0; nt < 8; ++nt) { const bf16x8 bw = *(const GAS bf16x8*)(Wg + (size_t)(16 * nt + fr) * 128 + 32 * ks + 8 * fq);
                acc[nt] = __builtin_amdgcn_mfma_f32_16x16x32_bf16(bw, a, acc[nt], 0, 0, 0); }
        }
        bf16* orow = P_AM + (size_t)(row0 + 16 * wave + fr) * 1536 + 1024 + g * 128;
#pragma unroll
        for (int nt = 0; nt < 8; ++nt) { const int d = 16 * nt + 4 * fq; const f32x4 sc = *(const f32x4*)(P_pool_scale + g * 128 + d); const f32x4 v = acc[nt] * sc;
            *(GAS unsigned long long*)(orow + d) = (unsigned long long)pk2(v[0], v[1]) | ((unsigned long long)pk2(v[2], v[3]) << 32); }
        __syncthreads();
    }
}
struct EpiMerge {
    static constexpr bool PERM = true; static constexpr int MID_T = 16;
    const bf16 *GR, *SGP; bf16* O;
    struct Pre {}; __device__ __forceinline__ Pre pre(const pg8::Unit&, int, int, int, int) const { return Pre{}; }
    __device__ __forceinline__ void scale(pg8::f32x4 (&acc)[2][2][4][2], const bf16* Sm, const pg8::Unit& u, int wr, int wc, int fr, int fq) const {
        const __amdgpu_buffer_rsrc_t rs = __builtin_amdgcn_make_buffer_rsrc((void*)Sm, 0, T * D * 2, 0x00020000);
        const int voff = ((u.pm * 256 + wr * 64 + fr) * D + u.pn * 256 + wc * 32 + 8 * fq) * 2;
#pragma unroll
        for (int ai = 0; ai < 2; ++ai)
#pragma unroll
            for (int m = 0; m < 4; ++m) {
#pragma unroll
                for (int bj = 0; bj < 2; ++bj) { const pg8::u32x4 w = __builtin_amdgcn_raw_buffer_load_b128(rs, voff, ((ai * 128 + m * 16) * D + bj * 128) * 2, 0);
                    acc[ai][bj][m][0][0] *= __uint_as_float(w.x << 16); acc[ai][bj][m][0][1] *= __uint_as_float(w.x & 0xffff0000u); acc[ai][bj][m][0][2] *= __uint_as_float(w.y << 16); acc[ai][bj][m][0][3] *= __uint_as_float(w.y & 0xffff0000u);
                    acc[ai][bj][m][1][0] *= __uint_as_float(w.z << 16); acc[ai][bj][m][1][1] *= __uint_as_float(w.z & 0xffff0000u); acc[ai][bj][m][1][2] *= __uint_as_float(w.w << 16); acc[ai][bj][m][1][3] *= __uint_as_float(w.w & 0xffff0000u); }
                asm volatile("" : "+v"(acc[ai][0][m][0]), "+v"(acc[ai][0][m][1]), "+v"(acc[ai][1][m][0]), "+v"(acc[ai][1][m][1])); asm volatile("" ::: "memory");
            }
    }
    __device__ __forceinline__ void mid(pg8::f32x4 (&acc)[2][2][4][2], const pg8::Unit& u, int wr, int wc, int fr, int fq) const { scale(acc, GR, u, wr, wc, fr, fq); }
    __device__ __forceinline__ void operator()(pg8::f32x4 (&acc)[2][2][4][2], const pg8::Unit& u, int wr, int wc, int fr, int fq, const Pre&) const {
        scale(acc, SGP, u, wr, wc, fr, fq);
        const int row0 = u.pm * 256 + wr * 64 + fr, col0 = u.pn * 256 + wc * 32 + 8 * fq;
#pragma unroll
        for (int ai = 0; ai < 2; ++ai)
#pragma unroll
            for (int m = 0; m < 4; ++m)
#pragma unroll
                for (int bj = 0; bj < 2; ++bj) { const pg8::f32x4 v0 = acc[ai][bj][m][0], v1 = acc[ai][bj][m][1];
                    pg8::u32x4 w; w.x = pg8::cvt_pk_bf16(v0[0], v0[1]); w.y = pg8::cvt_pk_bf16(v0[2], v0[3]); w.z = pg8::cvt_pk_bf16(v1[0], v1[1]); w.w = pg8::cvt_pk_bf16(v1[2], v1[3]);
                    *(pg8::u32x4*)(O + (size_t)(row0 + ai * 128 + m * 16) * D + col0 + bj * 128) = w; }
    }
};
struct EpiNull {
    static constexpr bool PERM = true; static constexpr int MID_T = -1;
    struct Pre {}; __device__ __forceinline__ Pre pre(const pg8::Unit&, int, int, int, int) const { return Pre{}; }
    __device__ __forceinline__ void mid(pg8::f32x4 (&)[2][2][4][2], const pg8::Unit&, int, int, int, int) const {}
    __device__ __forceinline__ void operator()(pg8::f32x4 (&acc)[2][2][4][2], const pg8::Unit&, int, int, int, int, const Pre&) const {
#pragma unroll
        for (int ai = 0; ai < 2; ++ai)
#pragma unroll
            for (int bj = 0; bj < 2; ++bj)
#pragma unroll
                for (int m = 0; m < 4; ++m) asm volatile("" :: "v"(acc[ai][bj][m][0]), "v"(acc[ai][bj][m][1]));
    }
};
struct EpiStore {
    static constexpr bool PERM = true; static constexpr int MID_T = -1;
    bf16* O; int ldc;
    struct Pre {}; __device__ __forceinline__ Pre pre(const pg8::Unit&, int, int, int, int) const { return Pre{}; }
    __device__ __forceinline__ void mid(pg8::f32x4 (&)[2][2][4][2], const pg8::Unit&, int, int, int, int) const {}
    __device__ __forceinline__ void operator()(pg8::f32x4 (&acc)[2][2][4][2], const pg8::Unit& u, int wr, int wc, int fr, int fq, const Pre&) const {
        const int row0 = u.pm * 256 + wr * 64 + fr, col0 = u.pn * 256 + wc * 32 + 8 * fq;
#pragma unroll
        for (int ai = 0; ai < 2; ++ai)
#pragma unroll
            for (int m = 0; m < 4; ++m)
#pragma unroll
                for (int bj = 0; bj < 2; ++bj) { const pg8::f32x4 v0 = acc[ai][bj][m][0], v1 = acc[ai][bj][m][1];
                    pg8::u32x4 w; w.x = pg8::cvt_pk_bf16(v0[0], v0[1]); w.y = pg8::cvt_pk_bf16(v0[2], v0[3]); w.z = pg8::cvt_pk_bf16(v1[0], v1[1]); w.w = pg8::cvt_pk_bf16(v1[2], v1[3]);
                    *(pg8::u32x4*)(O + (size_t)(row0 + ai * 128 + m * 16) * ldc + col0 + bj * 128) = w; }
    }
};
typedef float f32x16 __attribute__((ext_vector_type(16)));
__device__ __forceinline__ void p6_rows(const Params& p, LAS unsigned char* lds, int tid, int wave, int lane, int vcu, int G) {
    LAS float* tile = (LAS float*)lds;
    constexpr int RB = 1;
    float wreg[64];
#pragma unroll
    for (int i = 0; i < 64; ++i) wreg[i] = P_w_router[(size_t)(128 * wave + 2 * i + (lane >> 5)) * NE + (lane & 31)];
    for (int grp = vcu; grp < T / 64; grp += G) {
        const int b = (grp * 64) / SEQ;
        LAS float* vec = (LAS float*)(lds + TAB_OFF + 256);
        LAS int* lcnt = (LAS int*)(lds + TAB_OFF + 256 + 16384); LAS int* gbase = lcnt + 32; LAS int* pel = lcnt + 64;
        __syncthreads();
        if (tid < NE) lcnt[tid] = 0;
        if (tid < 256) { const int k = 4 * tid; const float* mf = P_modp + MODF_OFF + (size_t)b * 4 * D + k;
            const f32x4 a = *(const f32x4*)mf, g1 = *(const f32x4*)(P_g_post_mix + k), c = *(const f32x4*)(P_g_pre_ffn + k) * (1.f + *(const f32x4*)(mf + 2 * D)), d = *(const f32x4*)(mf + D);
            *(LAS f32x4*)(vec + k) = a; *(LAS f32x4*)(vec + 1024 + k) = g1; *(LAS f32x4*)(vec + 2048 + k) = c; *(LAS f32x4*)(vec + 3072 + k) = d; }
        __syncthreads();
#pragma unroll 1
        for (int half = 0; half < 2; ++half) {
#pragma unroll 1
            for (int sb = 0; sb < 4; sb += RB) {
                const int tr0 = wave * 4 + sb, m0 = grp * 64 + half * 32 + tr0;
                unsigned long long mw[RB][4]; f32x4 xv[RB][4]; float ss[RB];
#pragma unroll
                for (int rr = 0; rr < RB; ++rr)
#pragma unroll
                    for (int j = 0; j < 4; ++j) { mw[rr][j] = __builtin_nontemporal_load((const GAS unsigned long long*)(P_MIXOUT + (size_t)(m0 + rr) * D) + lane + 64 * j); xv[rr][j] = __builtin_nontemporal_load((const GAS f32x4*)(P_x + (size_t)(m0 + rr) * D) + lane + 64 * j); }
#define P6_UNPK(w) ((f32x4){__uint_as_float((unsigned)(w) << 16), __uint_as_float((unsigned)(w) & 0xffff0000u), __uint_as_float((unsigned)((w) >> 32) << 16), __uint_as_float((unsigned)((w) >> 32) & 0xffff0000u)})
#pragma unroll
                for (int rr = 0; rr < RB; ++rr) { float s = 0.f;
#pragma unroll
                    for (int j = 0; j < 4; ++j) { const f32x4 v = P6_UNPK(mw[rr][j]); s += (v.x * v.x + v.y * v.y) + (v.z * v.z + v.w * v.w); }
                    ss[rr] = s; }
#pragma unroll
                for (int o = 1; o < 64; o <<= 1) {
#pragma unroll
                    for (int rr = 0; rr < RB; ++rr) ss[rr] += __shfl_xor(ss[rr], o); }
#pragma unroll
                for (int rr = 0; rr < RB; ++rr) { const float rstd = 1.f / sqrtf(ss[rr] * (1.f / D) + EPS); GAS f32x4* orow = (GAS f32x4*)(P_out + (size_t)(m0 + rr) * D) + lane; float s = 0.f;
#pragma unroll
                    for (int j = 0; j < 4; ++j) { const int k = 4 * lane + 256 * j; const f32x4 v = P6_UNPK(mw[rr][j]);
                        const f32x4 x1 = xv[rr][j] + *(const LAS f32x4*)(vec + k) * (v * rstd * *(const LAS f32x4*)(vec + 1024 + k)); xv[rr][j] = x1; orow[64 * j] = x1; s += (x1.x * x1.x + x1.y * x1.y) + (x1.z * x1.z + x1.w * x1.w); }
                    ss[rr] = s; }
#undef P6_UNPK
#pragma unroll
                for (int o = 1; o < 64; o <<= 1) {
#pragma unroll
                    for (int rr = 0; rr < RB; ++rr) ss[rr] += __shfl_xor(ss[rr], o); }
#pragma unroll
                for (int rr = 0; rr < RB; ++rr) { const float rstd = 1.f / sqrtf(ss[rr] * (1.f / D) + EPS);
#pragma unroll
                    for (int j = 0; j < 4; ++j) { const int k = 4 * lane + 256 * j; const f32x4 u = xv[rr][j] * rstd * *(const LAS f32x4*)(vec + 2048 + k) + *(const LAS f32x4*)(vec + 3072 + k);
                        *((GAS unsigned*)((unsigned char*)P_U + (size_t)(m0 + rr) * D) + lane + 64 * j) = pk4_fp8(u.x * A8_SCALE, u.y * A8_SCALE, u.z * A8_SCALE, u.w * A8_SCALE);
                        LAS float* tp = tile + (tr0 + rr) * 1025 + k; tp[0] = u.x; tp[1] = u.y; tp[2] = u.z; tp[3] = u.w; } }
            }
            __syncthreads();
            f32x16 acc;
#pragma unroll
            for (int r = 0; r < 16; ++r) acc[r] = 0.f;
            { const LAS float* ap = tile + (lane & 31) * 1025 + 128 * wave + (lane >> 5);
#pragma unroll
              for (int i = 0; i < 64; ++i) acc = __builtin_amdgcn_mfma_f32_32x32x2f32(ap[2 * i], wreg[i], acc, 0, 0, 0); }
            __syncthreads();
            LAS float* part = (LAS float*)lds;
#pragma unroll
            for (int r = 0; r < 16; ++r) part[(wave * 32 + (r & 3) + 8 * (r >> 2) + 4 * (lane >> 5)) * 32 + (lane & 31)] = acc[r];
            __syncthreads();
#pragma unroll 1
            for (int rr = 0; rr < 4; ++rr) {
                const int tr = wave * 4 + rr, m = grp * 64 + half * 32 + tr;
                float mylg = -INFINITY;
                if (lane < 32) { float s = P_b_router[lane];
#pragma unroll
                    for (int w8 = 0; w8 < 8; ++w8) s += part[(w8 * 32 + tr) * 32 + lane];
                    mylg = s; }
                int sel[4]; float sv[4];
#pragma unroll
                for (int k = 0; k < 4; ++k) { float bv = mylg; int bi = lane;
#pragma unroll
                    for (int off = 1; off < 64; off <<= 1) { const float ov = __shfl_xor(bv, off); const int oi = __shfl_xor(bi, off);
                        if (ov > bv || (ov == bv && oi < bi)) { bv = ov; bi = oi; } }
                    sel[k] = bi; sv[k] = bv; if (lane == bi) mylg = -INFINITY; }
                float den = 0.f, pe[4];
#pragma unroll
                for (int k = 0; k < 4; ++k) { pe[k] = __expf(sv[k] - sv[0]); den += pe[k]; }
                if (lane == 0) {
#pragma unroll
                    for (int k = 0; k < 4; ++k) { P_prob[m * 4 + k] = pe[k] / den; const int loc = __hip_atomic_fetch_add(lcnt + sel[k], 1, __ATOMIC_RELAXED, __HIP_MEMORY_SCOPE_WORKGROUP);
                        pel[(half * 32 + tr) * 4 + k] = (sel[k] << 16) | loc; }
                }
            }
            __syncthreads();
        }
        if (tid < NE) { const int c = lcnt[tid]; gbase[tid] = c ? (int)__hip_atomic_fetch_add(P_ctl + CW_CNT + 64 * tid, (unsigned)c, __ATOMIC_RELAXED, __HIP_MEMORY_SCOPE_AGENT) : 0; }
        __syncthreads();
        if (tid < 256) { const int v = pel[tid], e = v >> 16, loc = v & 0xffff; P_lists[(size_t)e * T + gbase[e] + loc] = grp * 256 + tid; }
        __syncthreads();
    }
}
constexpr int MOE_MAXU = 10;
struct MoeSched {
    const bf16* Bt_all; size_t bstride; int K, ncol, a_shift, lda, G, c, total;
    const LAS int* pre;
    const LAS int* idx;
    const LAS int* utab;
    __device__ __forceinline__ bool locate(int i, pg8::Unit& u) const {
        const int L = (G == 256) ? ((i * 8 + (c & 7)) * 32 + (c >> 3)) : (i * G + c);
        if (L >= total || i >= MOE_MAXU) return false;
        const int RT = L / ncol; u.pn = L - RT * ncol;
        int e = 0;
#pragma unroll 1
        for (int q = 1; q < NE; ++q) e += (pre[q] <= RT) ? 1 : 0;
        u.e = e; u.pm = RT - pre[e]; u.ui = i; return true;
    }
    __device__ __forceinline__ bool next(int i, pg8::Unit& u) const {
        if (i >= MOE_MAXU) return false;
        const pg8::v4i_t t = *(const LAS pg8::v4i_t*)(utab + 4 * i);
        u.e = t[0]; u.pm = t[1]; u.pn = t[2]; u.ui = i; return t[3] != 0;
    }
    __device__ __forceinline__ unsigned a_off(const pg8::Unit& u, int r, int C) const {
        int pair = idx[u.ui * 256 + r]; if (pair < 0) pair = idx[u.ui * 256];
        return (unsigned)(((size_t)(pair >> a_shift) * lda + C) * 2u);
    }
    __device__ __forceinline__ const char* b_base(const pg8::Unit& u) const { return (const char*)(Bt_all + (size_t)u.e * bstride + (size_t)u.pn * 256 * K); }
    __device__ __forceinline__ void a_ready(const pg8::Unit&) const {}
    __device__ __forceinline__ void done(const pg8::Unit&) const {}
};
__device__ __forceinline__ void moe_setup(const Params& p, MoeSched& S, LAS int* pre, LAS int* idx, int tid) {
    LAS int* utab = pre + 48;
    LAS int* cnts = pre + 96;
    if (tid < NE) {
        const int c = (int)__hip_atomic_load(P_ctl + CW_CNT + 64 * tid, __ATOMIC_RELAXED, __HIP_MEMORY_SCOPE_AGENT); cnts[tid] = c;
        int v = (c + 255) >> 8;
#pragma unroll
        for (int o = 1; o < 32; o <<= 1) { const int t = __shfl_up(v, o); if (tid >= o) v += t; }
        pre[tid + 1] = v; if (tid == 0) pre[0] = 0;
    }
    __syncthreads();
    S.pre = pre; S.idx = idx; S.utab = utab; S.total = pre[NE] * S.ncol;
    for (int i = 0; i < MOE_MAXU; ++i) { pg8::Unit u; const bool ok = S.locate(i, u);
        if (tid == 0) { utab[4 * i] = ok ? u.e : 0; utab[4 * i + 1] = ok ? u.pm : 0; utab[4 * i + 2] = ok ? u.pn : 0; utab[4 * i + 3] = ok ? 1 : 0; }
        if (!ok) continue;
        if (tid < 256) { const int cnt = cnts[u.e]; const int r = u.pm * 256 + tid;
            idx[i * 256 + tid] = r < cnt ? P_lists[(size_t)u.e * T + r] : -1; } }
    __syncthreads();
}
struct EpiAct {
    static constexpr bool PERM = true; static constexpr int MID_T = -1;
    bf16* ACT; const float* b_gu; const LAS int* idx;
    struct Pre { f32x4 bg0, bg1, bu0, bu1; };
    __device__ __forceinline__ Pre pre(const pg8::Unit& u, int, int wc, int, int fq) const { const float* bg = b_gu + (size_t)u.e * 2 * DFF + u.pn * 128 + wc * 32 + 8 * fq;
        return Pre{*(const f32x4*)bg, *(const f32x4*)(bg + 4), *(const f32x4*)(bg + DFF), *(const f32x4*)(bg + DFF + 4)}; }
    __device__ __forceinline__ void mid(pg8::f32x4 (&)[2][2][4][2], const pg8::Unit&, int, int, int, int) const {}
    __device__ __forceinline__ void operator()(pg8::f32x4 (&acc)[2][2][4][2], const pg8::Unit& u, int wr, int wc, int fr, int fq, const Pre& q) const {
        const int col = u.pn * 128 + wc * 32 + 8 * fq;
        const f32x4 bg0 = q.bg0, bg1 = q.bg1, bu0 = q.bu0, bu1 = q.bu1;
#pragma unroll
        for (int ai = 0; ai < 2; ++ai)
#pragma unroll
            for (int m = 0; m < 4; ++m) {
                const int pair = idx[u.ui * 256 + ai * 128 + wr * 64 + m * 16 + fr];
                float o[8];
#pragma unroll
                for (int n = 0; n < 2; ++n)
#pragma unroll
                    for (int j = 0; j < 4; ++j) { float g = acc[ai][0][m][n][j] * MOE_DESCALE + (n ? bg1[j] : bg0[j]); float up = acc[ai][1][m][n][j] * MOE_DESCALE + (n ? bu1[j] : bu0[j]);
                        g = fminf(g, 7.f); up = fminf(fmaxf(up, -7.f), 7.f);
                        o[n * 4 + j] = (up * A8_SCALE + A8_SCALE) * (g * __builtin_amdgcn_rcpf(1.f + __builtin_amdgcn_exp2f(-2.4554669595930156f * g))); }
                if (pair >= 0) { pg8::u32x2 w; int w0 = __builtin_amdgcn_cvt_pk_fp8_f32(o[0], o[1], 0, false); w0 = __builtin_amdgcn_cvt_pk_fp8_f32(o[2], o[3], w0, true);
                    int w1 = __builtin_amdgcn_cvt_pk_fp8_f32(o[4], o[5], 0, false); w1 = __builtin_amdgcn_cvt_pk_fp8_f32(o[6], o[7], w1, true); w.x = (unsigned)w0; w.y = (unsigned)w1;
                    *(pg8::u32x2*)((unsigned char*)ACT + (size_t)pair * DFF + col) = w; }
            }
    }
};
struct EpiY {
    static constexpr bool PERM = true; static constexpr int MID_T = -1;
    bf16* Y; const float* b_dn; const LAS int* idx;
    struct Pre { f32x4 b00, b01, b10, b11; };
    __device__ __forceinline__ Pre pre(const pg8::Unit& u, int, int wc, int, int fq) const { const float* bb = b_dn + (size_t)u.e * D + u.pn * 256 + wc * 32 + 8 * fq;
        return Pre{*(const f32x4*)bb, *(const f32x4*)(bb + 4), *(const f32x4*)(bb + 128), *(const f32x4*)(bb + 132)}; }
    __device__ __forceinline__ void mid(pg8::f32x4 (&)[2][2][4][2], const pg8::Unit&, int, int, int, int) const {}
    __device__ __forceinline__ void operator()(pg8::f32x4 (&acc)[2][2][4][2], const pg8::Unit& u, int wr, int wc, int fr, int fq, const Pre& q) const {
        const int col0 = u.pn * 256 + wc * 32 + 8 * fq;
        f32x4 bv[2][2]; bv[0][0] = q.b00; bv[0][1] = q.b01; bv[1][0] = q.b10; bv[1][1] = q.b11;
#pragma unroll
        for (int ai = 0; ai < 2; ++ai)
#pragma unroll
            for (int m = 0; m < 4; ++m) {
                const int pair = idx[u.ui * 256 + ai * 128 + wr * 64 + m * 16 + fr];
                if (pair >= 0) {
#pragma unroll
                    for (int bj = 0; bj < 2; ++bj) { const pg8::f32x4 v0 = acc[ai][bj][m][0] * MOE_DESCALE + bv[bj][0], v1 = acc[ai][bj][m][1] * MOE_DESCALE + bv[bj][1];
                        pg8::u32x4 w; w.x = pg8::cvt_pk_bf16(v0[0], v0[1]); w.y = pg8::cvt_pk_bf16(v0[2], v0[3]); w.z = pg8::cvt_pk_bf16(v1[0], v1[1]); w.w = pg8::cvt_pk_bf16(v1[2], v1[3]);
                        *(pg8::u32x4*)(Y + (size_t)pair * D + col0 + bj * 128) = w; }
                }
            }
    }
};
__device__ __forceinline__ void p9_rows(const Params& p, int wave, int lane, int vcu, int G) {
    for (int grp = vcu; grp < T / 64; grp += G) {
        const int row0 = grp * 64 + wave * 8, b = row0 / SEQ;
        f32x4 gf[2][2];
#pragma unroll
        for (int j = 0; j < 2; ++j)
#pragma unroll
            for (int q = 0; q < 2; ++q) { const int k = 8 * lane + 512 * j + 4 * q; gf[j][q] = *(const f32x4*)(P_modp + MODF_OFF + (size_t)(b * 4 + 3) * D + k) * *(const f32x4*)(P_g_post_ffn + k); }
#pragma unroll 1
        for (int rb = 0; rb < 8; rb += 2) {
            v4u yw[2][4][2]; f32x4 xv[2][2][2]; f32x4 pr[2];
#pragma unroll
            for (int r = 0; r < 2; ++r) { const int m = row0 + rb + r; pr[r] = *(const f32x4*)(P_prob + (size_t)m * 4);
#pragma unroll
                for (int kk = 0; kk < 4; ++kk)
#pragma unroll
                    for (int j = 0; j < 2; ++j) yw[r][kk][j] = __builtin_nontemporal_load((const GAS v4u*)(P_Y + ((size_t)m * 4 + kk) * D) + lane + 64 * j);
#pragma unroll
                for (int j = 0; j < 2; ++j)
#pragma unroll
                    for (int q = 0; q < 2; ++q) xv[r][j][q] = *((const GAS f32x4*)(P_out + (size_t)m * D) + 2 * lane + 128 * j + q); }
            f32x4 f[2][2][2]; float ss[2];
#pragma unroll
            for (int r = 0; r < 2; ++r) { float s = 0.f;
#pragma unroll
                for (int j = 0; j < 2; ++j) { f32x4 f0 = {0.f, 0.f, 0.f, 0.f}, f1 = f0;
#pragma unroll
                    for (int kk = 0; kk < 4; ++kk) { const v4u w = yw[r][kk][j]; const float pk = pr[r][kk];
                        f0 += (f32x4){__uint_as_float(w.x << 16), __uint_as_float(w.x & 0xffff0000u), __uint_as_float(w.y << 16), __uint_as_float(w.y & 0xffff0000u)} * pk;
                        f1 += (f32x4){__uint_as_float(w.z << 16), __uint_as_float(w.z & 0xffff0000u), __uint_as_float(w.w << 16), __uint_as_float(w.w & 0xffff0000u)} * pk; }
                    f[r][j][0] = f0; f[r][j][1] = f1; s += (f0.x * f0.x + f0.y * f0.y) + (f0.z * f0.z + f0.w * f0.w) + (f1.x * f1.x + f1.y * f1.y) + (f1.z * f1.z + f1.w * f1.w); }
                ss[r] = s; }
#pragma unroll
            for (int o = 1; o < 64; o <<= 1) {
#pragma unroll
                for (int r = 0; r < 2; ++r) ss[r] += __shfl_xor(ss[r], o); }
#pragma unroll
            for (int r = 0; r < 2; ++r) { const int m = row0 + rb + r; const float rstd = 1.f / sqrtf(ss[r] * (1.f / D) + EPS);
#pragma unroll
                for (int j = 0; j < 2; ++j)
#pragma unroll
                    for (int q = 0; q < 2; ++q) __builtin_nontemporal_store(xv[r][j][q] + gf[j][q] * (f[r][j][q] * rstd), (GAS f32x4*)(P_out + (size_t)m * D) + 2 * lane + 128 * j + q); }
        }
    }
}
}

namespace mk {
namespace at {
typedef float f32x16 __attribute__((ext_vector_type(16)));
typedef short s16x4 __attribute__((ext_vector_type(4)));
typedef short v4i16_t __attribute__((ext_vector_type(4)));
typedef LAS const char* lds_cptr;
constexpr int KSLOT = 8192, VSLOT = 16384;
constexpr int L_K = 0, L_V = 3 * KSLOT, L_WS = L_V + 3 * VSLOT, L_ST = L_WS + NW * 256, L_END = L_ST + NW * 8192;
static_assert(L_END <= MISC_OFF, "attention LDS map");
__device__ __forceinline__ int crow(int r, int hi) { return (r & 3) + 8 * (r >> 2) + 4 * hi; }
__device__ __forceinline__ void glds16(const void* gsrc, unsigned lds_dst) { unsigned keep;
    asm volatile("s_mov_b32 %0, m0\n\ts_mov_b32 m0, %2\n\ts_nop 0\n\tglobal_load_lds_dwordx4 %1, off\n\ts_mov_b32 m0, %0" : "=&s"(keep) : "v"(gsrc), "s"(lds_dst) : "memory"); }
__device__ __forceinline__ void glds16s(const void* sbase, unsigned voff, unsigned lds_dst) { unsigned keep;
    asm volatile("s_mov_b32 %0, m0\n\ts_mov_b32 m0, %3\n\ts_nop 0\n\tglobal_load_lds_dwordx4 %1, %2\n\ts_mov_b32 m0, %0" : "=&s"(keep) : "v"(voff), "s"(sbase), "s"(lds_dst) : "memory"); }
__device__ __forceinline__ unsigned cvtpk(float lo, float hi) { typedef float f2 __attribute__((ext_vector_type(2))); typedef __bf16 b2 __attribute__((ext_vector_type(2))); f2 v = {lo, hi}; b2 b = __builtin_convertvector(v, b2); return __builtin_bit_cast(unsigned, b); }
__device__ __forceinline__ s16x4 vtr(lds_cptr p) { return __builtin_bit_cast(s16x4, __builtin_amdgcn_ds_read_tr16_b64_v4i16((LAS v4i16_t*)p)); }
__device__ __forceinline__ float swap_max(float m) { auto rr = __builtin_amdgcn_permlane32_swap(__float_as_uint(m), __float_as_uint(m), false, false); return fmaxf(__uint_as_float(rr[0]), __uint_as_float(rr[1])); }
__device__ __forceinline__ float swap_sum(float m) { auto rr = __builtin_amdgcn_permlane32_swap(__float_as_uint(m), __float_as_uint(m), false, false); return __uint_as_float(rr[0]) + __uint_as_float(rr[1]); }
#define AT_MFMA(a, b, c) __builtin_amdgcn_mfma_f32_32x32x16_bf16(a, b, c, 0, 0, 0)
__device__ __forceinline__ float at_max3(float a, float b, float c) { float r; asm("v_max3_f32 %0, %1, %2, %3" : "=v"(r) : "v"(a), "v"(b), "v"(c)); return r; }

constexpr float THRL = 8.f;
template <int VAR>
__device__ __forceinline__ void attn_unit(const Params& p, LAS unsigned char* lds, int tid, int b, int h, int qb, float lam, bf16* AMo) {
    const int lane = tid & 63, r32 = lane & 31, hi = lane >> 5; const int wid = __builtin_amdgcn_readfirstlane(tid >> 6);
    const size_t rowbase = (size_t)b * SEQ;
    const int q0 = qb * 256 + wid * 32;
    const int NT = 4 * qb + 4;
    const int my_last = 4 * qb + (wid >> 1);
    const unsigned lds0 = (unsigned)(uintptr_t)lds;
    LAS float* wsf = (LAS float*)(lds + L_WS) + wid * 64;
    const lds_cptr kp0 = (lds_cptr)(lds + L_K) + hi * 1024 + r32 * 16;
    const lds_cptr vp0 = (lds_cptr)(lds + L_V) + ((lane >> 4) & 1) * 32 + (lane & 3) * 8 + (4 * hi + ((lane & 15) >> 2)) * 64;
    LAS unsigned short* const stg = (LAS unsigned short*)(lds + L_ST + wid * 8192);
#pragma unroll 1
    for (int mp = 0; mp < 2; ++mp) {
        const int n = 2 * h + mp;
        bf16x8 qr[4];
        { const bf16* qw = P_QKV + (rowbase + q0 + r32) * 3072 + n * 64 + hi * 8;
#pragma unroll
          for (int d0 = 0; d0 < 4; ++d0) qr[d0] = *(const GAS bf16x8*)(qw + d0 * 16); }
        asm volatile("" : "+v"(qr[0]), "+v"(qr[1]), "+v"(qr[2]), "+v"(qr[3]));
        const char* kbase = (const char*)(P_QKV + rowbase * 3072 + 1024 + n * 64 + wid * 8);
        const char* vbase = (const char*)(P_QKV + (rowbase + 16 * (wid & 3)) * 3072 + 2048 + h * 128 + (wid >> 2) * 32);
        const unsigned klo = (unsigned)lane * 6144u, vlo = (unsigned)(lane >> 2) * 6144u + (unsigned)(lane & 3) * 16u;
#define AT_DMA(t, s) do { const size_t to_ = (size_t)(t) * 64 * 6144; \
                          glds16s(kbase + to_, klo, (unsigned)__builtin_amdgcn_readfirstlane(lds0 + L_K + (s) * KSLOT + wid * 1024)); \
                          glds16s(vbase + to_, vlo, (unsigned)__builtin_amdgcn_readfirstlane(lds0 + L_V + (s) * VSLOT + wid * 1024)); \
                          glds16s(vbase + to_ + 128, vlo, (unsigned)__builtin_amdgcn_readfirstlane(lds0 + L_V + (s) * VSLOT + (wid + 8) * 1024)); } while (0)
        AT_DMA(0, 0); AT_DMA(1, 1);
        f32x16 o[4];
        float mrow = 0.f, lsum = 0.f;
        int s = 0;
        f32x16 pA0, pA1, pB0, pB1;
        f32x16 negm = {0.f, 0.f, 0.f, 0.f, 0.f, 0.f, 0.f, 0.f, 0.f, 0.f, 0.f, 0.f, 0.f, 0.f, 0.f, 0.f};
#define AT_KRD(dst, kb, d0) do { dst[0] = *(const LAS bf16x8*)((kb) + (d0) * 2048); dst[1] = *(const LAS bf16x8*)((kb) + (d0) * 2048 + 512); } while (0)
#define AT_QK(P0, P1, sl) do { const lds_cptr kb_ = kp0 + (sl) * KSLOT; bf16x8 ka_[2], kb2_[2]; \
            AT_KRD(ka_, kb_, 0); AT_KRD(kb2_, kb_, 1); __builtin_amdgcn_sched_barrier(0); \
            P0 = AT_MFMA(ka_[0], qr[0], negm); P1 = AT_MFMA(ka_[1], qr[0], negm); AT_KRD(ka_, kb_, 2); __builtin_amdgcn_sched_barrier(0); \
            P0 = AT_MFMA(kb2_[0], qr[1], P0); P1 = AT_MFMA(kb2_[1], qr[1], P1); AT_KRD(kb2_, kb_, 3); __builtin_amdgcn_sched_barrier(0); \
            P0 = AT_MFMA(ka_[0], qr[2], P0); P1 = AT_MFMA(ka_[1], qr[2], P1); __builtin_amdgcn_sched_barrier(0); \
            P0 = AT_MFMA(kb2_[0], qr[3], P0); P1 = AT_MFMA(kb2_[1], qr[3], P1); __builtin_amdgcn_sched_barrier(0); } while (0)
#define AT_VRD(i, ks0) do { const s16x4 lo_ = vtr(vb_ + ((i) & 3) * 4096 + ((ks0) + ((i) >> 2)) * 1024), hh_ = vtr(vb_ + ((i) & 3) * 4096 + ((ks0) + ((i) >> 2)) * 1024 + 512); \
            F_[i] = (bf16x8){lo_[0], lo_[1], lo_[2], lo_[3], hh_[0], hh_[1], hh_[2], hh_[3]}; } while (0)
#define AT_MX3(a, b, c) at_max3(a, b, c)
#define AT_STEP(PC0, PC1, PN0, PN1, T) do { \
            asm volatile("s_waitcnt vmcnt(0) lgkmcnt(0)\n\ts_barrier" ::: "memory");     \
            const int s1_ = (s == 2) ? 0 : s + 1, s2_ = (s1_ == 2) ? 0 : s1_ + 1; \
            if ((T) + 2 < NT) AT_DMA((T) + 2, s2_); \
            if (VAR != 1 && (T) <= my_last) { \
                float ra_ = AT_MX3(PC0[0], PC0[1], PC1[0]), rb_ = AT_MX3(PC0[2], PC0[3], PC1[1]); ra_ = AT_MX3(ra_, PC1[2], PC1[3]); \
                _Pragma("unroll") for (int r = 4; r < 16; r += 4) { ra_ = AT_MX3(ra_, PC0[r], PC0[r + 1]); rb_ = AT_MX3(rb_, PC0[r + 2], PC0[r + 3]); ra_ = AT_MX3(ra_, PC1[r], PC1[r + 1]); rb_ = AT_MX3(rb_, PC1[r + 2], PC1[r + 3]); } \
                float rm_ = swap_max(fmaxf(ra_, rb_));                   \
                if ((T) == 0 || __any(rm_ > THRL)) {                      \
                    const float dl_ = ((T) == 0) ? rm_ : fmaxf(rm_, 0.f); \
                    mrow += dl_; \
                    _Pragma("unroll") for (int r = 0; r < 16; ++r) { PC0[r] -= dl_; PC1[r] -= dl_; negm[r] = -mrow; } \
                    if ((T) != 0) { const float al_ = __builtin_amdgcn_exp2f(-dl_); lsum *= al_; \
                        if (hi == 0) wsf[r32] = al_; \
                        asm volatile("s_waitcnt lgkmcnt(0)" ::: "memory"); \
                        _Pragma("unroll") for (int r = 0; r < 16; ++r) { const float f_ = wsf[crow(r, hi)]; \
                            _Pragma("unroll") for (int d0 = 0; d0 < 4; ++d0) o[d0][r] *= f_; } } } \
                __builtin_amdgcn_sched_barrier(0); \
                if ((T) + 1 <= my_last) AT_QK(PN0, PN1, s1_);             \
                if (VAR == 2) { asm volatile("" :: "v"(PC0), "v"(PC1)); } else { \
                const lds_cptr vb_ = vp0 + s * VSLOT; v4u pw_[4]; bf16x8 F_[8]; float sacc_ = 0.f; \
                if (VAR != 3) { AT_VRD(0, 0); AT_VRD(1, 0); AT_VRD(2, 0); AT_VRD(3, 0); AT_VRD(4, 0); AT_VRD(5, 0); AT_VRD(6, 0); AT_VRD(7, 0); }     \
                __builtin_amdgcn_sched_barrier(0); \
                _Pragma("unroll") for (int r = 0; r < 16; ++r) { PC0[r] = __builtin_amdgcn_exp2f(PC0[r]); sacc_ += PC0[r]; } \
                _Pragma("unroll") for (int i = 0; i < 4; ++i) { pw_[0][i] = cvtpk(PC0[2 * i], PC0[2 * i + 1]); pw_[1][i] = cvtpk(PC0[8 + 2 * i], PC0[9 + 2 * i]); } \
                __builtin_amdgcn_sched_barrier(0); \
                  \
                AT_GAP1(PC1, 0); AT_GAP1(PC1, 1); AT_GAP1(PC1, 2); AT_GAP1(PC1, 3); AT_GAP1(PC1, 4); AT_GAP1(PC1, 5); AT_GAP1(PC1, 6); AT_GAP1(PC1, 7); \
                _Pragma("unroll") for (int i = 0; i < 4; ++i) { pw_[2][i] = cvtpk(PC1[2 * i], PC1[2 * i + 1]); pw_[3][i] = cvtpk(PC1[8 + 2 * i], PC1[9 + 2 * i]); } \
                lsum += sacc_; \
                __builtin_amdgcn_sched_barrier(0); \
                if (VAR != 3) { _Pragma("unroll") for (int i = 0; i < 8; ++i) o[i & 3] = AT_MFMA(__builtin_bit_cast(bf16x8, pw_[2 + (i >> 2)]), F_[i], o[i & 3]); } else { asm volatile("" :: "v"(pw_[0]), "v"(pw_[1]), "v"(pw_[2]), "v"(pw_[3])); } \
                __builtin_amdgcn_sched_barrier(0); \
            } } \
            s = s1_; } while (0)
#define AT_GAP1(P1, i) do { if (VAR != 3) { o[(i) & 3] = AT_MFMA(__builtin_bit_cast(bf16x8, pw_[(i) >> 2]), F_[i], o[(i) & 3]); AT_VRD(i, 2); } \
            P1[2 * (i)] = __builtin_amdgcn_exp2f(P1[2 * (i)]); P1[2 * (i) + 1] = __builtin_amdgcn_exp2f(P1[2 * (i) + 1]); sacc_ += P1[2 * (i)]; sacc_ += P1[2 * (i) + 1]; \
            asm volatile("" : "+v"(P1), "+v"(sacc_)); __builtin_amdgcn_sched_barrier(0); } while (0)
        asm volatile("s_waitcnt vmcnt(3)\n\ts_barrier" ::: "memory");
#pragma unroll
        for (int r = 0; r < 16; ++r) {
#pragma unroll
            for (int d0 = 0; d0 < 4; ++d0) o[d0][r] = 0.f; }
        if (VAR != 1) AT_QK(pA0, pA1, 0);
        asm volatile("s_nop 7\n\ts_nop 7" ::: "memory");
#pragma unroll 1
        for (int t = 0; t < NT; t += 2) {
            AT_STEP(pA0, pA1, pB0, pB1, t);
            AT_STEP(pB0, pB1, pA0, pA1, t + 1);
        }
        asm volatile("s_waitcnt lgkmcnt(0)\n\ts_barrier" ::: "memory");
#undef AT_STEP
#undef AT_GAP1
#undef AT_MX3
#undef AT_VRD
#undef AT_QK
#undef AT_KRD
        int le_ = lane; asm volatile("" : "+v"(le_)); const int r32e = le_ & 31, hie = le_ >> 5;
        LAS unsigned short* const stge = (LAS unsigned short*)(lds + L_ST + wid * 8192) + r32e;
        lsum = swap_sum(lsum);
        if (hie == 0) wsf[32 + r32e] = 1.f / lsum;
        asm volatile("s_waitcnt lgkmcnt(0)" ::: "memory");
        float rli[16];
#pragma unroll
        for (int r = 0; r < 16; ++r) rli[r] = wsf[32 + crow(r, hie)];
        asm volatile("s_waitcnt lgkmcnt(0)" ::: "memory");
        if (mp == 0) {
#pragma unroll
            for (int r = 0; r < 16; ++r) { const int q = crow(r, hie);
#pragma unroll
                for (int d0 = 0; d0 < 4; ++d0) stge[q * 128 + 32 * d0] = (unsigned short)f2bf(o[d0][r] * rli[r]); }
            asm volatile("s_waitcnt lgkmcnt(0)" ::: "memory");
        } else {
            float ssq[16];
#pragma unroll
            for (int r = 0; r < 16; ++r) { ssq[r] = 0.f; const int q = crow(r, hie);
#pragma unroll
                for (int d0 = 0; d0 < 4; ++d0) { const float a0 = __uint_as_float((unsigned)stge[q * 128 + 32 * d0] << 16); const float v0 = a0 - lam * (o[d0][r] * rli[r]); o[d0][r] = v0; ssq[r] += v0 * v0; } }
            asm volatile("s_waitcnt lgkmcnt(0)" ::: "memory");
#pragma unroll
            for (int off = 1; off < 32; off <<= 1)
#pragma unroll
                for (int r = 0; r < 16; ++r) ssq[r] += __shfl_xor(ssq[r], off);
#pragma unroll
            for (int r = 0; r < 16; ++r) { const float rs = (1.f / sqrtf(ssq[r] * (1.f / 128.f) + EPS)) * 0.8f; const int q = crow(r, hie);
#pragma unroll
                for (int d0 = 0; d0 < 4; ++d0) { stge[q * 128 + 32 * d0] = (unsigned short)f2bf(o[d0][r] * rs * P_g_sub[r32e + 32 * d0]); } }
            asm volatile("s_waitcnt lgkmcnt(0)" ::: "memory");
            bf16* ow = AMo + (rowbase + q0) * 1536 + h * 128;
#pragma unroll
            for (int i = 0; i < 8; ++i) { const int row = i * 4 + (le_ >> 4), ch = le_ & 15; const v4u v = *(const LAS v4u*)(stge - r32e + row * 128 + ch * 8); *(GAS v4u*)(ow + (size_t)row * 1536 + ch * 8) = v; }
        }
#undef AT_DMA
    }
}
}
template <int VAR = 0>
__device__ __forceinline__ void attn_phase(const Params& p, LAS unsigned char* lds, int tid, int vcu, int G) {
    const float lam = lam_value(p);
    bf16* AMo = VAR == 0 ? P_AM : P_ACT;
    for (int pr = vcu; pr < 256; pr += G) {
        const int bh = pr >> 2, s = pr & 3, b = bh >> 3, h = bh & 7;
#pragma unroll 1
        for (int u = 0; u < 2; ++u) at::attn_unit<VAR>(p, lds, tid, b, h, u ? 7 - s : s, lam, AMo);
    }
}
}

namespace mk {
constexpr int NPH = 10;
#ifndef MK_SKIP
#define MK_SKIP 0
#endif
#ifndef MK_REPEAT
#define MK_REPEAT 0
#endif
#ifndef MK_PROFILE_PREFIX
#define MK_PROFILE_PREFIX 0
#endif
__global__ void __launch_bounds__(NTHR, 2) mega(Params p) {
    extern __shared__ __attribute__((aligned(16))) unsigned char lds_raw[];
    LAS unsigned char* lds = (LAS unsigned char*)lds_raw;
    volatile LAS unsigned* MISC = (volatile LAS unsigned*)(lds + MISC_OFF);
    const int tid0 = threadIdx.x;
    typedef __attribute__((address_space(4))) const Params CParams;
    CParams* const kp0 = (CParams*)__builtin_amdgcn_kernarg_segment_ptr();
#define FRESH int tid = tid0; asm volatile("" : "+v"(tid)); const int lane = tid & 63, wave = __builtin_amdgcn_readfirstlane(tid >> 6); (void)lane; (void)wave; \
              CParams* kp_ = kp0; asm volatile("" : "+s"(kp_)); Params p; { typedef __attribute__((address_space(4))) const unsigned long long cu64_; cu64_* s_ = (cu64_*)kp_; unsigned long long* d_ = (unsigned long long*)&p; \
              _Pragma("unroll") for (int i_ = 0; i_ < (int)(sizeof(Params) / 8); ++i_) d_[i_] = s_[i_]; }
    const int G = gridDim.x; const int bx = blockIdx.x; const int vcu = (G % 8 == 0) ? (bx % 8) * (G / 8) + bx / 8 : bx;
    if (tid0 < 64) MISC[tid0] = 0u;
    __syncthreads();
    XcdBarrier bar = xcd_barrier_post(P_ctl + CW_BAR + p.li * XCD_BAR_WORDS, MISC + 8);
    LAS int* pre = (LAS int*)(lds + TAB_OFF); LAS int* idx = (LAS int*)(lds + TAB_OFF + 512);
#ifdef MK_DOUBLE_BAR
#define SEAM(k) do { if (IN(k) && IN((k) + 1)) { xcd_barrier(bar); xcd_barrier(bar); } } while (0)
#else
#define SEAM(k) do { if (IN(k) && IN((k) + 1)) xcd_barrier(bar); } while (0)
#endif
#ifndef MK_ATTN_VAR
#define MK_ATTN_VAR 0
#endif
#define PHASE(k, ...) if (IN(k) && !(MK_SKIP & (1 << (k)))) { { FRESH; __VA_ARGS__ } if (MK_REPEAT & (1 << (k))) { __syncthreads(); FRESH; __VA_ARGS__ } } SEAM(k);
#ifdef MK_P2_NULL
#define PHASE_P2NULL if (IN(2)) { FRESH; pg8::Gemm g{P_U, D}; pg8::StaticOrder S; S.init(T, INW, D, D, P_Wt_in, G, bx); EpiNull E{}; pg8::gemm_phase<EpiNull, pg8::StaticOrder, true>(lds + RING_OFF, g, S, E, tid); xcd_barrier(bar); }
#else
#define PHASE_P2NULL
#endif
#ifdef MK_P7_NULL
#define PHASE_P7NULL if (IN(7)) { FRESH; MoeSched S{P_Wt_gu, (size_t)2 * DFF * D / 2, D / 2, 8, 2, D / 2, G, bx, 0, nullptr, nullptr, nullptr}; moe_setup(p, S, pre, idx, tid); pg8::Gemm g{P_U, D / 2}; EpiNull E{}; pg8::gemm_phase<EpiNull, MoeSched, true, true>(lds + RING_OFF, g, S, E, tid); xcd_barrier(bar); }
#else
#define PHASE_P7NULL
#endif
#define PROGRAM \
    PHASE(0, p0_prologue(p, lds, tid, wave, lane, vcu, G);) \
    PHASE(1, p1_rows(p, lds, tid, wave, lane, vcu, G);) \
    PHASE(2, pg8::Gemm g{P_U, D}; pg8::StaticOrder S; S.init(T, INW, D, D, P_Wt_in, G, bx); \
             EpiZ E{P_QKV, P_PB, P_GR, P_SGP, P_rope}; \
             pg8::gemm_phase<EpiZ, pg8::StaticOrder, true>(lds + RING_OFF, g, S, E, tid);) \
    PHASE_P2NULL \
    PHASE(3, if (!(p.flags & 2)) attn_phase<0>(p, lds, tid, vcu, G); \
             pool_phase(p, lds, tid, wave, lane, vcu, G); \
             if (MK_ATTN_VAR) { __syncthreads(); attn_phase<MK_ATTN_VAR>(p, lds, tid, vcu, G); }) \
    PHASE(4, pg8::Gemm g{P_AM, 1536}; pg8::StaticOrder S; S.init(T, D, 1536, 1536, P_Wt_mix, G, bx); \
             EpiMerge E{P_GR, P_SGP, P_MERGED}; \
             pg8::gemm_phase<EpiMerge, pg8::StaticOrder, true>(lds + RING_OFF, g, S, E, tid);) \
    PHASE(5, if (MK_PROFILE_PREFIX && bx == 0 && tid < NE) __hip_atomic_store(P_ctl + CW_CNT + 64 * tid, 0u, __ATOMIC_RELAXED, __HIP_MEMORY_SCOPE_AGENT); \
             pg8::Gemm g{P_MERGED, D}; pg8::StaticOrder S; S.init(T, D, D, D, P_Wt_out, G, bx); \
             EpiStore E{P_MIXOUT, D}; \
             pg8::gemm_phase<EpiStore, pg8::StaticOrder, true>(lds + RING_OFF, g, S, E, tid);) \
    PHASE(6, p6_rows(p, lds, tid, wave, lane, vcu, G);) \
    PHASE(7, MoeSched S{P_Wt_gu, (size_t)2 * DFF * D / 2, D / 2, 8, 2, D / 2, G, bx, 0, nullptr, nullptr, nullptr};     \
             moe_setup(p, S, pre, idx, tid); \
             pg8::Gemm g{P_U, D / 2}; EpiAct E{P_ACT, P_b_gu, idx}; \
             pg8::gemm_phase<EpiAct, MoeSched, true, true>(lds + RING_OFF, g, S, E, tid);) \
    PHASE_P7NULL \
    PHASE(8, MoeSched S{P_Wt_dn, (size_t)D * DFF / 2, DFF / 2, 4, 0, DFF / 2, G, bx, 0, nullptr, nullptr, nullptr}; \
             moe_setup(p, S, pre, idx, tid); \
             pg8::Gemm g{P_ACT, DFF / 2}; EpiY E{P_Y, P_b_dn, idx}; \
             pg8::gemm_phase<EpiY, MoeSched, true, true>(lds + RING_OFF, g, S, E, tid);) \
    PHASE(9, p9_rows(p, wave, lane, vcu, G);)
#if MK_PROFILE_PREFIX
    {
#define IN(k) ((k) < MK_PROFILE_PREFIX)
        PROGRAM
#undef IN
        xcd_barrier(bar);
    }
#endif
    {
        const int lo = p.ph_lo, hi = p.ph_hi;
#define IN(k) (lo <= (k) && (k) < hi)
        PROGRAM
#undef IN
    }
#undef PROGRAM
#undef SEAM
#undef PHASE
#undef FRESH
}
}

static int g_grid = 0;
static int mk_setup() {
    if (g_grid) return g_grid;
    int dev = 0, cus = 0;
    if (hipGetDevice(&dev) != hipSuccess || hipDeviceGetAttribute(&cus, hipDeviceAttributeMultiprocessorCount, dev) != hipSuccess) { g_grid = -1; return -1; }
    if (hipFuncSetAttribute((const void*)mk::mega, hipFuncAttributeMaxDynamicSharedMemorySize, mk::LDS_BYTES) != hipSuccess) { g_grid = -1; return -1; }
    int per_cu = 0;
    if (hipOccupancyMaxActiveBlocksPerMultiprocessor(&per_cu, (const void*)mk::mega, mk::NTHR, mk::LDS_BYTES) != hipSuccess || per_cu < 1) { fprintf(stderr, "kernel_launch: occupancy query reports %d workgroups per CU\n", per_cu); }
    (void)hipGetLastError();
    g_grid = cus;
    return g_grid;
}
extern "C" void kernel_launch(void* const* d_in, const int* in_sizes, int n_in, void* d_out, int out_size, void* d_ws, size_t ws_size, hipStream_t stream) {
    if (mk_setup() < 0 || n_in != 26) return;
    unsigned char* wsb = (unsigned char*)d_ws;
    const size_t MiB = 1u << 20;
    mk::Params p{};
    p.x = (const GAS float*)d_in[0]; p.c = (const GAS float*)d_in[1]; p.pos = (const GAS int*)d_in[2]; p.w_mod = (const GAS float*)d_in[3]; p.b_mod = (const GAS float*)d_in[4]; p.g_pre_mix = (const GAS float*)d_in[5];
    p.w_in = (const GAS float*)d_in[6]; p.lq1 = (const GAS float*)d_in[7]; p.lk1 = (const GAS float*)d_in[8]; p.lq2 = (const GAS float*)d_in[9]; p.lk2 = (const GAS float*)d_in[10]; p.g_sub = (const GAS float*)d_in[11];
    p.w_pg = (const GAS float*)d_in[12]; p.pool_scale = (const GAS float*)d_in[13]; p.w_att = (const GAS float*)d_in[14]; p.w_pb = (const GAS float*)d_in[15]; p.w_out = (const GAS float*)d_in[16];
    p.g_post_mix = (const GAS float*)d_in[17]; p.g_pre_ffn = (const GAS float*)d_in[18]; p.w_router = (const GAS float*)d_in[19]; p.b_router = (const GAS float*)d_in[20];
    p.w_gu = (const GAS float*)d_in[21]; p.b_gu = (const GAS float*)d_in[22]; p.w_dn = (const GAS float*)d_in[23]; p.b_dn = (const GAS float*)d_in[24]; p.g_post_ffn = (const GAS float*)d_in[25];
    p.out = (GAS float*)d_out;
    size_t off = 0;
    auto carve = [&](size_t mib) { unsigned char* r = wsb + off; off += mib * MiB; return r; };
    p.ctl = (GAS unsigned*)carve(1); p.modp = (GAS float*)carve(2); p.rope = (GAS float*)carve(1);
    p.Wt_in = (GAS bf16*)carve(11); p.Wt_mix = (GAS bf16*)carve(3); p.Wt_out = (GAS bf16*)carve(2); p.Wt_pg = (GAS bf16*)carve(1);
    p.prob = (GAS float*)carve(1); p.lists = (GAS int*)carve(2);
    p.U = (GAS bf16*)carve(32); p.QKV = (GAS bf16*)carve(96); p.PB = (GAS bf16*)carve(16); p.GR = (GAS bf16*)carve(32); p.SGP = (GAS bf16*)carve(32);
    p.AM = (GAS bf16*)carve(48); p.MERGED = (GAS bf16*)carve(32); p.MIXOUT = (GAS bf16*)carve(32);
    p.Wt_gu = (GAS bf16*)carve(128); p.Wt_dn = (GAS bf16*)carve(64); p.ACT = (GAS bf16*)carve(128); p.Y = (GAS bf16*)carve(128);
    if (off > ws_size) { fprintf(stderr, "kernel_launch: workspace too small: need %zu, have %zu\n", off, ws_size); return; }
    p.flags = 0; p.ph_lo = 0; p.ph_hi = mk::NPH; p.li = 0;
    if (hipMemsetAsync(wsb, 0, 1 * MiB, stream) != hipSuccess) return;
    hipLaunchKernelGGL(mk::mega, dim3(g_grid), dim3(mk::NTHR), mk::LDS_BYTES, stream, p);
}
```

```cpp
#include <hip/hip_runtime.h>
#include <hip/hip_bf16.h>
#include <cstdio>
#include <cstdint>
#include <cmath>
#define GAS __attribute__((address_space(1)))
#define LAS __attribute__((address_space(3)))
typedef unsigned short bf16;
typedef unsigned v4u __attribute__((ext_vector_type(4)));
typedef float f32x4 __attribute__((ext_vector_type(4)));
typedef short bf16x8 __attribute__((ext_vector_type(8)));
typedef GAS unsigned gu32;
typedef GAS unsigned long long gu64;
#define RLX_AGENT __ATOMIC_RELAXED, __HIP_MEMORY_SCOPE_AGENT
#define LDS_WAIT() asm volatile("s_waitcnt lgkmcnt(0)" ::: "memory")
#define VM_WAIT() asm volatile("s_waitcnt vmcnt(0)" ::: "memory")
__device__ __forceinline__ unsigned long long rt() { return __builtin_amdgcn_s_memrealtime(); }
__device__ __forceinline__ unsigned f2bf(float f) { unsigned u = __builtin_bit_cast(unsigned, f); return (u + 0x7fffu + ((u >> 16) & 1u)) >> 16; }
__device__ __forceinline__ unsigned pk2(float lo, float hi) { return f2bf(lo) | (f2bf(hi) << 16); }

#define XB_TMO      128
#define XB_XCNT(j)  (256  + 64 * (j))
#define XB_XSUB(j)  (1280 + 64 * (j))
#define XB_XGEN(j)  (2304 + 64 * (j))
#define XB_TOP      3328
#define XB_TOPGEN   3392
#define XCD_BAR_WORDS 3456
#define XB_SPIN_CAP (1u << 18)

__device__ __forceinline__ unsigned xb_ld(unsigned* p)              { return __hip_atomic_load(p, __ATOMIC_RELAXED, __HIP_MEMORY_SCOPE_AGENT); }
__device__ __forceinline__ unsigned xb_add(unsigned* p, unsigned v) { return __hip_atomic_fetch_add(p, v, __ATOMIC_RELAXED, __HIP_MEMORY_SCOPE_AGENT); }
__device__ __forceinline__ unsigned xb_xcc_id() { return (unsigned)__builtin_amdgcn_s_getreg((3 << 11) | 20) & 0xFu; }
#define XB_SPIN(cond, bar) do { unsigned _sp = 0; while (cond) { __builtin_amdgcn_s_sleep(1); \
    if ((++_sp & 255u) == 0u) { if (xb_ld(&(bar)[XB_TMO])) break; if (_sp > XB_SPIN_CAP) { atomicAdd(&(bar)[XB_TMO], 1u); break; } } } } while (0)

struct XcdBarrier {
    unsigned* bar; unsigned x;
    volatile LAS unsigned* st;
};

__device__ __forceinline__ XcdBarrier xcd_barrier_post(unsigned* bar, volatile LAS unsigned* st) {
    XcdBarrier b; b.bar = bar; b.x = xb_xcc_id(); b.st = st;
    if (threadIdx.x == 0) (void)xb_add(&bar[XB_XCNT(b.x)], 1u);
    return b;
}
__device__ __forceinline__ void xcd_barrier_complete(unsigned* bar, unsigned x, unsigned& nloc, unsigned& nx) {
    const unsigned G = gridDim.x * gridDim.y * gridDim.z;
    unsigned sum, cnt, mine, sp = 0u;
    for (;;) {
        sum = 0u; cnt = 0u; mine = 0u;
#pragma unroll
        for (unsigned j = 0; j < 16; ++j) { const unsigned c = xb_ld(&bar[XB_XCNT(j)]); sum += c; cnt += (c > 0u) ? 1u : 0u; mine = (j == x) ? c : mine; }
        if (sum == G) break;
        __builtin_amdgcn_s_sleep(1);
        if ((++sp & 255u) == 0u) { if (xb_ld(&bar[XB_TMO])) break; if (sp > XB_SPIN_CAP) { atomicAdd(&bar[XB_TMO], 1u); break; } }
    }
    nloc = mine > 0u ? mine : 1u; nx = cnt > 0u ? cnt : 1u;
}

__device__ __forceinline__ void xcd_barrier(const XcdBarrier& b) {
    asm volatile("s_waitcnt vmcnt(0)" ::: "memory");
    __syncthreads();
    if (threadIdx.x == 0) {
        unsigned* bar = b.bar;
        __builtin_amdgcn_s_waitcnt(0);
        unsigned nloc = b.st[0], nx = b.st[1];
        if (nloc == 0u) { xcd_barrier_complete(bar, b.x, nloc, nx); b.st[0] = nloc; b.st[1] = nx; }
        const unsigned old = xb_add(&bar[XB_XSUB(b.x)], 1u);
        const unsigned gen = old / nloc;
        if (old + 1u == (gen + 1u) * nloc) {
            __builtin_amdgcn_fence(__ATOMIC_RELEASE, "agent");
            asm volatile("s_waitcnt vmcnt(0)" ::: "memory");
            const unsigned og = xb_add(&bar[XB_TOP], 1u);
            const unsigned tg = og / nx;
            if (og + 1u == (tg + 1u) * nx) xb_add(&bar[XB_TOPGEN], 1u);
            else XB_SPIN(xb_ld(&bar[XB_TOPGEN]) == tg, bar);
            __builtin_amdgcn_fence(__ATOMIC_ACQUIRE, "agent");
            xb_add(&bar[XB_XGEN(b.x)], 1u);
            asm volatile("s_waitcnt vmcnt(0)" ::: "memory");
        } else {
            XB_SPIN(xb_ld(&bar[XB_XGEN(b.x)]) == gen, bar);
            __builtin_amdgcn_fence(__ATOMIC_ACQUIRE, "agent");
            asm volatile("s_waitcnt vmcnt(0)" ::: "memory");
        }
    }
    __syncthreads();
}


namespace pg8 {
#define PG8_LAS __attribute__((address_space(3)))
typedef unsigned short bf16_t;
typedef short bf16x8 __attribute__((ext_vector_type(8)));
typedef float f32x4 __attribute__((ext_vector_type(4)));
typedef unsigned u32x4 __attribute__((ext_vector_type(4)));
typedef unsigned u32x2 __attribute__((ext_vector_type(2)));
constexpr int BM = 256, BK = 64, HALF = 128, HTB = HALF * BK * 2  , STAGE_BYTES = 8 * HTB, NXCD = 8, WGM = 8;

__host__ __device__ __forceinline__ int lds_byte(int r, int c) { const int st = (r >> 4) * 2 + (c >> 5), rr = r & 15, cc = c & 31, ob = rr * 64 + cc * 2; return st * 1024 + (ob ^ (((ob >> 9) & 1) << 5)); }
__host__ __device__ __forceinline__ void stage_rc(int b, int& R, int& C) { const int st = b / 1024, sb = b % 1024, swz = sb ^ (((sb >> 9) & 1) << 5); R = (st >> 1) * 16 + swz / 64; C = (st & 1) * 32 + (swz % 64) / 2; }
__host__ __device__ __forceinline__ int perm32(int rho) { const int n = rho >> 4, i = rho & 15; return 8 * (i >> 2) + 4 * n + (i & 3); }

struct Unit { int pm, pn, e, ui; };
struct Gemm { const bf16_t* A; int K; };

struct StaticOrder {
    int nM, nN, nwg, G, c, lda; const bf16_t* Bt; int K;
    __device__ void init(int M, int N, int K_, int lda_, const bf16_t* Bt_, int G_, int c_) { nM = M / BM; nN = N / BM; nwg = nM * nN; G = G_; c = c_; lda = lda_; Bt = Bt_; K = K_; }
    __device__ bool next(int i, Unit& u) const {
        const long L = (long)i * G + c; if (L >= nwg) return false;
        int wgid = (int)L; { const int q = nwg / NXCD, r = nwg % NXCD, xcd = wgid % NXCD, off = wgid / NXCD; wgid = (xcd < r ? xcd * (q + 1) : r * (q + 1) + (xcd - r) * q) + off; }
        const int nig = WGM * nN, gid = wgid / nig, fm = gid * WGM;
        u.pm = fm + ((wgid % nig) % WGM); u.pn = (wgid % nig) / WGM; u.e = 0; u.ui = i; return true;
    }
    __device__ __forceinline__ unsigned a_off(const Unit& u, int r, int C) const { return (unsigned)(((size_t)(u.pm * BM + r) * lda + C) * 2u); }
    __device__ __forceinline__ const char* b_base(const Unit& u) const { return (const char*)Bt + (size_t)u.pn * BM * K * 2; }
    __device__ __forceinline__ void a_ready(const Unit&) const {}
    __device__ __forceinline__ void done(const Unit&) const {}
};

typedef int v8i_t __attribute__((ext_vector_type(8))); typedef int v4i_t __attribute__((ext_vector_type(4)));
__device__ __forceinline__ v8i_t cat8(bf16x8 a, bf16x8 b) { const v4i_t x = __builtin_bit_cast(v4i_t, a), y = __builtin_bit_cast(v4i_t, b); return __builtin_shufflevector(x, y, 0, 1, 2, 3, 4, 5, 6, 7); }
__device__ __forceinline__ unsigned cvt_pk_bf16(float lo, float hi) { unsigned r; asm volatile("v_cvt_pk_bf16_f32 %0, %1, %2" : "=v"(r) : "v"(lo), "v"(hi)); return r; }

template <class Epi, class Sched, bool ALIGN_EPI = true, bool FP8 = false>
__device__ __forceinline__ void gemm_phase(PG8_LAS unsigned char* lds, const Gemm g, const Sched& S, const Epi& E, const int tid) {
    const int wid = __builtin_amdgcn_readfirstlane(tid >> 6), lane = tid & 63, wr = wid >> 2, wc = wid & 3, fr = lane & 15, fq = lane >> 4;
    const int K = g.K, nt = K / BK;
    unsigned voffB[2];
#pragma unroll
    for (int i = 0; i < 2; ++i) { int R, C; stage_rc(tid * 16 + i * 8192, R, C); const int Rb = Epi::PERM ? ((R & ~31) + perm32(R & 31)) : R; voffB[i] = (unsigned)(Rb * K + C) * 2u; }
#define PG8_AOFF(dst, unit) do { _Pragma("unroll") for (int _i = 0; _i < 2; ++_i) { int _R, _C; stage_rc(tid * 16 + _i * 8192, _R, _C); dst[0][_i] = S.a_off(unit, _R, _C); dst[1][_i] = S.a_off(unit, HALF + _R, _C); } } while (0)
    const size_t kstep = (size_t)(BK * 2);
    const size_t hstepB = (size_t)HALF * K * 2;
    const unsigned ldsw = (unsigned)wid * 1024u;
    const int aoff = lds_byte(wr * 64 + fr, fq * 8), boff = lds_byte(wc * 32 + fr, fq * 8);
#define PG8_SA(b, h) (((b) * 2 + (h)) * HTB)
#define PG8_SB(b, h) ((4 + (b) * 2 + (h)) * HTB)
#define PG8_STAGE(bufoff, gbase, voff) do { _Pragma("unroll") for (int _i = 0; _i < 2; ++_i) { unsigned _o = (voff)[_i]; asm volatile("" : "+v"(_o));     \
        __builtin_amdgcn_global_load_lds((const unsigned*)((const char*)(gbase) + _o), (PG8_LAS unsigned*)(lds + (bufoff) + ldsw + _i * 8192), 16, 0, 0); } } while (0)
#define PG8_LDA(dst, b, h) do { _Pragma("unroll") for (int m = 0; m < 4; ++m) { const v4i_t _lo = *(const PG8_LAS v4i_t*)(lds + PG8_SA(b, h) + aoff + m * 2048), _hi = *(const PG8_LAS v4i_t*)(lds + PG8_SA(b, h) + aoff + m * 2048 + 1024); \
        dst[m] = __builtin_shufflevector(_lo, _hi, 0, 1, 2, 3, 4, 5, 6, 7); } } while (0)
#define PG8_LDB(dst, b, h) do { _Pragma("unroll") for (int n = 0; n < 2; ++n) { const v4i_t _lo = *(const PG8_LAS v4i_t*)(lds + PG8_SB(b, h) + boff + n * 2048), _hi = *(const PG8_LAS v4i_t*)(lds + PG8_SB(b, h) + boff + n * 2048 + 1024); \
        dst[n] = __builtin_shufflevector(_lo, _hi, 0, 1, 2, 3, 4, 5, 6, 7); } } while (0)
#define PG8_LO(v) __builtin_bit_cast(bf16x8, __builtin_shufflevector(v, v, 0, 1, 2, 3))
#define PG8_HI(v) __builtin_bit_cast(bf16x8, __builtin_shufflevector(v, v, 4, 5, 6, 7))
#define PG8_MMA(ai, bj, At, Bt) do { __builtin_amdgcn_s_setprio(1); \
        if constexpr (FP8) { _Pragma("unroll") for (int m = 0; m < 4; ++m) _Pragma("unroll") for (int n = 0; n < 2; ++n) \
            asm volatile("v_mfma_scale_f32_16x16x128_f8f6f4 %0, %1, %2, %0, %3, %3 op_sel_hi:[0,0,0]" : "+v"(acc[ai][bj][m][n]) : "v"(Bt[n]), "v"(At[m]), "v"(sc1)); } \
        else { _Pragma("unroll") for (int m = 0; m < 4; ++m) _Pragma("unroll") for (int n = 0; n < 2; ++n) { \
            acc[ai][bj][m][n] = __builtin_amdgcn_mfma_f32_16x16x32_bf16(PG8_LO(Bt[n]), PG8_LO(At[m]), acc[ai][bj][m][n], 0, 0, 0); \
            acc[ai][bj][m][n] = __builtin_amdgcn_mfma_f32_16x16x32_bf16(PG8_HI(Bt[n]), PG8_HI(At[m]), acc[ai][bj][m][n], 0, 0, 0); } } \
        __builtin_amdgcn_s_setprio(0); } while (0)
#define PG8_WAIT_V(n) asm volatile("s_waitcnt vmcnt(" #n ")" ::: "memory")
#define PG8_WAIT_L(n) asm volatile("s_waitcnt lgkmcnt(" #n ")" ::: "memory")
#define PG8_BAR __builtin_amdgcn_s_barrier()
#define PG8_SCHED __builtin_amdgcn_sched_barrier(0)
    Unit cur, nxt; int ui = 0;
    if (!S.next(0, cur)) return;
    f32x4 acc[2][2][4][2];
    int sc1 = 0x7F7F7F7F; asm volatile("" : "+v"(sc1));
    typename Epi::Pre pre{};
    v8i_t At[4], B0[2], B1[2];
    const char* const Ab = (const char*)g.A;
    unsigned aoc[2][2];
    PG8_AOFF(aoc, cur);
    const char* cB = S.b_base(cur);
    S.a_ready(cur);
    PG8_STAGE(PG8_SB(0, 0), cB, voffB); PG8_STAGE(PG8_SB(0, 1), cB + hstepB, voffB); PG8_STAGE(PG8_SA(0, 0), Ab, aoc[0]); PG8_STAGE(PG8_SA(0, 1), Ab, aoc[1]);
    if (wr == 1) PG8_BAR;
    PG8_WAIT_V(2); PG8_BAR;
    PG8_STAGE(PG8_SB(1, 0), cB + kstep, voffB); PG8_STAGE(PG8_SA(1, 0), Ab + kstep, aoc[0]); PG8_STAGE(PG8_SB(1, 1), cB + hstepB + kstep, voffB);
    PG8_WAIT_V(6); PG8_BAR;
#pragma unroll
    for (int a = 0; a < 2; ++a)
#pragma unroll
        for (int b = 0; b < 2; ++b)
#pragma unroll
            for (int m = 0; m < 4; ++m)
#pragma unroll
                for (int n = 0; n < 2; ++n) acc[a][b][m][n] = (f32x4){0.f, 0.f, 0.f, 0.f};
    for (;;) {
        const bool has_next = S.next(ui + 1, nxt);
        const char* nB = has_next ? S.b_base(nxt) : cB;
        int t = 0;
#pragma unroll 1
        for (int seg = 0; seg < (Epi::MID_T >= 0 ? 2 : 1); ++seg) {
        const int tend = (Epi::MID_T >= 0 && seg == 0) ? Epi::MID_T : nt;
#pragma unroll 1
        for (; t < tend; t += 2) {
            const bool last = (t == nt - 2);
            if (last) pre = E.pre(cur, wr, wc, fr, fq);
            const char* a1 = Ab + (size_t)(t + 1) * kstep;
            const char* a2 = last ? Ab : Ab + (size_t)(t + 2) * kstep; const char* b2 = last ? nB : cB + (size_t)(t + 2) * kstep;
            const char* a3 = a2 + kstep; const char* b3 = b2 + kstep;
            unsigned o2[2][2];
#pragma unroll
            for (int h = 0; h < 2; ++h)
#pragma unroll
                for (int i = 0; i < 2; ++i) o2[h][i] = aoc[h][i];
            if (last && has_next) PG8_AOFF(o2, nxt);
            if (last && has_next) S.a_ready(nxt);
            PG8_LDB(B0, 0, 0); PG8_LDB(B1, 0, 1); PG8_SCHED; PG8_LDA(At, 0, 0); PG8_STAGE(PG8_SA(1, 1), a1, aoc[1]);
            PG8_WAIT_V(8); PG8_WAIT_L(0); PG8_BAR; PG8_MMA(0, 0, At, B0); PG8_MMA(0, 1, At, B1); PG8_BAR; PG8_SCHED;
            PG8_LDA(At, 0, 1); PG8_STAGE(PG8_SB(0, 0), b2, voffB); PG8_STAGE(PG8_SB(0, 1), b2 + hstepB, voffB); PG8_STAGE(PG8_SA(0, 0), a2, o2[0]);
            PG8_WAIT_V(8); PG8_WAIT_L(0); PG8_BAR; PG8_MMA(1, 0, At, B0); PG8_MMA(1, 1, At, B1); PG8_BAR; PG8_SCHED;
            PG8_LDB(B0, 1, 0); PG8_LDB(B1, 1, 1); PG8_SCHED; PG8_LDA(At, 1, 0); PG8_STAGE(PG8_SA(0, 1), a2, o2[1]);
            PG8_WAIT_V(8); PG8_WAIT_L(0); PG8_BAR; PG8_MMA(0, 0, At, B0); PG8_MMA(0, 1, At, B1); PG8_BAR; PG8_SCHED;
            PG8_LDA(At, 1, 1); PG8_STAGE(PG8_SB(1, 0), b3, voffB); PG8_STAGE(PG8_SB(1, 1), b3 + hstepB, voffB); PG8_STAGE(PG8_SA(1, 0), a3, o2[0]);
            PG8_WAIT_V(8); PG8_WAIT_L(0); PG8_BAR; PG8_MMA(1, 0, At, B0); PG8_MMA(1, 1, At, B1); PG8_BAR; PG8_SCHED;
        }
        if (Epi::MID_T >= 0) { if (seg == 0) E.mid(acc, cur, wr, wc, fr, fq); }
        }
        if constexpr (FP8) asm volatile("s_nop 15\n\ts_nop 7" ::: "memory");
        if constexpr (ALIGN_EPI) { if (wr == 0) PG8_BAR; }
        cur.pm = __builtin_amdgcn_readfirstlane(cur.pm); cur.pn = __builtin_amdgcn_readfirstlane(cur.pn); cur.e = __builtin_amdgcn_readfirstlane(cur.e); cur.ui = __builtin_amdgcn_readfirstlane(cur.ui);
        asm volatile("" : "+s"(cur.pm), "+s"(cur.pn), "+s"(cur.e), "+s"(cur.ui));
        { int t_ = tid; asm volatile("" : "+v"(t_)); const int fr_ = t_ & 15, fq_ = (t_ & 63) >> 4;
          E(acc, cur, wr, wc, fr_, fq_, pre); } S.done(cur);
        if (!has_next) break;
#pragma unroll
        for (int a = 0; a < 2; ++a)
#pragma unroll
            for (int b = 0; b < 2; ++b)
#pragma unroll
                for (int m = 0; m < 4; ++m)
#pragma unroll
                    for (int n = 0; n < 2; ++n) acc[a][b][m][n] = (f32x4){0.f, 0.f, 0.f, 0.f};
        cur = nxt; cB = nB; ++ui;
        PG8_AOFF(aoc, cur);
        if constexpr (ALIGN_EPI) { if (wr == 1) PG8_BAR; }
    }
    PG8_WAIT_V(0);
    if constexpr (!ALIGN_EPI) { if (wr == 0) PG8_BAR; }
    PG8_BAR;
#undef PG8_AOFF
#undef PG8_SA
#undef PG8_SB
#undef PG8_STAGE
#undef PG8_LDA
#undef PG8_LDB
#undef PG8_MMA
#undef PG8_LO
#undef PG8_HI
#undef PG8_WAIT_V
#undef PG8_WAIT_L
#undef PG8_BAR
#undef PG8_SCHED
}
}

namespace mk {
constexpr int T = 16384, D = 1024, SEQ = 2048, NB = 8, INW = 5632, NE = 32, DFF = 1024, NMOD = 6144;
constexpr int NW = 8, NTHR = 512;
constexpr float EPS = 1e-6f;
constexpr float W8_SCALE = 64.f, A8_SCALE = 8.f, MOE_DESCALE = 1.f / 512.f;
constexpr float C2 = 0.18033688011112042f;
constexpr int LDS_BYTES = 155648;
constexpr int RING_OFF = 0, TAB_OFF = 131072, MISC_OFF = 155648 - 256;

struct Params {
    const GAS float *x, *c; const GAS int* pos;
    const GAS float *w_mod, *b_mod, *g_pre_mix, *w_in, *lq1, *lk1, *lq2, *lk2, *g_sub, *w_pg, *pool_scale, *w_att, *w_pb, *w_out, *g_post_mix, *g_pre_ffn, *w_router, *b_router, *w_gu, *b_gu, *w_dn, *b_dn, *g_post_ffn;
    GAS float* out;
    GAS unsigned* ctl; GAS float* modp; GAS float* rope;
    GAS bf16 *Wt_in, *Wt_mix, *Wt_out, *Wt_pg, *Wt_gu, *Wt_dn;
    GAS bf16 *U, *QKV, *PB, *GR, *SGP, *AM, *MERGED, *MIXOUT, *ACT, *Y;
    GAS float* prob; GAS int* lists;
    int ph_lo, ph_hi, li, flags;
};
#define P_x ((const float*)p.x)
#define P_c ((const float*)p.c)
#define P_w_mod ((const float*)p.w_mod)
#define P_b_mod ((const float*)p.b_mod)
#define P_g_pre_mix ((const float*)p.g_pre_mix)
#define P_w_in ((const float*)p.w_in)
#define P_lq1 ((const float*)p.lq1)
#define P_lk1 ((const float*)p.lk1)
#define P_lq2 ((const float*)p.lq2)
#define P_lk2 ((const float*)p.lk2)
#define P_g_sub ((const float*)p.g_sub)
#define P_w_pg ((const float*)p.w_pg)
#define P_pool_scale ((const float*)p.pool_scale)
#define P_w_att ((const float*)p.w_att)
#define P_w_pb ((const float*)p.w_pb)
#define P_w_out ((const float*)p.w_out)
#define P_g_post_mix ((const float*)p.g_post_mix)
#define P_g_pre_ffn ((const float*)p.g_pre_ffn)
#define P_w_router ((const float*)p.w_router)
#define P_b_router ((const float*)p.b_router)
#define P_w_gu ((const float*)p.w_gu)
#define P_b_gu ((const float*)p.b_gu)
#define P_w_dn ((const float*)p.w_dn)
#define P_b_dn ((const float*)p.b_dn)
#define P_g_post_ffn ((const float*)p.g_post_ffn)
#define P_pos ((const int*)p.pos)
#define P_out ((float*)p.out)
#define P_ctl ((unsigned*)p.ctl)
#define P_modp ((float*)p.modp)
#define P_rope ((float*)p.rope)
#define P_prob ((float*)p.prob)
#define P_lists ((int*)p.lists)
#define P_Wt_in ((bf16*)p.Wt_in)
#define P_Wt_mix ((bf16*)p.Wt_mix)
#define P_Wt_out ((bf16*)p.Wt_out)
#define P_Wt_pg ((bf16*)p.Wt_pg)
#define P_Wt_gu ((bf16*)p.Wt_gu)
#define P_Wt_dn ((bf16*)p.Wt_dn)
#define P_U ((bf16*)p.U)
#define P_QKV ((bf16*)p.QKV)
#define P_PB ((bf16*)p.PB)
#define P_GR ((bf16*)p.GR)
#define P_SGP ((bf16*)p.SGP)
#define P_AM ((bf16*)p.AM)
#define P_MERGED ((bf16*)p.MERGED)
#define P_MIXOUT ((bf16*)p.MIXOUT)
#define P_ACT ((bf16*)p.ACT)
#define P_Y ((bf16*)p.Y)
constexpr int CW_TMO = 0, CW_CNT = 64  , CW_BAR = 4096  ;

__device__ __forceinline__ float wave_sum(float v) {
#pragma unroll
    for (int o = 1; o < 64; o <<= 1) v += __shfl_xor(v, o);
    return v;
}
__device__ __forceinline__ void tr_item(const float* W, int ldw, int k0, int n0, bf16* WT, int ldt, int drow0, int kcol0, LAS float* scr, int lane) {
#pragma unroll 8
    for (int i = 0; i < 32; ++i) { const int kk = 2 * i + (lane >> 5); scr[kk * 33 + (lane & 31)] = __builtin_nontemporal_load(&W[(size_t)(k0 + kk) * ldw + n0 + (lane & 31)]); }
    LDS_WAIT(); asm volatile("" ::: "memory");
    const int c = lane & 7;
#pragma unroll
    for (int j = 0; j < 4; ++j) { const int n = (lane >> 3) + 8 * j; const LAS float* s = scr + (8 * c) * 33 + n;
        v4u o; o.x = pk2(s[0 * 33], s[1 * 33]); o.y = pk2(s[2 * 33], s[3 * 33]); o.z = pk2(s[4 * 33], s[5 * 33]); o.w = pk2(s[6 * 33], s[7 * 33]);
        *(GAS v4u*)(WT + (size_t)(drow0 + n) * ldt + kcol0 + k0 + 8 * c) = o; }
    LDS_WAIT(); asm volatile("" ::: "memory");
}
__device__ __forceinline__ unsigned pk4_fp8(float a, float b, float c, float d) {
    a = fminf(fmaxf(a, -448.f), 448.f); b = fminf(fmaxf(b, -448.f), 448.f); c = fminf(fmaxf(c, -448.f), 448.f); d = fminf(fmaxf(d, -448.f), 448.f);
    int w = __builtin_amdgcn_cvt_pk_fp8_f32(a, b, 0, false); w = __builtin_amdgcn_cvt_pk_fp8_f32(c, d, w, true); return (unsigned)w; }
__device__ __forceinline__ void tr_item8(const float* W, int ldw, int k0, int n0, unsigned char* WT, int ldt, int drow0, LAS float* scr, int lane, float scale) {
#pragma unroll 8
    for (int i = 0; i < 64; ++i) { const int kk = 2 * i + (lane >> 5); scr[kk * 33 + (lane & 31)] = __builtin_nontemporal_load(&W[(size_t)(k0 + kk) * ldw + n0 + (lane & 31)]); }
    LDS_WAIT(); asm volatile("" ::: "memory");
    const int c = lane & 7;
#pragma unroll
    for (int j = 0; j < 4; ++j) { const int n = (lane >> 3) + 8 * j; const LAS float* s = scr + (16 * c) * 33 + n;
        v4u o; o.x = pk4_fp8(s[0 * 33] * scale, s[1 * 33] * scale, s[2 * 33] * scale, s[3 * 33] * scale); o.y = pk4_fp8(s[4 * 33] * scale, s[5 * 33] * scale, s[6 * 33] * scale, s[7 * 33] * scale);
        o.z = pk4_fp8(s[8 * 33] * scale, s[9 * 33] * scale, s[10 * 33] * scale, s[11 * 33] * scale); o.w = pk4_fp8(s[12 * 33] * scale, s[13 * 33] * scale, s[14 * 33] * scale, s[15 * 33] * scale);
        *(GAS v4u*)(WT + (size_t)(drow0 + n) * ldt + k0 + 16 * c) = o; }
    LDS_WAIT(); asm volatile("" ::: "memory");
}
__device__ __forceinline__ int ilv_row(int n, int H) { const int w = n >= H ? 1 : 0, c = n - w * H; return 256 * (c >> 7) + 128 * w + (c & 127); }

__device__ __forceinline__ void p0_prologue(const Params& p, LAS unsigned char* lds, int tid, int wave, int lane, int vcu, int G) {
    LAS float* sc = (LAS float*)lds;
    for (int i = tid; i < NB * D; i += NTHR) { const float cv = P_c[i]; sc[i] = cv / (1.f + expf(-cv)); }
    __syncthreads();
    const int gw = vcu * NW + wave, NGW = G * NW;
    for (int task = (wave < 3 ? vcu * 3 + wave : 96 * 8); task < 96 * 8; task += G * 3) {
        const int cg = task >> 3, ks = task & 7, col = cg * 64 + lane;
        float acc[NB];
#pragma unroll
        for (int b = 0; b < NB; ++b) acc[b] = 0.f;
#pragma unroll 4
        for (int k = ks * 128; k < ks * 128 + 128; ++k) { const float wv = __builtin_nontemporal_load(&P_w_mod[(size_t)k * NMOD + col]);
#pragma unroll
            for (int b = 0; b < NB; ++b) acc[b] += sc[b * D + k] * wv; }
#pragma unroll
        for (int b = 0; b < NB; ++b) P_modp[(size_t)(ks * NB + b) * NMOD + col] = acc[b];
    }
    __syncthreads();
    LAS float* scr = (LAS float*)(lds + wave * 17408);
    constexpr int I1 = 16 * 176, I2 = 16 * 32, I3 = 8 * 32, I4 = 16 * 32, I5 = 32, I6E = 8 * 64, I7E = 8 * 32;
    const int nitems = (p.flags & 1) ? (I1 + I2 + I3 + I4 + I5) : (I1 + I2 + I3 + I4 + I5 + NE * I6E + NE * I7E);
    for (int it = gw; it < nitems; it += NGW) {
        int r = it;
        if (r < I1) { const int kb = r / 176, nb = r % 176, n0 = nb * 32; const int dr = n0 < 3584 ? n0 : 3584 + ilv_row(n0 - 3584, 1024);
            tr_item(P_w_in, INW, kb * 64, n0, P_Wt_in, D, dr, 0, scr, lane); continue; } r -= I1;
        if (r < I2) { const int kb = r / 32, nb = r % 32; tr_item(P_w_att, D, kb * 64, nb * 32, P_Wt_mix, 1536, nb * 32, 0, scr, lane); continue; } r -= I2;
        if (r < I3) { const int kb = r / 32, nb = r % 32; tr_item(P_w_pb, D, kb * 64, nb * 32, P_Wt_mix, 1536, nb * 32, 1024, scr, lane); continue; } r -= I3;
        if (r < I4) { const int kb = r / 32, nb = r % 32; tr_item(P_w_out, D, kb * 64, nb * 32, P_Wt_out, D, nb * 32, 0, scr, lane); continue; } r -= I4;
        if (r < I5) { const int g = r >> 3, q = r & 7, kb = q >> 2, nb = q & 3; tr_item(P_w_pg + (size_t)g * 128 * 128, 128, kb * 64, nb * 32, P_Wt_pg + (size_t)g * 128 * 128, 128, nb * 32, 0, scr, lane); continue; } r -= I5;
        if (r < NE * I6E) { const int e = r / I6E, q = r % I6E, kb = q / 64, nb = q % 64, n0 = nb * 32;
            tr_item8(P_w_gu + (size_t)e * D * 2 * DFF, 2 * DFF, kb * 128, n0, (unsigned char*)P_Wt_gu + (size_t)e * 2 * DFF * D, D, ilv_row(n0, DFF), scr, lane, W8_SCALE); continue; } r -= NE * I6E;
        { const int e = r / I7E, q = r % I7E, kb = q / 32, nb = q % 32; tr_item8(P_w_dn + (size_t)e * DFF * D, D, kb * 128, nb * 32, (unsigned char*)P_Wt_dn + (size_t)e * D * DFF, DFF, nb * 32, scr, lane, W8_SCALE); }
    }
}
__device__ __forceinline__ double rope_invf(int i) {
    return i == 0 ? 1.0 : i == 1 ? 0.19392274474868576 : i == 2 ? 0.03760603093086393 : i == 3 ? 0.007292664737217109 : i == 4 ? 0.001414213562373095 : i == 5 ? 0.0002742481756762073 : i == 6 ? 5.318295896944988e-05 : 1.031338537721246e-05;
}
__device__ __forceinline__ f32x4 mod4(const Params& p, int b, int off, int k) {
    const float* base = P_modp + (size_t)b * NMOD + off + k;
    f32x4 t[9]; t[8] = *(const f32x4*)(P_b_mod + off + k);
#pragma unroll
    for (int ks = 0; ks < 8; ++ks) t[ks] = *(const f32x4*)(base + (size_t)ks * NB * NMOD);
    asm volatile("" : "+v"(t[0]), "+v"(t[1]), "+v"(t[2]), "+v"(t[3]), "+v"(t[4]), "+v"(t[5]), "+v"(t[6]), "+v"(t[7]), "+v"(t[8]));
    return t[8] + (((t[0] + t[1]) + (t[2] + t[3])) + ((t[4] + t[5]) + (t[6] + t[7])));
}
constexpr int MODF_OFF = 8 * NB * NMOD;
__device__ __forceinline__ void p1_rows(const Params& p, LAS unsigned char* lds, int tid, int wave, int lane, int vcu, int G) {
    LAS float* av = (LAS float*)lds; LAS float* sv = av + D;
    for (int grp = vcu; grp < T / 64; grp += G) {
        const int row0 = grp * 64 + wave * 8, b = row0 / SEQ;
        __syncthreads();
        { const int k = 4 * (tid & 255);
          if (tid < 256) *(LAS f32x4*)(av + k) = *(const f32x4*)(P_g_pre_mix + k) * (1.f + mod4(p, b, 1024, k)); else *(LAS f32x4*)(sv + k) = mod4(p, b, 0, k);
          if ((grp & 31) == 0) {
#pragma unroll
              for (int q = 0; q < 2; ++q) { const int vi = (tid >> 8) * 2 + q; const int off = vi == 0 ? 2048 : vi == 1 ? 3072 : vi == 2 ? 4096 : 5120;
                  *(f32x4*)(P_modp + MODF_OFF + (size_t)(b * 4 + vi) * D + k) = mod4(p, b, off, k); } } }
        __syncthreads();
        f32x4 a[4], sh[4];
#pragma unroll
        for (int j = 0; j < 4; ++j) { const int k = 4 * lane + 256 * j; a[j] = *(const LAS f32x4*)(av + k); sh[j] = *(const LAS f32x4*)(sv + k); }
#pragma unroll 1
        for (int rb = 0; rb < 8; rb += 4) {
            f32x4 v[4][4]; float ss[4];
#pragma unroll
            for (int r = 0; r < 4; ++r) { const GAS f32x4* xr = (const GAS f32x4*)(P_x + (size_t)(row0 + rb + r) * D) + lane;
#pragma unroll
                for (int j = 0; j < 4; ++j) v[r][j] = __builtin_nontemporal_load(xr + 64 * j); }
#pragma unroll
            for (int r = 0; r < 4; ++r) { float s = 0.f;
#pragma unroll
                for (int j = 0; j < 4; ++j) s += (v[r][j].x * v[r][j].x + v[r][j].y * v[r][j].y) + (v[r][j].z * v[r][j].z + v[r][j].w * v[r][j].w);
                ss[r] = s; }
#pragma unroll
            for (int o = 1; o < 64; o <<= 1) {
#pragma unroll
                for (int r = 0; r < 4; ++r) ss[r] += __shfl_xor(ss[r], o); }
#pragma unroll
            for (int r = 0; r < 4; ++r) { const int m = row0 + rb + r; const float rstd = 1.f / sqrtf(ss[r] * (1.f / D) + EPS);
                GAS unsigned long long* o8 = (GAS unsigned long long*)(P_U + (size_t)m * D) + lane;
#pragma unroll
                for (int j = 0; j < 4; ++j) { const f32x4 u = v[r][j] * rstd * a[j] + sh[j]; o8[64 * j] = (unsigned long long)pk2(u.x, u.y) | ((unsigned long long)pk2(u.z, u.w) << 32); } }
        }
        if (lane < 8) {
            const double invf = rope_invf(lane);
#pragma unroll 1
            for (int r = 0; r < 8; ++r) { const int m = row0 + r; const double ang = (double)P_pos[m] * invf; const double kk = __builtin_rint(ang * 0.15915494309189535);
                const float rr = (float)(ang - kk * 6.283185307179586); P_rope[(size_t)m * 16 + lane] = cosf(rr); P_rope[(size_t)m * 16 + 8 + lane] = sinf(rr); }
        }
    }
}
struct EpiZ {
    static constexpr bool PERM = true; static constexpr int MID_T = -1;
    bf16 *QKV, *PB, *GR, *SGP; const float* rope;
    struct Pre {}; __device__ __forceinline__ Pre pre(const pg8::Unit&, int, int, int, int) const { return Pre{}; }
    __device__ __forceinline__ void mid(pg8::f32x4 (&)[2][2][4][2], const pg8::Unit&, int, int, int, int) const {}
    __device__ __forceinline__ void operator()(const pg8::f32x4 (&acc)[2][2][4][2], const pg8::Unit& u, int wr, int wc, int fr, int fq, const Pre&) const {
        const int row0 = u.pm * 256 + wr * 64 + fr, pn = u.pn, cw = wc * 32 + 8 * fq;
        if (pn < 14) {
            const bool rp = pn < 8 && (wc & 1) == 0; const float sc = pn < 4 ? C2 : 1.f;
            bf16* base = pn < 12 ? QKV : PB; const int ld = pn < 12 ? 3072 : 512; const int colt = (pn < 12 ? pn : pn - 12) * 256 + cw;
#pragma unroll
            for (int ai = 0; ai < 2; ++ai)
#pragma unroll
                for (int m = 0; m < 4; ++m) {
                    const int row = row0 + ai * 128 + m * 16;
                    f32x4 c0 = {1.f, 1.f, 1.f, 1.f}, c1 = c0, s0 = {0.f, 0.f, 0.f, 0.f}, s1 = s0;
                    if (rp) { const f32x4* rt = (const f32x4*)(rope + (size_t)row * 16); c0 = rt[0]; c1 = rt[1]; s0 = rt[2]; s1 = rt[3]; }
#pragma unroll
                    for (int bj = 0; bj < 2; ++bj) {
                        f32x4 v0 = acc[ai][bj][m][0], v1 = acc[ai][bj][m][1];
                        if (rp) {
                            f32x4 p0, p1;
#pragma unroll
                            for (int j = 0; j < 4; ++j) { p0[j] = __shfl_xor(v0[j], 16); p1[j] = __shfl_xor(v1[j], 16); }
                            if (fq == 0) { v0 = v0 * c0 - p0 * s0; v1 = v1 * c1 - p1 * s1; }
                            else if (fq == 1) { v0 = v0 * c0 + p0 * s0; v1 = v1 * c1 + p1 * s1; }
                        }
                        v0 = v0 * sc; v1 = v1 * sc;
                        pg8::u32x4 w; w.x = pg8::cvt_pk_bf16(v0[0], v0[1]); w.y = pg8::cvt_pk_bf16(v0[2], v0[3]); w.z = pg8::cvt_pk_bf16(v1[0], v1[1]); w.w = pg8::cvt_pk_bf16(v1[2], v1[3]);
                        *(pg8::u32x4*)(base + (size_t)row * ld + colt + bj * 128) = w;
                    }
                }
        } else {
            const int colt = (pn - 14) * 128 + cw;
#pragma unroll
            for (int ai = 0; ai < 2; ++ai)
#pragma unroll
                for (int m = 0; m < 4; ++m) {
                    const int row = row0 + ai * 128 + m * 16;
                    float r[8], g[8];
#pragma unroll
                    for (int n = 0; n < 2; ++n)
#pragma unroll
                        for (int j = 0; j < 4; ++j) { const float a = fminf(fmaxf(acc[ai][0][m][n][j], -30.f), 30.f), b = fminf(fmaxf(acc[ai][1][m][n][j], -30.f), 30.f);
                            const float ea = __builtin_amdgcn_exp2f(-1.4426950408889634f * a), eb = __builtin_amdgcn_exp2f(-1.4426950408889634f * b); r[n * 4 + j] = (1.f + eb) * __builtin_amdgcn_rcpf(1.f + ea); g[n * 4 + j] = __builtin_amdgcn_rcpf(1.f + eb); }
                    pg8::u32x4 w; w.x = pg8::cvt_pk_bf16(r[0], r[1]); w.y = pg8::cvt_pk_bf16(r[2], r[3]); w.z = pg8::cvt_pk_bf16(r[4], r[5]); w.w = pg8::cvt_pk_bf16(r[6], r[7]);
                    *(pg8::u32x4*)(GR + (size_t)row * D + colt) = w;
                    w.x = pg8::cvt_pk_bf16(g[0], g[1]); w.y = pg8::cvt_pk_bf16(g[2], g[3]); w.z = pg8::cvt_pk_bf16(g[4], g[5]); w.w = pg8::cvt_pk_bf16(g[6], g[7]);
                    *(pg8::u32x4*)(SGP + (size_t)row * D + colt) = w;
                }
        }
    }
};
}

namespace mk {
__device__ __forceinline__ float bf2f(unsigned short v) { return __uint_as_float((unsigned)v << 16); }
__device__ __forceinline__ float lam_value(const Params& p, int lane) {
    const float a = P_lq1[lane] * P_lk1[lane], b = P_lq2[lane] * P_lk2[lane];
    return expf(wave_sum(a)) - expf(wave_sum(b)) + 0.2f;
}
__device__ __forceinline__ void attn_interim(const Params& p, LAS unsigned char* lds, int tid, int vcu, int G) {
    const float lam = lam_value(p, tid & 63);
    const int sub = tid >> 8, t = tid & 255, r = t >> 2, j = t & 3;
    LAS float* Ks1 = (LAS float*)(lds + sub * 65536); LAS float* Ks2 = Ks1 + 4096; LAS float* Vs = Ks2 + 4096;
    for (int it = 0;; ++it) {
        const int pi = vcu + G * it; if (pi >= 1024) break;
        const int cc = pi & 31, c = (it & 1) ? 31 - cc : cc;
        const int bh = 2 * (pi >> 5) + sub, b = bh >> 3, h = bh & 7;
        const size_t m = (size_t)b * SEQ + c * 64 + r;
        float q1[16], q2[16];
#pragma unroll
        for (int i = 0; i < 16; ++i) { q1[i] = bf2f(P_QKV[m * 3072 + (2 * h) * 64 + j * 16 + i]); q2[i] = bf2f(P_QKV[m * 3072 + (2 * h + 1) * 64 + j * 16 + i]); }
        float m1 = -INFINITY, l1 = 0.f, m2 = -INFINITY, l2 = 0.f, a1[32], a2[32];
#pragma unroll
        for (int d = 0; d < 32; ++d) { a1[d] = 0.f; a2[d] = 0.f; }
        for (int kt = 0; kt <= c; ++kt) {
            __syncthreads();
            for (int e = t; e < 64 * 64; e += 256) { const int kr = e >> 6, kc = e & 63; const size_t km = (size_t)b * SEQ + kt * 64 + kr;
                Ks1[e] = bf2f(P_QKV[km * 3072 + 1024 + (2 * h) * 64 + kc]); Ks2[e] = bf2f(P_QKV[km * 3072 + 1024 + (2 * h + 1) * 64 + kc]); }
            for (int e = t; e < 64 * 128; e += 256) { const int kr = e >> 7, kc = e & 127; const size_t km = (size_t)b * SEQ + kt * 64 + kr; Vs[e] = bf2f(P_QKV[km * 3072 + 2048 + h * 128 + kc]); }
            __syncthreads();
            for (int kk = 0; kk < 64; ++kk) {
                float s1 = 0.f, s2 = 0.f;
#pragma unroll
                for (int i = 0; i < 16; ++i) { s1 += q1[i] * Ks1[kk * 64 + j * 16 + i]; s2 += q2[i] * Ks2[kk * 64 + j * 16 + i]; }
                s1 += __shfl_xor(s1, 1); s1 += __shfl_xor(s1, 2); s2 += __shfl_xor(s2, 1); s2 += __shfl_xor(s2, 2);
                { const float mn = fmaxf(m1, s1), al = exp2f(m1 - mn), pp = exp2f(s1 - mn); l1 = l1 * al + pp; m1 = mn;
#pragma unroll
                  for (int d = 0; d < 32; ++d) a1[d] = a1[d] * al + pp * Vs[kk * 128 + j * 32 + d]; }
                { const float mn = fmaxf(m2, s2), al = exp2f(m2 - mn), pp = exp2f(s2 - mn); l2 = l2 * al + pp; m2 = mn;
#pragma unroll
                  for (int d = 0; d < 32; ++d) a2[d] = a2[d] * al + pp * Vs[kk * 128 + j * 32 + d]; }
            }
        }
        float ss = 0.f; const float i1 = 1.f / l1, i2 = lam / l2;
#pragma unroll
        for (int d = 0; d < 32; ++d) { a1[d] = a1[d] * i1 - a2[d] * i2; ss += a1[d] * a1[d]; }
        ss += __shfl_xor(ss, 1); ss += __shfl_xor(ss, 2);
        const float rstd = (1.f / sqrtf(ss * (1.f / 128.f) + EPS)) * 0.8f;
#pragma unroll
        for (int d = 0; d < 32; d += 2) { const float o0 = a1[d] * rstd * P_g_sub[j * 32 + d], o1 = a1[d + 1] * rstd * P_g_sub[j * 32 + d + 1];
            *(unsigned*)(P_AM + m * 1536 + h * 128 + j * 32 + d) = pk2(o0, o1); }
    }
    __syncthreads();
}
__device__ __forceinline__ void pool_phase(const Params& p, LAS unsigned char* lds, int tid, int wave, int lane, int vcu, int G) {
    LAS float* Pf = (LAS float*)lds;
    LAS unsigned short* Mx = (LAS unsigned short*)(lds + 144 * 128 * 4);
    const int fr = lane & 15, fq = lane >> 4;
    for (int unit = vcu; unit < 512; unit += G) {
        const int rt = unit >> 2, g = unit & 3, w = 2 << g, row0 = rt * 128, s0 = row0 & (SEQ - 1);
        for (int ch = tid; ch < 144 * 16; ch += NTHR) { const int r = ch >> 4, c8 = (ch & 15) * 8, tt = s0 - 16 + r;
            v4u raw = {0u, 0u, 0u, 0u};
            if (tt >= 0) raw = *(const GAS v4u*)(P_PB + (size_t)(row0 - 16 + r) * 512 + g * 128 + c8);
            LAS float* d = Pf + r * 128 + c8;
            d[0] = __uint_as_float(raw.x << 16); d[1] = __uint_as_float(raw.x & 0xffff0000u); d[2] = __uint_as_float(raw.y << 16); d[3] = __uint_as_float(raw.y & 0xffff0000u);
            d[4] = __uint_as_float(raw.z << 16); d[5] = __uint_as_float(raw.z & 0xffff0000u); d[6] = __uint_as_float(raw.w << 16); d[7] = __uint_as_float(raw.w & 0xffff0000u); }
        __syncthreads();
        { const int c = tid & 127, rb = (tid >> 7) * 32;
          float ssum = 0.f;
          for (int q = 0; q < w; ++q) ssum += Pf[(rb + 16 - q) * 128 + c];
          for (int i = 0; i < 32; ++i) { const int r = rb + i, s = s0 + r; const int cnt = (s + 1) < w ? (s + 1) : w;
              const float pv = Pf[(r + 16) * 128 + c]; const float mx = ssum * __builtin_amdgcn_rcpf((float)cnt) - pv;
              Mx[r * 136 + c] = (unsigned short)f2bf(mx);
              if (i < 31) ssum += Pf[(r + 17) * 128 + c] - Pf[(r + 17 - w) * 128 + c]; } }
        __syncthreads();
        f32x4 acc[8];
#pragma unroll
        for (int nt = 0; nt < 8; ++nt) acc[nt] = (f32x4){0.f, 0.f, 0.f, 0.f};
        const bf16* Wg = P_Wt_pg + (size_t)g * 128 * 128;
#pragma unroll
        for (int ks = 0; ks < 4; ++ks) {
            const bf16x8 a = *(const LAS bf16x8*)(Mx + (16 * wave + fr) * 136 + 32 * ks + 8 * fq);
#pragma unroll
            for (int nt = 0; nt < 8; ++nt) { const bf16x8 bw = *(const GAS bf16x8*)(Wg + (size_t)(16 * nt + fr) * 128 + 32 * ks + 8 * fq);
                acc[nt] = __builtin_amdgcn_mfma_f32_16x16x32_bf16(bw, a, acc[nt], 0, 0, 0); }
        }
        bf16* orow = P_AM + (size_t)(row0 + 16 * wave + fr) * 1536 + 1024 + g * 128;
#pragma unroll
        for (int nt = 0; nt < 8; ++nt) { const int d = 16 * nt + 4 * fq; const f32x4 sc = *(const f32x4*)(P_pool_scale + g * 128 + d); const f32x4 v = acc[nt] * sc;
            *(GAS unsigned long long*)(orow + d) = (unsigned long long)pk2(v[0], v[1]) | ((unsigned long long)pk2(v[2], v[3]) << 32); }
        __syncthreads();
    }
}
struct EpiMerge {
    static constexpr bool PERM = true; static constexpr int MID_T = 16;
    const bf16 *GR, *SGP; bf16* O;
    struct Pre {}; __device__ __forceinline__ Pre pre(const pg8::Unit&, int, int, int, int) const { return Pre{}; }
    __device__ __forceinline__ void scale(pg8::f32x4 (&acc)[2][2][4][2], const bf16* Sm, const pg8::Unit& u, int wr, int wc, int fr, int fq) const {
        const __amdgpu_buffer_rsrc_t rs = __builtin_amdgcn_make_buffer_rsrc((void*)Sm, 0, T * D * 2, 0x00020000);
        const int voff = ((u.pm * 256 + wr * 64 + fr) * D + u.pn * 256 + wc * 32 + 8 * fq) * 2;
#pragma unroll
        for (int ai = 0; ai < 2; ++ai)
#pragma unroll
            for (int m = 0; m < 4; ++m) {
#pragma unroll
                for (int bj = 0; bj < 2; ++bj) { const pg8::u32x4 w = __builtin_amdgcn_raw_buffer_load_b128(rs, voff, ((ai * 128 + m * 16) * D + bj * 128) * 2, 0);
                    acc[ai][bj][m][0][0] *= __uint_as_float(w.x << 16); acc[ai][bj][m][0][1] *= __uint_as_float(w.x & 0xffff0000u); acc[ai][bj][m][0][2] *= __uint_as_float(w.y << 16); acc[ai][bj][m][0][3] *= __uint_as_float(w.y & 0xffff0000u);
                    acc[ai][bj][m][1][0] *= __uint_as_float(w.z << 16); acc[ai][bj][m][1][1] *= __uint_as_float(w.z & 0xffff0000u); acc[ai][bj][m][1][2] *= __uint_as_float(w.w << 16); acc[ai][bj][m][1][3] *= __uint_as_float(w.w & 0xffff0000u); }
                asm volatile("" : "+v"(acc[ai][0][m][0]), "+v"(acc[ai][0][m][1]), "+v"(acc[ai][1][m][0]), "+v"(acc[ai][1][m][1])); asm volatile("" ::: "memory");
            }
    }
    __device__ __forceinline__ void mid(pg8::f32x4 (&acc)[2][2][4][2], const pg8::Unit& u, int wr, int wc, int fr, int fq) const { scale(acc, GR, u, wr, wc, fr, fq); }
    __device__ __forceinline__ void operator()(pg8::f32x4 (&acc)[2][2][4][2], const pg8::Unit& u, int wr, int wc, int fr, int fq, const Pre&) const {
        scale(acc, SGP, u, wr, wc, fr, fq);
        const int row0 = u.pm * 256 + wr * 64 + fr, col0 = u.pn * 256 + wc * 32 + 8 * fq;
#pragma unroll
        for (int ai = 0; ai < 2; ++ai)
#pragma unroll
            for (int m = 0; m < 4; ++m)
#pragma unroll
                for (int bj = 0; bj < 2; ++bj) { const pg8::f32x4 v0 = acc[ai][bj][m][0], v1 = acc[ai][bj][m][1];
                    pg8::u32x4 w; w.x = pg8::cvt_pk_bf16(v0[0], v0[1]); w.y = pg8::cvt_pk_bf16(v0[2], v0[3]); w.z = pg8::cvt_pk_bf16(v1[0], v1[1]); w.w = pg8::cvt_pk_bf16(v1[2], v1[3]);
                    *(pg8::u32x4*)(O + (size_t)(row0 + ai * 128 + m * 16) * D + col0 + bj * 128) = w; }
    }
};
struct EpiNull {
    static constexpr bool PERM = true; static constexpr int MID_T = -1;
    struct Pre {}; __device__ __forceinline__ Pre pre(const pg8::Unit&, int, int, int, int) const { return Pre{}; }
    __device__ __forceinline__ void mid(pg8::f32x4 (&)[2][2][4][2], const pg8::Unit&, int, int, int, int) const {}
    __device__ __forceinline__ void operator()(pg8::f32x4 (&acc)[2][2][4][2], const pg8::Unit&, int, int, int, int, const Pre&) const {
#pragma unroll
        for (int ai = 0; ai < 2; ++ai)
#pragma unroll
            for (int bj = 0; bj < 2; ++bj)
#pragma unroll
                for (int m = 0; m < 4; ++m) asm volatile("" :: "v"(acc[ai][bj][m][0]), "v"(acc[ai][bj][m][1]));
    }
};
struct EpiStore {
    static constexpr bool PERM = true; static constexpr int MID_T = -1;
    bf16* O; int ldc;
    struct Pre {}; __device__ __forceinline__ Pre pre(const pg8::Unit&, int, int, int, int) const { return Pre{}; }
    __device__ __forceinline__ void mid(pg8::f32x4 (&)[2][2][4][2], const pg8::Unit&, int, int, int, int) const {}
    __device__ __forceinline__ void operator()(pg8::f32x4 (&acc)[2][2][4][2], const pg8::Unit& u, int wr, int wc, int fr, int fq, const Pre&) const {
        const int row0 = u.pm * 256 + wr * 64 + fr, col0 = u.pn * 256 + wc * 32 + 8 * fq;
#pragma unroll
        for (int ai = 0; ai < 2; ++ai)
#pragma unroll
            for (int m = 0; m < 4; ++m)
#pragma unroll
                for (int bj = 0; bj < 2; ++bj) { const pg8::f32x4 v0 = acc[ai][bj][m][0], v1 = acc[ai][bj][m][1];
                    pg8::u32x4 w; w.x = pg8::cvt_pk_bf16(v0[0], v0[1]); w.y = pg8::cvt_pk_bf16(v0[2], v0[3]); w.z = pg8::cvt_pk_bf16(v1[0], v1[1]); w.w = pg8::cvt_pk_bf16(v1[2], v1[3]);
                    *(pg8::u32x4*)(O + (size_t)(row0 + ai * 128 + m * 16) * ldc + col0 + bj * 128) = w; }
    }
};
typedef float f32x16 __attribute__((ext_vector_type(16)));
__device__ __forceinline__ void p6_rows(const Params& p, LAS unsigned char* lds, int tid, int wave, int lane, int vcu, int G) {
    LAS float* tile = (LAS float*)lds;
    constexpr int RB = 1;
    float wreg[64];
#pragma unroll
    for (int i = 0; i < 64; ++i) wreg[i] = P_w_router[(size_t)(128 * wave + 2 * i + (lane >> 5)) * NE + (lane & 31)];
    for (int grp = vcu; grp < T / 64; grp += G) {
        const int b = (grp * 64) / SEQ;
        LAS float* vec = (LAS float*)(lds + TAB_OFF + 256);
        LAS int* lcnt = (LAS int*)(lds + TAB_OFF + 256 + 16384); LAS int* gbase = lcnt + 32; LAS int* pel = lcnt + 64;
        __syncthreads();
        if (tid < NE) lcnt[tid] = 0;
        if (tid < 256) { const int k = 4 * tid; const float* mf = P_modp + MODF_OFF + (size_t)b * 4 * D + k;
            const f32x4 a = *(const f32x4*)mf, g1 = *(const f32x4*)(P_g_post_mix + k), c = *(const f32x4*)(P_g_pre_ffn + k) * (1.f + *(const f32x4*)(mf + 2 * D)), d = *(const f32x4*)(mf + D);
            *(LAS f32x4*)(vec + k) = a; *(LAS f32x4*)(vec + 1024 + k) = g1; *(LAS f32x4*)(vec + 2048 + k) = c; *(LAS f32x4*)(vec + 3072 + k) = d; }
        __syncthreads();
#pragma unroll 1
        for (int half = 0; half < 2; ++half) {
#pragma unroll 1
            for (int sb = 0; sb < 4; sb += RB) {
                const int tr0 = wave * 4 + sb, m0 = grp * 64 + half * 32 + tr0;
                unsigned long long mw[RB][4]; f32x4 xv[RB][4]; float ss[RB];
#pragma unroll
                for (int rr = 0; rr < RB; ++rr)
#pragma unroll
                    for (int j = 0; j < 4; ++j) { mw[rr][j] = __builtin_nontemporal_load((const GAS unsigned long long*)(P_MIXOUT + (size_t)(m0 + rr) * D) + lane + 64 * j); xv[rr][j] = __builtin_nontemporal_load((const GAS f32x4*)(P_x + (size_t)(m0 + rr) * D) + lane + 64 * j); }
#define P6_UNPK(w) ((f32x4){__uint_as_float((unsigned)(w) << 16), __uint_as_float((unsigned)(w) & 0xffff0000u), __uint_as_float((unsigned)((w) >> 32) << 16), __uint_as_float((unsigned)((w) >> 32) & 0xffff0000u)})
#pragma unroll
                for (int rr = 0; rr < RB; ++rr) { float s = 0.f;
#pragma unroll
                    for (int j = 0; j < 4; ++j) { const f32x4 v = P6_UNPK(mw[rr][j]); s += (v.x * v.x + v.y * v.y) + (v.z * v.z + v.w * v.w); }
                    ss[rr] = s; }
#pragma unroll
                for (int o = 1; o < 64; o <<= 1) {
#pragma unroll
                    for (int rr = 0; rr < RB; ++rr) ss[rr] += __shfl_xor(ss[rr], o); }
#pragma unroll
                for (int rr = 0; rr < RB; ++rr) { const float rstd = 1.f / sqrtf(ss[rr] * (1.f / D) + EPS); GAS f32x4* orow = (GAS f32x4*)(P_out + (size_t)(m0 + rr) * D) + lane; float s = 0.f;
#pragma unroll
                    for (int j = 0; j < 4; ++j) { const int k = 4 * lane + 256 * j; const f32x4 v = P6_UNPK(mw[rr][j]);
                        const f32x4 x1 = xv[rr][j] + *(const LAS f32x4*)(vec + k) * (v * rstd * *(const LAS f32x4*)(vec + 1024 + k)); xv[rr][j] = x1; orow[64 * j] = x1; s += (x1.x * x1.x + x1.y * x1.y) + (x1.z * x1.z + x1.w * x1.w); }
                    ss[rr] = s; }
#undef P6_UNPK
#pragma unroll
                for (int o = 1; o < 64; o <<= 1) {
#pragma unroll
                    for (int rr = 0; rr < RB; ++rr) ss[rr] += __shfl_xor(ss[rr], o); }
#pragma unroll
                for (int rr = 0; rr < RB; ++rr) { const float rstd = 1.f / sqrtf(ss[rr] * (1.f / D) + EPS);
#pragma unroll
                    for (int j = 0; j < 4; ++j) { const int k = 4 * lane + 256 * j; const f32x4 u = xv[rr][j] * rstd * *(const LAS f32x4*)(vec + 2048 + k) + *(const LAS f32x4*)(vec + 3072 + k);
                        *((GAS unsigned*)((unsigned char*)P_U + (size_t)(m0 + rr) * D) + lane + 64 * j) = pk4_fp8(u.x * A8_SCALE, u.y * A8_SCALE, u.z * A8_SCALE, u.w * A8_SCALE);
                        LAS float* tp = tile + (tr0 + rr) * 1025 + k; tp[0] = u.x; tp[1] = u.y; tp[2] = u.z; tp[3] = u.w; } }
            }
            __syncthreads();
            f32x16 acc;
#pragma unroll
            for (int r = 0; r < 16; ++r) acc[r] = 0.f;
            { const LAS float* ap = tile + (lane & 31) * 1025 + 128 * wave + (lane >> 5);
#pragma unroll
              for (int i = 0; i < 64; ++i) acc = __builtin_amdgcn_mfma_f32_32x32x2f32(ap[2 * i], wreg[i], acc, 0, 0, 0); }
            __syncthreads();
            LAS float* part = (LAS float*)lds;
#pragma unroll
            for (int r = 0; r < 16; ++r) part[(wave * 32 + (r & 3) + 8 * (r >> 2) + 4 * (lane >> 5)) * 32 + (lane & 31)] = acc[r];
            __syncthreads();
#pragma unroll 1
            for (int rr = 0; rr < 4; ++rr) {
                const int tr = wave * 4 + rr, m = grp * 64 + half * 32 + tr;
                float mylg = -INFINITY;
                if (lane < 32) { float s = P_b_router[lane];
#pragma unroll
                    for (int w8 = 0; w8 < 8; ++w8) s += part[(w8 * 32 + tr) * 32 + lane];
                    mylg = s; }
                int sel[4]; float sv[4];
#pragma unroll
                for (int k = 0; k < 4; ++k) { float bv = mylg; int bi = lane;
#pragma unroll
                    for (int off = 1; off < 64; off <<= 1) { const float ov = __shfl_xor(bv, off); const int oi = __shfl_xor(bi, off);
                        if (ov > bv || (ov == bv && oi < bi)) { bv = ov; bi = oi; } }
                    sel[k] = bi; sv[k] = bv; if (lane == bi) mylg = -INFINITY; }
                float den = 0.f, pe[4];
#pragma unroll
                for (int k = 0; k < 4; ++k) { pe[k] = __expf(sv[k] - sv[0]); den += pe[k]; }
                if (lane == 0) {
#pragma unroll
                    for (int k = 0; k < 4; ++k) { P_prob[m * 4 + k] = pe[k] / den; const int loc = __hip_atomic_fetch_add(lcnt + sel[k], 1, __ATOMIC_RELAXED, __HIP_MEMORY_SCOPE_WORKGROUP);
                        pel[(half * 32 + tr) * 4 + k] = (sel[k] << 16) | loc; }
                }
            }
            __syncthreads();
        }
        if (tid < NE) { const int c = lcnt[tid]; gbase[tid] = c ? (int)__hip_atomic_fetch_add(P_ctl + CW_CNT + 64 * tid, (unsigned)c, __ATOMIC_RELAXED, __HIP_MEMORY_SCOPE_AGENT) : 0; }
        __syncthreads();
        if (tid < 256) { const int v = pel[tid], e = v >> 16, loc = v & 0xffff; P_lists[(size_t)e * T + gbase[e] + loc] = grp * 256 + tid; }
        __syncthreads();
    }
}
constexpr int MOE_MAXU = 10;
struct MoeSched {
    const bf16* Bt_all; size_t bstride; int K, ncol, a_shift, lda, G, c, total;
    const LAS int* pre;
    const LAS int* idx;
    const LAS int* utab;
    __device__ __forceinline__ bool locate(int i, pg8::Unit& u) const {
        const int L = (G == 256) ? ((i * 8 + (c & 7)) * 32 + (c >> 3)) : (i * G + c);
        if (L >= total || i >= MOE_MAXU) return false;
        const int RT = L / ncol; u.pn = L - RT * ncol;
        int e = 0;
#pragma unroll 1
        for (int q = 1; q < NE; ++q) e += (pre[q] <= RT) ? 1 : 0;
        u.e = e; u.pm = RT - pre[e]; u.ui = i; return true;
    }
    __device__ __forceinline__ bool next(int i, pg8::Unit& u) const {
        if (i >= MOE_MAXU) return false;
        const pg8::v4i_t t = *(const LAS pg8::v4i_t*)(utab + 4 * i);
        u.e = t[0]; u.pm = t[1]; u.pn = t[2]; u.ui = i; return t[3] != 0;
    }
    __device__ __forceinline__ unsigned a_off(const pg8::Unit& u, int r, int C) const {
        int pair = idx[u.ui * 256 + r]; if (pair < 0) pair = idx[u.ui * 256];
        return (unsigned)(((size_t)(pair >> a_shift) * lda + C) * 2u);
    }
    __device__ __forceinline__ const char* b_base(const pg8::Unit& u) const { return (const char*)(Bt_all + (size_t)u.e * bstride + (size_t)u.pn * 256 * K); }
    __device__ __forceinline__ void a_ready(const pg8::Unit&) const {}
    __device__ __forceinline__ void done(const pg8::Unit&) const {}
};
__device__ __forceinline__ void moe_setup(const Params& p, MoeSched& S, LAS int* pre, LAS int* idx, int tid) {
    LAS int* utab = pre + 48;
    LAS int* cnts = pre + 96;
    if (tid < NE) {
        const int c = (int)__hip_atomic_load(P_ctl + CW_CNT + 64 * tid, __ATOMIC_RELAXED, __HIP_MEMORY_SCOPE_AGENT); cnts[tid] = c;
        int v = (c + 255) >> 8;
#pragma unroll
        for (int o = 1; o < 32; o <<= 1) { const int t = __shfl_up(v, o); if (tid >= o) v += t; }
        pre[tid + 1] = v; if (tid == 0) pre[0] = 0;
    }
    __syncthreads();
    S.pre = pre; S.idx = idx; S.utab = utab; S.total = pre[NE] * S.ncol;
    for (int i = 0; i < MOE_MAXU; ++i) { pg8::Unit u; const bool ok = S.locate(i, u);
        if (tid == 0) { utab[4 * i] = ok ? u.e : 0; utab[4 * i + 1] = ok ? u.pm : 0; utab[4 * i + 2] = ok ? u.pn : 0; utab[4 * i + 3] = ok ? 1 : 0; }
        if (!ok) continue;
        if (tid < 256) { const int cnt = cnts[u.e]; const int r = u.pm * 256 + tid;
            idx[i * 256 + tid] = r < cnt ? P_lists[(size_t)u.e * T + r] : -1; } }
    __syncthreads();
}
struct EpiAct {
    static constexpr bool PERM = true; static constexpr int MID_T = -1;
    bf16* ACT; const float* b_gu; const LAS int* idx;
    struct Pre { f32x4 bg0, bg1, bu0, bu1; };
    __device__ __forceinline__ Pre pre(const pg8::Unit& u, int, int wc, int, int fq) const { const float* bg = b_gu + (size_t)u.e * 2 * DFF + u.pn * 128 + wc * 32 + 8 * fq;
        return Pre{*(const f32x4*)bg, *(const f32x4*)(bg + 4), *(const f32x4*)(bg + DFF), *(const f32x4*)(bg + DFF + 4)}; }
    __device__ __forceinline__ void mid(pg8::f32x4 (&)[2][2][4][2], const pg8::Unit&, int, int, int, int) const {}
    __device__ __forceinline__ void operator()(pg8::f32x4 (&acc)[2][2][4][2], const pg8::Unit& u, int wr, int wc, int fr, int fq, const Pre& q) const {
        const int col = u.pn * 128 + wc * 32 + 8 * fq;
        const f32x4 bg0 = q.bg0, bg1 = q.bg1, bu0 = q.bu0, bu1 = q.bu1;
#pragma unroll
        for (int ai = 0; ai < 2; ++ai)
#pragma unroll
            for (int m = 0; m < 4; ++m) {
                const int pair = idx[u.ui * 256 + ai * 128 + wr * 64 + m * 16 + fr];
                float o[8];
#pragma unroll
                for (int n = 0; n < 2; ++n)
#pragma unroll
                    for (int j = 0; j < 4; ++j) { float g = acc[ai][0][m][n][j] * MOE_DESCALE + (n ? bg1[j] : bg0[j]); float up = acc[ai][1][m][n][j] * MOE_DESCALE + (n ? bu1[j] : bu0[j]);
                        g = fminf(g, 7.f); up = fminf(fmaxf(up, -7.f), 7.f);
                        o[n * 4 + j] = (up * A8_SCALE + A8_SCALE) * (g * __builtin_amdgcn_rcpf(1.f + __builtin_amdgcn_exp2f(-2.4554669595930156f * g))); }
                if (pair >= 0) { pg8::u32x2 w; int w0 = __builtin_amdgcn_cvt_pk_fp8_f32(o[0], o[1], 0, false); w0 = __builtin_amdgcn_cvt_pk_fp8_f32(o[2], o[3], w0, true);
                    int w1 = __builtin_amdgcn_cvt_pk_fp8_f32(o[4], o[5], 0, false); w1 = __builtin_amdgcn_cvt_pk_fp8_f32(o[6], o[7], w1, true); w.x = (unsigned)w0; w.y = (unsigned)w1;
                    *(pg8::u32x2*)((unsigned char*)ACT + (size_t)pair * DFF + col) = w; }
            }
    }
};
struct EpiY {
    static constexpr bool PERM = true; static constexpr int MID_T = -1;
    bf16* Y; const float* b_dn; const LAS int* idx;
    struct Pre { f32x4 b00, b01, b10, b11; };
    __device__ __forceinline__ Pre pre(const pg8::Unit& u, int, int wc, int, int fq) const { const float* bb = b_dn + (size_t)u.e * D + u.pn * 256 + wc * 32 + 8 * fq;
        return Pre{*(const f32x4*)bb, *(const f32x4*)(bb + 4), *(const f32x4*)(bb + 128), *(const f32x4*)(bb + 132)}; }
    __device__ __forceinline__ void mid(pg8::f32x4 (&)[2][2][4][2], const pg8::Unit&, int, int, int, int) const {}
    __device__ __forceinline__ void operator()(pg8::f32x4 (&acc)[2][2][4][2], const pg8::Unit& u, int wr, int wc, int fr, int fq, const Pre& q) const {
        const int col0 = u.pn * 256 + wc * 32 + 8 * fq;
        f32x4 bv[2][2]; bv[0][0] = q.b00; bv[0][1] = q.b01; bv[1][0] = q.b10; bv[1][1] = q.b11;
#pragma unroll
        for (int ai = 0; ai < 2; ++ai)
#pragma unroll
            for (int m = 0; m < 4; ++m) {
                const int pair = idx[u.ui * 256 + ai * 128 + wr * 64 + m * 16 + fr];
                if (pair >= 0) {
#pragma unroll
                    for (int bj = 0; bj < 2; ++bj) { const pg8::f32x4 v0 = acc[ai][bj][m][0] * MOE_DESCALE + bv[bj][0], v1 = acc[ai][bj][m][1] * MOE_DESCALE + bv[bj][1];
                        pg8::u32x4 w; w.x = pg8::cvt_pk_bf16(v0[0], v0[1]); w.y = pg8::cvt_pk_bf16(v0[2], v0[3]); w.z = pg8::cvt_pk_bf16(v1[0], v1[1]); w.w = pg8::cvt_pk_bf16(v1[2], v1[3]);
                        *(pg8::u32x4*)(Y + (size_t)pair * D + col0 + bj * 128) = w; }
                }
            }
    }
};
__device__ __forceinline__ void p9_rows(const Params& p, int wave, int lane, int vcu, int G) {
    for (int grp = vcu; grp < T / 64; grp += G) {
        const int row0 = grp * 64 + wave * 8, b = row0 / SEQ;
        f32x4 gf[2][2];
#pragma unroll
        for (int j = 0; j < 2; ++j)
#pragma unroll
            for (int q = 0; q < 2; ++q) { const int k = 8 * lane + 512 * j + 4 * q; gf[j][q] = *(const f32x4*)(P_modp + MODF_OFF + (size_t)(b * 4 + 3) * D + k) * *(const f32x4*)(P_g_post_ffn + k); }
#pragma unroll 1
        for (int rb = 0; rb < 8; rb += 2) {
            v4u yw[2][4][2]; f32x4 xv[2][2][2]; f32x4 pr[2];
#pragma unroll
            for (int r = 0; r < 2; ++r) { const int m = row0 + rb + r; pr[r] = *(const f32x4*)(P_prob + (size_t)m * 4);
#pragma unroll
                for (int kk = 0; kk < 4; ++kk)
#pragma unroll
                    for (int j = 0; j < 2; ++j) yw[r][kk][j] = __builtin_nontemporal_load((const GAS v4u*)(P_Y + ((size_t)m * 4 + kk) * D) + lane + 64 * j);
#pragma unroll
                for (int j = 0; j < 2; ++j)
#pragma unroll
                    for (int q = 0; q < 2; ++q) xv[r][j][q] = *((const GAS f32x4*)(P_out + (size_t)m * D) + 2 * lane + 128 * j + q); }
            f32x4 f[2][2][2]; float ss[2];
#pragma unroll
            for (int r = 0; r < 2; ++r) { float s = 0.f;
#pragma unroll
                for (int j = 0; j < 2; ++j) { f32x4 f0 = {0.f, 0.f, 0.f, 0.f}, f1 = f0;
#pragma unroll
                    for (int kk = 0; kk < 4; ++kk) { const v4u w = yw[r][kk][j]; const float pk = pr[r][kk];
                        f0 += (f32x4){__uint_as_float(w.x << 16), __uint_as_float(w.x & 0xffff0000u), __uint_as_float(w.y << 16), __uint_as_float(w.y & 0xffff0000u)} * pk;
                        f1 += (f32x4){__uint_as_float(w.z << 16), __uint_as_float(w.z & 0xffff0000u), __uint_as_float(w.w << 16), __uint_as_float(w.w & 0xffff0000u)} * pk; }
                    f[r][j][0] = f0; f[r][j][1] = f1; s += (f0.x * f0.x + f0.y * f0.y) + (f0.z * f0.z + f0.w * f0.w) + (f1.x * f1.x + f1.y * f1.y) + (f1.z * f1.z + f1.w * f1.w); }
                ss[r] = s; }
#pragma unroll
            for (int o = 1; o < 64; o <<= 1) {
#pragma unroll
                for (int r = 0; r < 2; ++r) ss[r] += __shfl_xor(ss[r], o); }
#pragma unroll
            for (int r = 0; r < 2; ++r) { const int m = row0 + rb + r; const float rstd = 1.f / sqrtf(ss[r] * (1.f / D) + EPS);
#pragma unroll
                for (int j = 0; j < 2; ++j)
#pragma unroll
                    for (int q = 0; q < 2; ++q) __builtin_nontemporal_store(xv[r][j][q] + gf[j][q] * (f[r][j][q] * rstd), (GAS f32x4*)(P_out + (size_t)m * D) + 2 * lane + 128 * j + q); }
        }
    }
}
}

namespace mk {
namespace at {
typedef float f32x16 __attribute__((ext_vector_type(16)));
typedef short s16x4 __attribute__((ext_vector_type(4)));
typedef short v4i16_t __attribute__((ext_vector_type(4)));
typedef LAS const char* lds_cptr;
constexpr int KSLOT = 8192, VSLOT = 16384;
constexpr int L_K = 0, L_V = 3 * KSLOT, L_WS = L_V + 3 * VSLOT, L_ST = L_WS + NW * 256, L_END = L_ST + NW * 8192;
static_assert(L_END <= MISC_OFF, "attention LDS map");
__device__ __forceinline__ int crow(int r, int hi) { return (r & 3) + 8 * (r >> 2) + 4 * hi; }
__device__ __forceinline__ void glds16(const void* gsrc, unsigned lds_dst) { unsigned keep;
    asm volatile("s_mov_b32 %0, m0\n\ts_mov_b32 m0, %2\n\ts_nop 0\n\tglobal_load_lds_dwordx4 %1, off\n\ts_mov_b32 m0, %0" : "=&s"(keep) : "v"(gsrc), "s"(lds_dst) : "memory"); }
__device__ __forceinline__ void glds16s(const void* sbase, unsigned voff, unsigned lds_dst) { unsigned keep;
    asm volatile("s_mov_b32 %0, m0\n\ts_mov_b32 m0, %3\n\ts_nop 0\n\tglobal_load_lds_dwordx4 %1, %2\n\ts_mov_b32 m0, %0" : "=&s"(keep) : "v"(voff), "s"(sbase), "s"(lds_dst) : "memory"); }
__device__ __forceinline__ unsigned cvtpk(float lo, float hi) { typedef float f2 __attribute__((ext_vector_type(2))); typedef __bf16 b2 __attribute__((ext_vector_type(2))); f2 v = {lo, hi}; b2 b = __builtin_convertvector(v, b2); return __builtin_bit_cast(unsigned, b); }
__device__ __forceinline__ s16x4 vtr(lds_cptr p) { return __builtin_bit_cast(s16x4, __builtin_amdgcn_ds_read_tr16_b64_v4i16((LAS v4i16_t*)p)); }
__device__ __forceinline__ float swap_max(float m) { auto rr = __builtin_amdgcn_permlane32_swap(__float_as_uint(m), __float_as_uint(m), false, false); return fmaxf(__uint_as_float(rr[0]), __uint_as_float(rr[1])); }
__device__ __forceinline__ float swap_sum(float m) { auto rr = __builtin_amdgcn_permlane32_swap(__float_as_uint(m), __float_as_uint(m), false, false); return __uint_as_float(rr[0]) + __uint_as_float(rr[1]); }
#define AT_MFMA(a, b, c) __builtin_amdgcn_mfma_f32_32x32x16_bf16(a, b, c, 0, 0, 0)
__device__ __forceinline__ float at_max3(float a, float b, float c) { float r; asm("v_max3_f32 %0, %1, %2, %3" : "=v"(r) : "v"(a), "v"(b), "v"(c)); return r; }

constexpr float THRL = 8.f;
template <int VAR>
__device__ __forceinline__ void attn_unit(const Params& p, LAS unsigned char* lds, int tid, int b, int h, int qb, float lam, bf16* AMo) {
    const int lane = tid & 63, r32 = lane & 31, hi = lane >> 5; const int wid = __builtin_amdgcn_readfirstlane(tid >> 6);
    const size_t rowbase = (size_t)b * SEQ;
    const int q0 = qb * 256 + wid * 32;
    const int NT = 4 * qb + 4;
    const int my_last = 4 * qb + (wid >> 1);
    const unsigned lds0 = (unsigned)(uintptr_t)lds;
    LAS float* wsf = (LAS float*)(lds + L_WS) + wid * 64;
    const lds_cptr kp0 = (lds_cptr)(lds + L_K) + hi * 1024 + r32 * 16;
    const lds_cptr vp0 = (lds_cptr)(lds + L_V) + ((lane >> 4) & 1) * 32 + (lane & 3) * 8 + (4 * hi + ((lane & 15) >> 2)) * 64;
    LAS unsigned short* const stg = (LAS unsigned short*)(lds + L_ST + wid * 8192);
#pragma unroll 1
    for (int mp = 0; mp < 2; ++mp) {
        const int n = 2 * h + mp;
        bf16x8 qr[4];
        { const bf16* qw = P_QKV + (rowbase + q0 + r32) * 3072 + n * 64 + hi * 8;
#pragma unroll
          for (int d0 = 0; d0 < 4; ++d0) qr[d0] = *(const GAS bf16x8*)(qw + d0 * 16); }
        asm volatile("" : "+v"(qr[0]), "+v"(qr[1]), "+v"(qr[2]), "+v"(qr[3]));
        const char* kbase = (const char*)(P_QKV + rowbase * 3072 + 1024 + n * 64 + wid * 8);
        const char* vbase = (const char*)(P_QKV + (rowbase + 16 * (wid & 3)) * 3072 + 2048 + h * 128 + (wid >> 2) * 32);
        const unsigned klo = (unsigned)lane * 6144u, vlo = (unsigned)(lane >> 2) * 6144u + (unsigned)(lane & 3) * 16u;
#define AT_DMA(t, s) do { const size_t to_ = (size_t)(t) * 64 * 6144; \
                          glds16s(kbase + to_, klo, (unsigned)__builtin_amdgcn_readfirstlane(lds0 + L_K + (s) * KSLOT + wid * 1024)); \
                          glds16s(vbase + to_, vlo, (unsigned)__builtin_amdgcn_readfirstlane(lds0 + L_V + (s) * VSLOT + wid * 1024)); \
                          glds16s(vbase + to_ + 128, vlo, (unsigned)__builtin_amdgcn_readfirstlane(lds0 + L_V + (s) * VSLOT + (wid + 8) * 1024)); } while (0)
        AT_DMA(0, 0); AT_DMA(1, 1);
        f32x16 o[4];
        float mrow = 0.f, lsum = 0.f;
        int s = 0;
        f32x16 pA0, pA1, pB0, pB1;
        f32x16 negm = {0.f, 0.f, 0.f, 0.f, 0.f, 0.f, 0.f, 0.f, 0.f, 0.f, 0.f, 0.f, 0.f, 0.f, 0.f, 0.f};
#define AT_KRD(dst, kb, d0) do { dst[0] = *(const LAS bf16x8*)((kb) + (d0) * 2048); dst[1] = *(const LAS bf16x8*)((kb) + (d0) * 2048 + 512); } while (0)
#define AT_QK(P0, P1, sl) do { const lds_cptr kb_ = kp0 + (sl) * KSLOT; bf16x8 ka_[2], kb2_[2]; \
            AT_KRD(ka_, kb_, 0); AT_KRD(kb2_, kb_, 1); __builtin_amdgcn_sched_barrier(0); \
            P0 = AT_MFMA(ka_[0], qr[0], negm); P1 = AT_MFMA(ka_[1], qr[0], negm); AT_KRD(ka_, kb_, 2); __builtin_amdgcn_sched_barrier(0); \
            P0 = AT_MFMA(kb2_[0], qr[1], P0); P1 = AT_MFMA(kb2_[1], qr[1], P1); AT_KRD(kb2_, kb_, 3); __builtin_amdgcn_sched_barrier(0); \
            P0 = AT_MFMA(ka_[0], qr[2], P0); P1 = AT_MFMA(ka_[1], qr[2], P1); __builtin_amdgcn_sched_barrier(0); \
            P0 = AT_MFMA(kb2_[0], qr[3], P0); P1 = AT_MFMA(kb2_[1], qr[3], P1); __builtin_amdgcn_sched_barrier(0); } while (0)
#define AT_VRD(i, ks0) do { const s16x4 lo_ = vtr(vb_ + ((i) & 3) * 4096 + ((ks0) + ((i) >> 2)) * 1024), hh_ = vtr(vb_ + ((i) & 3) * 4096 + ((ks0) + ((i) >> 2)) * 1024 + 512); \
            F_[i] = (bf16x8){lo_[0], lo_[1], lo_[2], lo_[3], hh_[0], hh_[1], hh_[2], hh_[3]}; } while (0)
#define AT_MX3(a, b, c) at_max3(a, b, c)
#define AT_STEP(PC0, PC1, PN0, PN1, T) do { \
            asm volatile("s_waitcnt vmcnt(0) lgkmcnt(0)\n\ts_barrier" ::: "memory");     \
            const int s1_ = (s == 2) ? 0 : s + 1, s2_ = (s1_ == 2) ? 0 : s1_ + 1; \
            if ((T) + 2 < NT) AT_DMA((T) + 2, s2_); \
            if (VAR != 1 && (T) <= my_last) { \
                float ra_ = AT_MX3(PC0[0], PC0[1], PC1[0]), rb_ = AT_MX3(PC0[2], PC0[3], PC1[1]); ra_ = AT_MX3(ra_, PC1[2], PC1[3]); \
                _Pragma("unroll") for (int r = 4; r < 16; r += 4) { ra_ = AT_MX3(ra_, PC0[r], PC0[r + 1]); rb_ = AT_MX3(rb_, PC0[r + 2], PC0[r + 3]); ra_ = AT_MX3(ra_, PC1[r], PC1[r + 1]); rb_ = AT_MX3(rb_, PC1[r + 2], PC1[r + 3]); } \
                float rm_ = swap_max(fmaxf(ra_, rb_));                   \
                if ((T) == 0 || __any(rm_ > THRL)) {                      \
                    const float dl_ = ((T) == 0) ? rm_ : fmaxf(rm_, 0.f); \
                    mrow += dl_; \
                    _Pragma("unroll") for (int r = 0; r < 16; ++r) { PC0[r] -= dl_; PC1[r] -= dl_; negm[r] = -mrow; } \
                    if ((T) != 0) { const float al_ = __builtin_amdgcn_exp2f(-dl_); lsum *= al_; \
                        if (hi == 0) wsf[r32] = al_; \
                        asm volatile("s_waitcnt lgkmcnt(0)" ::: "memory"); \
                        _Pragma("unroll") for (int r = 0; r < 16; ++r) { const float f_ = wsf[crow(r, hi)]; \
                            _Pragma("unroll") for (int d0 = 0; d0 < 4; ++d0) o[d0][r] *= f_; } } } \
                __builtin_amdgcn_sched_barrier(0); \
                if ((T) + 1 <= my_last) AT_QK(PN0, PN1, s1_);             \
                if (VAR == 2) { asm volatile("" :: "v"(PC0), "v"(PC1)); } else { \
                const lds_cptr vb_ = vp0 + s * VSLOT; v4u pw_[4]; bf16x8 F_[8]; float sacc_ = 0.f; \
                if (VAR != 3) { AT_VRD(0, 0); AT_VRD(1, 0); AT_VRD(2, 0); AT_VRD(3, 0); AT_VRD(4, 0); AT_VRD(5, 0); AT_VRD(6, 0); AT_VRD(7, 0); }     \
                __builtin_amdgcn_sched_barrier(0); \
                _Pragma("unroll") for (int r = 0; r < 16; ++r) { PC0[r] = __builtin_amdgcn_exp2f(PC0[r]); sacc_ += PC0[r]; } \
                _Pragma("unroll") for (int i = 0; i < 4; ++i) { pw_[0][i] = cvtpk(PC0[2 * i], PC0[2 * i + 1]); pw_[1][i] = cvtpk(PC0[8 + 2 * i], PC0[9 + 2 * i]); } \
                __builtin_amdgcn_sched_barrier(0); \
                  \
                AT_GAP1(PC1, 0); AT_GAP1(PC1, 1); AT_GAP1(PC1, 2); AT_GAP1(PC1, 3); AT_GAP1(PC1, 4); AT_GAP1(PC1, 5); AT_GAP1(PC1, 6); AT_GAP1(PC1, 7); \
                _Pragma("unroll") for (int i = 0; i < 4; ++i) { pw_[2][i] = cvtpk(PC1[2 * i], PC1[2 * i + 1]); pw_[3][i] = cvtpk(PC1[8 + 2 * i], PC1[9 + 2 * i]); } \
                lsum += sacc_; \
                __builtin_amdgcn_sched_barrier(0); \
                if (VAR != 3) { _Pragma("unroll") for (int i = 0; i < 8; ++i) o[i & 3] = AT_MFMA(__builtin_bit_cast(bf16x8, pw_[2 + (i >> 2)]), F_[i], o[i & 3]); } else { asm volatile("" :: "v"(pw_[0]), "v"(pw_[1]), "v"(pw_[2]), "v"(pw_[3])); } \
                __builtin_amdgcn_sched_barrier(0); \
            } } \
            s = s1_; } while (0)
#define AT_GAP1(P1, i) do { if (VAR != 3) { o[(i) & 3] = AT_MFMA(__builtin_bit_cast(bf16x8, pw_[(i) >> 2]), F_[i], o[(i) & 3]); AT_VRD(i, 2); } \
            P1[2 * (i)] = __builtin_amdgcn_exp2f(P1[2 * (i)]); P1[2 * (i) + 1] = __builtin_amdgcn_exp2f(P1[2 * (i) + 1]); sacc_ += P1[2 * (i)]; sacc_ += P1[2 * (i) + 1]; \
            asm volatile("" : "+v"(P1), "+v"(sacc_)); __builtin_amdgcn_sched_barrier(0); } while (0)
        asm volatile("s_waitcnt vmcnt(3)\n\ts_barrier" ::: "memory");
#pragma unroll
        for (int r = 0; r < 16; ++r) {
#pragma unroll
            for (int d0 = 0; d0 < 4; ++d0) o[d0][r] = 0.f; }
        if (VAR != 1) AT_QK(pA0, pA1, 0);
        asm volatile("s_nop 7\n\ts_nop 7" ::: "memory");
#pragma unroll 1
        for (int t = 0; t < NT; t += 2) {
            AT_STEP(pA0, pA1, pB0, pB1, t);
            AT_STEP(pB0, pB1, pA0, pA1, t + 1);
        }
        asm volatile("s_waitcnt lgkmcnt(0)\n\ts_barrier" ::: "memory");
#undef AT_STEP
#undef AT_GAP1
#undef AT_MX3
#undef AT_VRD
#undef AT_QK
#undef AT_KRD
        int le_ = lane; asm volatile("" : "+v"(le_)); const int r32e = le_ & 31, hie = le_ >> 5;
        LAS unsigned short* const stge = (LAS unsigned short*)(lds + L_ST + wid * 8192) + r32e;
        lsum = swap_sum(lsum);
        if (hie == 0) wsf[32 + r32e] = 1.f / lsum;
        asm volatile("s_waitcnt lgkmcnt(0)" ::: "memory");
        float rli[16];
#pragma unroll
        for (int r = 0; r < 16; ++r) rli[r] = wsf[32 + crow(r, hie)];
        asm volatile("s_waitcnt lgkmcnt(0)" ::: "memory");
        if (mp == 0) {
#pragma unroll
            for (int r = 0; r < 16; ++r) { const int q = crow(r, hie);
#pragma unroll
                for (int d0 = 0; d0 < 4; ++d0) stge[q * 128 + 32 * d0] = (unsigned short)f2bf(o[d0][r] * rli[r]); }
            asm volatile("s_waitcnt lgkmcnt(0)" ::: "memory");
        } else {
            float ssq[16];
#pragma unroll
            for (int r = 0; r < 16; ++r) { ssq[r] = 0.f; const int q = crow(r, hie);
#pragma unroll
                for (int d0 = 0; d0 < 4; ++d0) { const float a0 = __uint_as_float((unsigned)stge[q * 128 + 32 * d0] << 16); const float v0 = a0 - lam * (o[d0][r] * rli[r]); o[d0][r] = v0; ssq[r] += v0 * v0; } }
            asm volatile("s_waitcnt lgkmcnt(0)" ::: "memory");
#pragma unroll
            for (int off = 1; off < 32; off <<= 1)
#pragma unroll
                for (int r = 0; r < 16; ++r) ssq[r] += __shfl_xor(ssq[r], off);
#pragma unroll
            for (int r = 0; r < 16; ++r) { const float rs = (1.f / sqrtf(ssq[r] * (1.f / 128.f) + EPS)) * 0.8f; const int q = crow(r, hie);
#pragma unroll
                for (int d0 = 0; d0 < 4; ++d0) { stge[q * 128 + 32 * d0] = (unsigned short)f2bf(o[d0][r] * rs * P_g_sub[r32e + 32 * d0]); } }
            asm volatile("s_waitcnt lgkmcnt(0)" ::: "memory");
            bf16* ow = AMo + (rowbase + q0) * 1536 + h * 128;
#pragma unroll
            for (int i = 0; i < 8; ++i) { const int row = i * 4 + (le_ >> 4), ch = le_ & 15; const v4u v = *(const LAS v4u*)(stge - r32e + row * 128 + ch * 8); *(GAS v4u*)(ow + (size_t)row * 1536 + ch * 8) = v; }
        }
#undef AT_DMA
    }
}
}
template <int VAR = 0>
__device__ __forceinline__ void attn_phase(const Params& p, LAS unsigned char* lds, int tid, int vcu, int G) {
    const float lam = lam_value(p, tid & 63);
    bf16* AMo = VAR == 0 ? P_AM : P_ACT;
    for (int pr = vcu; pr < 256; pr += G) {
        const int bh = pr >> 2, s = pr & 3, b = bh >> 3, h = bh & 7;
#pragma unroll 1
        for (int u = 0; u < 2; ++u) at::attn_unit<VAR>(p, lds, tid, b, h, u ? 7 - s : s, lam, AMo);
    }
}
}

namespace mk {
constexpr int NPH = 10;
#ifndef MK_SKIP
#define MK_SKIP 0
#endif
#ifndef MK_REPEAT
#define MK_REPEAT 0
#endif
#ifndef MK_PROFILE_PREFIX
#define MK_PROFILE_PREFIX 0
#endif
__global__ void __launch_bounds__(NTHR, 2) mega(Params p) {
    extern __shared__ __attribute__((aligned(16))) unsigned char lds_raw[];
    LAS unsigned char* lds = (LAS unsigned char*)lds_raw;
    volatile LAS unsigned* MISC = (volatile LAS unsigned*)(lds + MISC_OFF);
    const int tid0 = threadIdx.x;
    typedef __attribute__((address_space(4))) const Params CParams;
    CParams* const kp0 = (CParams*)__builtin_amdgcn_kernarg_segment_ptr();
#define FRESH int tid = tid0; asm volatile("" : "+v"(tid)); const int lane = tid & 63, wave = __builtin_amdgcn_readfirstlane(tid >> 6); (void)lane; (void)wave; \
              CParams* kp_ = kp0; asm volatile("" : "+s"(kp_)); Params p; { typedef __attribute__((address_space(4))) const unsigned long long cu64_; cu64_* s_ = (cu64_*)kp_; unsigned long long* d_ = (unsigned long long*)&p; \
              _Pragma("unroll") for (int i_ = 0; i_ < (int)(sizeof(Params) / 8); ++i_) d_[i_] = s_[i_]; }
    const int G = gridDim.x; const int bx = blockIdx.x; const int vcu = (G % 8 == 0) ? (bx % 8) * (G / 8) + bx / 8 : bx;
    if (tid0 < 64) MISC[tid0] = 0u;
    __syncthreads();
    XcdBarrier bar = xcd_barrier_post(P_ctl + CW_BAR + p.li * XCD_BAR_WORDS, MISC + 8);
    LAS int* pre = (LAS int*)(lds + TAB_OFF); LAS int* idx = (LAS int*)(lds + TAB_OFF + 512);
#ifdef MK_DOUBLE_BAR
#define SEAM(k) do { if (IN(k) && IN((k) + 1)) { xcd_barrier(bar); xcd_barrier(bar); } } while (0)
#else
#define SEAM(k) do { if (IN(k) && IN((k) + 1)) xcd_barrier(bar); } while (0)
#endif
#ifndef MK_ATTN_VAR
#define MK_ATTN_VAR 0
#endif
#define PHASE(k, ...) if (IN(k) && !(MK_SKIP & (1 << (k)))) { { FRESH; __VA_ARGS__ } if (MK_REPEAT & (1 << (k))) { __syncthreads(); FRESH; __VA_ARGS__ } } SEAM(k);
#ifdef MK_P2_NULL
#define PHASE_P2NULL if (IN(2)) { FRESH; pg8::Gemm g{P_U, D}; pg8::StaticOrder S; S.init(T, INW, D, D, P_Wt_in, G, bx); EpiNull E{}; pg8::gemm_phase<EpiNull, pg8::StaticOrder, true>(lds + RING_OFF, g, S, E, tid); xcd_barrier(bar); }
#else
#define PHASE_P2NULL
#endif
#ifdef MK_P7_NULL
#define PHASE_P7NULL if (IN(7)) { FRESH; MoeSched S{P_Wt_gu, (size_t)2 * DFF * D / 2, D / 2, 8, 2, D / 2, G, bx, 0, nullptr, nullptr, nullptr}; moe_setup(p, S, pre, idx, tid); pg8::Gemm g{P_U, D / 2}; EpiNull E{}; pg8::gemm_phase<EpiNull, MoeSched, true, true>(lds + RING_OFF, g, S, E, tid); xcd_barrier(bar); }
#else
#define PHASE_P7NULL
#endif
#define PROGRAM \
    PHASE(0, p0_prologue(p, lds, tid, wave, lane, vcu, G);) \
    PHASE(1, p1_rows(p, lds, tid, wave, lane, vcu, G);) \
    PHASE(2, pg8::Gemm g{P_U, D}; pg8::StaticOrder S; S.init(T, INW, D, D, P_Wt_in, G, bx); \
             EpiZ E{P_QKV, P_PB, P_GR, P_SGP, P_rope}; \
             pg8::gemm_phase<EpiZ, pg8::StaticOrder, true>(lds + RING_OFF, g, S, E, tid);) \
    PHASE_P2NULL \
    PHASE(3, if (!(p.flags & 2)) attn_phase<0>(p, lds, tid, vcu, G); \
             pool_phase(p, lds, tid, wave, lane, vcu, G); \
             if (MK_ATTN_VAR) { __syncthreads(); attn_phase<MK_ATTN_VAR>(p, lds, tid, vcu, G); }) \
    PHASE(4, pg8::Gemm g{P_AM, 1536}; pg8::StaticOrder S; S.init(T, D, 1536, 1536, P_Wt_mix, G, bx); \
             EpiMerge E{P_GR, P_SGP, P_MERGED}; \
             pg8::gemm_phase<EpiMerge, pg8::StaticOrder, true>(lds + RING_OFF, g, S, E, tid);) \
    PHASE(5, if (MK_PROFILE_PREFIX && bx == 0 && tid < NE) __hip_atomic_store(P_ctl + CW_CNT + 64 * tid, 0u, __ATOMIC_RELAXED, __HIP_MEMORY_SCOPE_AGENT); \
             pg8::Gemm g{P_MERGED, D}; pg8::StaticOrder S; S.init(T, D, D, D, P_Wt_out, G, bx); \
             EpiStore E{P_MIXOUT, D}; \
             pg8::gemm_phase<EpiStore, pg8::StaticOrder, true>(lds + RING_OFF, g, S, E, tid);) \
    PHASE(6, p6_rows(p, lds, tid, wave, lane, vcu, G);) \
    PHASE(7, MoeSched S{P_Wt_gu, (size_t)2 * DFF * D / 2, D / 2, 8, 2, D / 2, G, bx, 0, nullptr, nullptr, nullptr};     \
             moe_setup(p, S, pre, idx, tid); \
             pg8::Gemm g{P_U, D / 2}; EpiAct E{P_ACT, P_b_gu, idx}; \
             pg8::gemm_phase<EpiAct, MoeSched, true, true>(lds + RING_OFF, g, S, E, tid);) \
    PHASE_P7NULL \
    PHASE(8, MoeSched S{P_Wt_dn, (size_t)D * DFF / 2, DFF / 2, 4, 0, DFF / 2, G, bx, 0, nullptr, nullptr, nullptr}; \
             moe_setup(p, S, pre, idx, tid); \
             pg8::Gemm g{P_ACT, DFF / 2}; EpiY E{P_Y, P_b_dn, idx}; \
             pg8::gemm_phase<EpiY, MoeSched, true, true>(lds + RING_OFF, g, S, E, tid);) \
    PHASE(9, p9_rows(p, wave, lane, vcu, G);)
#if MK_PROFILE_PREFIX
    {
#define IN(k) ((k) < MK_PROFILE_PREFIX)
        PROGRAM
#undef IN
        xcd_barrier(bar);
    }
#endif
    {
        const int lo = p.ph_lo, hi = p.ph_hi;
#define IN(k) (lo <= (k) && (k) < hi)
        PROGRAM
#undef IN
    }
#undef PROGRAM
#undef SEAM
#undef PHASE
#undef FRESH
}
}

static int g_grid = 0;
static int mk_setup() {
    if (g_grid) return g_grid;
    int dev = 0, cus = 0;
    if (hipGetDevice(&dev) != hipSuccess || hipDeviceGetAttribute(&cus, hipDeviceAttributeMultiprocessorCount, dev) != hipSuccess) { g_grid = -1; return -1; }
    if (hipFuncSetAttribute((const void*)mk::mega, hipFuncAttributeMaxDynamicSharedMemorySize, mk::LDS_BYTES) != hipSuccess) { g_grid = -1; return -1; }
    int per_cu = 0;
    if (hipOccupancyMaxActiveBlocksPerMultiprocessor(&per_cu, (const void*)mk::mega, mk::NTHR, mk::LDS_BYTES) != hipSuccess || per_cu < 1) { fprintf(stderr, "kernel_launch: occupancy query reports %d workgroups per CU\n", per_cu); }
    (void)hipGetLastError();
    g_grid = cus;
    return g_grid;
}
extern "C" void kernel_launch(void* const* d_in, const int* in_sizes, int n_in, void* d_out, int out_size, void* d_ws, size_t ws_size, hipStream_t stream) {
    if (mk_setup() < 0 || n_in != 26) return;
    unsigned char* wsb = (unsigned char*)d_ws;
    const size_t MiB = 1u << 20;
    mk::Params p{};
    p.x = (const GAS float*)d_in[0]; p.c = (const GAS float*)d_in[1]; p.pos = (const GAS int*)d_in[2]; p.w_mod = (const GAS float*)d_in[3]; p.b_mod = (const GAS float*)d_in[4]; p.g_pre_mix = (const GAS float*)d_in[5];
    p.w_in = (const GAS float*)d_in[6]; p.lq1 = (const GAS float*)d_in[7]; p.lk1 = (const GAS float*)d_in[8]; p.lq2 = (const GAS float*)d_in[9]; p.lk2 = (const GAS float*)d_in[10]; p.g_sub = (const GAS float*)d_in[11];
    p.w_pg = (const GAS float*)d_in[12]; p.pool_scale = (const GAS float*)d_in[13]; p.w_att = (const GAS float*)d_in[14]; p.w_pb = (const GAS float*)d_in[15]; p.w_out = (const GAS float*)d_in[16];
    p.g_post_mix = (const GAS float*)d_in[17]; p.g_pre_ffn = (const GAS float*)d_in[18]; p.w_router = (const GAS float*)d_in[19]; p.b_router = (const GAS float*)d_in[20];
    p.w_gu = (const GAS float*)d_in[21]; p.b_gu = (const GAS float*)d_in[22]; p.w_dn = (const GAS float*)d_in[23]; p.b_dn = (const GAS float*)d_in[24]; p.g_post_ffn = (const GAS float*)d_in[25];
    p.out = (GAS float*)d_out;
    size_t off = 0;
    auto carve = [&](size_t mib) { unsigned char* r = wsb + off; off += mib * MiB; return r; };
    p.ctl = (GAS unsigned*)carve(1); p.modp = (GAS float*)carve(2); p.rope = (GAS float*)carve(1);
    p.Wt_in = (GAS bf16*)carve(11); p.Wt_mix = (GAS bf16*)carve(3); p.Wt_out = (GAS bf16*)carve(2); p.Wt_pg = (GAS bf16*)carve(1);
    p.prob = (GAS float*)carve(1); p.lists = (GAS int*)carve(2);
    p.U = (GAS bf16*)carve(32); p.QKV = (GAS bf16*)carve(96); p.PB = (GAS bf16*)carve(16); p.GR = (GAS bf16*)carve(32); p.SGP = (GAS bf16*)carve(32);
    p.AM = (GAS bf16*)carve(48); p.MERGED = (GAS bf16*)carve(32); p.MIXOUT = (GAS bf16*)carve(32);
    p.Wt_gu = (GAS bf16*)carve(128); p.Wt_dn = (GAS bf16*)carve(64); p.ACT = (GAS bf16*)carve(128); p.Y = (GAS bf16*)carve(128);
    if (off > ws_size) { fprintf(stderr, "kernel_launch: workspace too small: need %zu, have %zu\n", off, ws_size); return; }
    p.flags = 0; p.ph_lo = 0; p.ph_hi = mk::NPH; p.li = 0;
    if (hipMemsetAsync(wsb, 0, 1 * MiB, stream) != hipSuccess) return;
    hipLaunchKernelGGL(mk::mega, dim3(g_grid), dim3(mk::NTHR), mk::LDS_BYTES, stream, p);
}
```

```cpp
#include <hip/hip_runtime.h>
#include <hip/hip_bf16.h>
#include <cstdio>
#include <cstdint>
#include <cmath>
#define GAS __attribute__((address_space(1)))
#define LAS __attribute__((address_space(3)))
typedef unsigned short bf16;
typedef unsigned v4u __attribute__((ext_vector_type(4)));
typedef float f32x4 __attribute__((ext_vector_type(4)));
typedef short bf16x8 __attribute__((ext_vector_type(8)));
typedef GAS unsigned gu32;
typedef GAS unsigned long long gu64;
#define RLX_AGENT __ATOMIC_RELAXED, __HIP_MEMORY_SCOPE_AGENT
#define LDS_WAIT() asm volatile("s_waitcnt lgkmcnt(0)" ::: "memory")
#define VM_WAIT() asm volatile("s_waitcnt vmcnt(0)" ::: "memory")
__device__ __forceinline__ unsigned long long rt() { return __builtin_amdgcn_s_memrealtime(); }
__device__ __forceinline__ unsigned f2bf(float f) { unsigned u = __builtin_bit_cast(unsigned, f); return (u + 0x7fffu + ((u >> 16) & 1u)) >> 16; }
__device__ __forceinline__ unsigned pk2(float lo, float hi) { return f2bf(lo) | (f2bf(hi) << 16); }

#define XB_TMO      128
#define XB_XCNT(j)  (256  + 64 * (j))
#define XB_XSUB(j)  (1280 + 64 * (j))
#define XB_XGEN(j)  (2304 + 64 * (j))
#define XB_TOP      3328
#define XB_TOPGEN   3392
#define XCD_BAR_WORDS 3456
#define XB_SPIN_CAP (1u << 18)

__device__ __forceinline__ unsigned xb_ld(unsigned* p)              { return __hip_atomic_load(p, __ATOMIC_RELAXED, __HIP_MEMORY_SCOPE_AGENT); }
__device__ __forceinline__ unsigned xb_add(unsigned* p, unsigned v) { return __hip_atomic_fetch_add(p, v, __ATOMIC_RELAXED, __HIP_MEMORY_SCOPE_AGENT); }
__device__ __forceinline__ unsigned xb_xcc_id() { return (unsigned)__builtin_amdgcn_s_getreg((3 << 11) | 20) & 0xFu; }
#define XB_SPIN(cond, bar) do { unsigned _sp = 0; while (cond) { __builtin_amdgcn_s_sleep(1); \
    if ((++_sp & 255u) == 0u) { if (xb_ld(&(bar)[XB_TMO])) break; if (_sp > XB_SPIN_CAP) { atomicAdd(&(bar)[XB_TMO], 1u); break; } } } } while (0)

struct XcdBarrier {
    unsigned* bar; unsigned x;
    volatile LAS unsigned* st;
};

__device__ __forceinline__ XcdBarrier xcd_barrier_post(unsigned* bar, volatile LAS unsigned* st) {
    XcdBarrier b; b.bar = bar; b.x = xb_xcc_id(); b.st = st;
    if (threadIdx.x == 0) (void)xb_add(&bar[XB_XCNT(b.x)], 1u);
    return b;
}
__device__ __forceinline__ void xcd_barrier_complete(unsigned* bar, unsigned x, unsigned& nloc, unsigned& nx) {
    const unsigned G = gridDim.x * gridDim.y * gridDim.z;
    unsigned sum, cnt, mine, sp = 0u;
    for (;;) {
        sum = 0u; cnt = 0u; mine = 0u;
#pragma unroll
        for (unsigned j = 0; j < 16; ++j) { const unsigned c = xb_ld(&bar[XB_XCNT(j)]); sum += c; cnt += (c > 0u) ? 1u : 0u; mine = (j == x) ? c : mine; }
        if (sum == G) break;
        __builtin_amdgcn_s_sleep(1);
        if ((++sp & 255u) == 0u) { if (xb_ld(&bar[XB_TMO])) break; if (sp > XB_SPIN_CAP) { atomicAdd(&bar[XB_TMO], 1u); break; } }
    }
    nloc = mine > 0u ? mine : 1u; nx = cnt > 0u ? cnt : 1u;
}

__device__ __forceinline__ void xcd_barrier(const XcdBarrier& b) {
    asm volatile("s_waitcnt vmcnt(0)" ::: "memory");
    __syncthreads();
    if (threadIdx.x == 0) {
        unsigned* bar = b.bar;
        __builtin_amdgcn_s_waitcnt(0);
        unsigned nloc = b.st[0], nx = b.st[1];
        if (nloc == 0u) { xcd_barrier_complete(bar, b.x, nloc, nx); b.st[0] = nloc; b.st[1] = nx; }
        const unsigned old = xb_add(&bar[XB_XSUB(b.x)], 1u);
        const unsigned gen = old / nloc;
        if (old + 1u == (gen + 1u) * nloc) {
            __builtin_amdgcn_fence(__ATOMIC_RELEASE, "agent");
            asm volatile("s_waitcnt vmcnt(0)" ::: "memory");
            const unsigned og = xb_add(&bar[XB_TOP], 1u);
            const unsigned tg = og / nx;
            if (og + 1u == (tg + 1u) * nx) xb_add(&bar[XB_TOPGEN], 1u);
            else XB_SPIN(xb_ld(&bar[XB_TOPGEN]) == tg, bar);
            __builtin_amdgcn_fence(__ATOMIC_ACQUIRE, "agent");
            xb_add(&bar[XB_XGEN(b.x)], 1u);
            asm volatile("s_waitcnt vmcnt(0)" ::: "memory");
        } else {
            XB_SPIN(xb_ld(&bar[XB_XGEN(b.x)]) == gen, bar);
            __builtin_amdgcn_fence(__ATOMIC_ACQUIRE, "agent");
            asm volatile("s_waitcnt vmcnt(0)" ::: "memory");
        }
    }
    __syncthreads();
}


namespace pg8 {
#define PG8_LAS __attribute__((address_space(3)))
typedef unsigned short bf16_t;
typedef short bf16x8 __attribute__((ext_vector_type(8)));
typedef float f32x4 __attribute__((ext_vector_type(4)));
typedef unsigned u32x4 __attribute__((ext_vector_type(4)));
typedef unsigned u32x2 __attribute__((ext_vector_type(2)));
constexpr int BM = 256, BK = 64, HALF = 128, HTB = HALF * BK * 2  , STAGE_BYTES = 8 * HTB, NXCD = 8, WGM = 8;

__host__ __device__ __forceinline__ int lds_byte(int r, int c) { const int st = (r >> 4) * 2 + (c >> 5), rr = r & 15, cc = c & 31, ob = rr * 64 + cc * 2; return st * 1024 + (ob ^ (((ob >> 9) & 1) << 5)); }
__host__ __device__ __forceinline__ void stage_rc(int b, int& R, int& C) { const int st = b / 1024, sb = b % 1024, swz = sb ^ (((sb >> 9) & 1) << 5); R = (st >> 1) * 16 + swz / 64; C = (st & 1) * 32 + (swz % 64) / 2; }
__host__ __device__ __forceinline__ int perm32(int rho) { const int n = rho >> 4, i = rho & 15; return 8 * (i >> 2) + 4 * n + (i & 3); }

struct Unit { int pm, pn, e, ui; };
struct Gemm { const bf16_t* A; int K; };

struct StaticOrder {
    int nM, nN, nwg, G, c, lda; const bf16_t* Bt; int K;
    __device__ void init(int M, int N, int K_, int lda_, const bf16_t* Bt_, int G_, int c_) { nM = M / BM; nN = N / BM; nwg = nM * nN; G = G_; c = c_; lda = lda_; Bt = Bt_; K = K_; }
    __device__ bool next(int i, Unit& u) const {
        const long L = (long)i * G + c; if (L >= nwg) return false;
        int wgid = (int)L; { const int q = nwg / NXCD, r = nwg % NXCD, xcd = wgid % NXCD, off = wgid / NXCD; wgid = (xcd < r ? xcd * (q + 1) : r * (q + 1) + (xcd - r) * q) + off; }
        const int nig = WGM * nN, gid = wgid / nig, fm = gid * WGM;
        u.pm = fm + ((wgid % nig) % WGM); u.pn = (wgid % nig) / WGM; u.e = 0; u.ui = i; return true;
    }
    __device__ __forceinline__ unsigned a_off(const Unit& u, int r, int C) const { return (unsigned)(((size_t)(u.pm * BM + r) * lda + C) * 2u); }
    __device__ __forceinline__ const char* b_base(const Unit& u) const { return (const char*)Bt + (size_t)u.pn * BM * K * 2; }
    __device__ __forceinline__ void a_ready(const Unit&) const {}
    __device__ __forceinline__ void done(const Unit&) const {}
};

typedef int v8i_t __attribute__((ext_vector_type(8))); typedef int v4i_t __attribute__((ext_vector_type(4)));
__device__ __forceinline__ v8i_t cat8(bf16x8 a, bf16x8 b) { const v4i_t x = __builtin_bit_cast(v4i_t, a), y = __builtin_bit_cast(v4i_t, b); return __builtin_shufflevector(x, y, 0, 1, 2, 3, 4, 5, 6, 7); }
__device__ __forceinline__ unsigned cvt_pk_bf16(float lo, float hi) { unsigned r; asm volatile("v_cvt_pk_bf16_f32 %0, %1, %2" : "=v"(r) : "v"(lo), "v"(hi)); return r; }

template <class Epi, class Sched, bool ALIGN_EPI = true, bool FP8 = false>
__device__ __forceinline__ void gemm_phase(PG8_LAS unsigned char* lds, const Gemm g, const Sched& S, const Epi& E, const int tid) {
    const int wid = __builtin_amdgcn_readfirstlane(tid >> 6), lane = tid & 63, wr = wid >> 2, wc = wid & 3, fr = lane & 15, fq = lane >> 4;
    const int K = g.K, nt = K / BK;
    unsigned voffB[2];
#pragma unroll
    for (int i = 0; i < 2; ++i) { int R, C; stage_rc(tid * 16 + i * 8192, R, C); const int Rb = Epi::PERM ? ((R & ~31) + perm32(R & 31)) : R; voffB[i] = (unsigned)(Rb * K + C) * 2u; }
#define PG8_AOFF(dst, unit) do { _Pragma("unroll") for (int _i = 0; _i < 2; ++_i) { int _R, _C; stage_rc(tid * 16 + _i * 8192, _R, _C); dst[0][_i] = S.a_off(unit, _R, _C); dst[1][_i] = S.a_off(unit, HALF + _R, _C); } } while (0)
    const size_t kstep = (size_t)(BK * 2);
    const size_t hstepB = (size_t)HALF * K * 2;
    const unsigned ldsw = (unsigned)wid * 1024u;
    const int aoff = lds_byte(wr * 64 + fr, fq * 8), boff = lds_byte(wc * 32 + fr, fq * 8);
#define PG8_SA(b, h) (((b) * 2 + (h)) * HTB)
#define PG8_SB(b, h) ((4 + (b) * 2 + (h)) * HTB)
#define PG8_STAGE(bufoff, gbase, voff) do { _Pragma("unroll") for (int _i = 0; _i < 2; ++_i) { unsigned _o = (voff)[_i]; asm volatile("" : "+v"(_o));     \
        __builtin_amdgcn_global_load_lds((const unsigned*)((const char*)(gbase) + _o), (PG8_LAS unsigned*)(lds + (bufoff) + ldsw + _i * 8192), 16, 0, 0); } } while (0)
#define PG8_LDA(dst, b, h) do { _Pragma("unroll") for (int m = 0; m < 4; ++m) { const v4i_t _lo = *(const PG8_LAS v4i_t*)(lds + PG8_SA(b, h) + aoff + m * 2048), _hi = *(const PG8_LAS v4i_t*)(lds + PG8_SA(b, h) + aoff + m * 2048 + 1024); \
        dst[m] = __builtin_shufflevector(_lo, _hi, 0, 1, 2, 3, 4, 5, 6, 7); } } while (0)
#define PG8_LDB(dst, b, h) do { _Pragma("unroll") for (int n = 0; n < 2; ++n) { const v4i_t _lo = *(const PG8_LAS v4i_t*)(lds + PG8_SB(b, h) + boff + n * 2048), _hi = *(const PG8_LAS v4i_t*)(lds + PG8_SB(b, h) + boff + n * 2048 + 1024); \
        dst[n] = __builtin_shufflevector(_lo, _hi, 0, 1, 2, 3, 4, 5, 6, 7); } } while (0)
#define PG8_LO(v) __builtin_bit_cast(bf16x8, __builtin_shufflevector(v, v, 0, 1, 2, 3))
#define PG8_HI(v) __builtin_bit_cast(bf16x8, __builtin_shufflevector(v, v, 4, 5, 6, 7))
#define PG8_MMA(ai, bj, At, Bt) do { __builtin_amdgcn_s_setprio(1); \
        if constexpr (FP8) { _Pragma("unroll") for (int m = 0; m < 4; ++m) _Pragma("unroll") for (int n = 0; n < 2; ++n) \
            asm volatile("v_mfma_scale_f32_16x16x128_f8f6f4 %0, %1, %2, %0, %3, %3 op_sel_hi:[0,0,0]" : "+v"(acc[ai][bj][m][n]) : "v"(Bt[n]), "v"(At[m]), "v"(sc1)); } \
        else { _Pragma("unroll") for (int m = 0; m < 4; ++m) _Pragma("unroll") for (int n = 0; n < 2; ++n) { \
            acc[ai][bj][m][n] = __builtin_amdgcn_mfma_f32_16x16x32_bf16(PG8_LO(Bt[n]), PG8_LO(At[m]), acc[ai][bj][m][n], 0, 0, 0); \
            acc[ai][bj][m][n] = __builtin_amdgcn_mfma_f32_16x16x32_bf16(PG8_HI(Bt[n]), PG8_HI(At[m]), acc[ai][bj][m][n], 0, 0, 0); } } \
        __builtin_amdgcn_s_setprio(0); } while (0)
#define PG8_WAIT_V(n) asm volatile("s_waitcnt vmcnt(" #n ")" ::: "memory")
#define PG8_WAIT_L(n) asm volatile("s_waitcnt lgkmcnt(" #n ")" ::: "memory")
#define PG8_BAR __builtin_amdgcn_s_barrier()
#define PG8_SCHED __builtin_amdgcn_sched_barrier(0)
    Unit cur, nxt; int ui = 0;
    if (!S.next(0, cur)) return;
    f32x4 acc[2][2][4][2];
    int sc1 = 0x7F7F7F7F; asm volatile("" : "+v"(sc1));
    typename Epi::Pre pre{};
    v8i_t At[4], B0[2], B1[2];
    const char* const Ab = (const char*)g.A;
    unsigned aoc[2][2];
    PG8_AOFF(aoc, cur);
    const char* cB = S.b_base(cur);
    S.a_ready(cur);
    PG8_STAGE(PG8_SB(0, 0), cB, voffB); PG8_STAGE(PG8_SB(0, 1), cB + hstepB, voffB); PG8_STAGE(PG8_SA(0, 0), Ab, aoc[0]); PG8_STAGE(PG8_SA(0, 1), Ab, aoc[1]);
    if (wr == 1) PG8_BAR;
    PG8_WAIT_V(2); PG8_BAR;
    PG8_STAGE(PG8_SB(1, 0), cB + kstep, voffB); PG8_STAGE(PG8_SA(1, 0), Ab + kstep, aoc[0]); PG8_STAGE(PG8_SB(1, 1), cB + hstepB + kstep, voffB);
    PG8_WAIT_V(6); PG8_BAR;
#pragma unroll
    for (int a = 0; a < 2; ++a)
#pragma unroll
        for (int b = 0; b < 2; ++b)
#pragma unroll
            for (int m = 0; m < 4; ++m)
#pragma unroll
                for (int n = 0; n < 2; ++n) acc[a][b][m][n] = (f32x4){0.f, 0.f, 0.f, 0.f};
    for (;;) {
        const bool has_next = S.next(ui + 1, nxt);
        const char* nB = has_next ? S.b_base(nxt) : cB;
        int t = 0;
#pragma unroll 1
        for (int seg = 0; seg < (Epi::MID_T >= 0 ? 2 : 1); ++seg) {
        const int tend = (Epi::MID_T >= 0 && seg == 0) ? Epi::MID_T : nt;
#pragma unroll 1
        for (; t < tend; t += 2) {
            const bool last = (t == nt - 2);
            if (last) pre = E.pre(cur, wr, wc, fr, fq);
            const char* a1 = Ab + (size_t)(t + 1) * kstep;
            const char* a2 = last ? Ab : Ab + (size_t)(t + 2) * kstep; const char* b2 = last ? nB : cB + (size_t)(t + 2) * kstep;
            const char* a3 = a2 + kstep; const char* b3 = b2 + kstep;
            unsigned o2[2][2];
#pragma unroll
            for (int h = 0; h < 2; ++h)
#pragma unroll
                for (int i = 0; i < 2; ++i) o2[h][i] = aoc[h][i];
            if (last && has_next) PG8_AOFF(o2, nxt);
            if (last && has_next) S.a_ready(nxt);
            PG8_LDB(B0, 0, 0); PG8_LDB(B1, 0, 1); PG8_SCHED; PG8_LDA(At, 0, 0); PG8_STAGE(PG8_SA(1, 1), a1, aoc[1]);
            PG8_WAIT_V(8); PG8_WAIT_L(0); PG8_BAR; PG8_MMA(0, 0, At, B0); PG8_MMA(0, 1, At, B1); PG8_BAR; PG8_SCHED;
            PG8_LDA(At, 0, 1); PG8_STAGE(PG8_SB(0, 0), b2, voffB); PG8_STAGE(PG8_SB(0, 1), b2 + hstepB, voffB); PG8_STAGE(PG8_SA(0, 0), a2, o2[0]);
            PG8_WAIT_V(8); PG8_WAIT_L(0); PG8_BAR; PG8_MMA(1, 0, At, B0); PG8_MMA(1, 1, At, B1); PG8_BAR; PG8_SCHED;
            PG8_LDB(B0, 1, 0); PG8_LDB(B1, 1, 1); PG8_SCHED; PG8_LDA(At, 1, 0); PG8_STAGE(PG8_SA(0, 1), a2, o2[1]);
            PG8_WAIT_V(8); PG8_WAIT_L(0); PG8_BAR; PG8_MMA(0, 0, At, B0); PG8_MMA(0, 1, At, B1); PG8_BAR; PG8_SCHED;
            PG8_LDA(At, 1, 1); PG8_STAGE(PG8_SB(1, 0), b3, voffB); PG8_STAGE(PG8_SB(1, 1), b3 + hstepB, voffB); PG8_STAGE(PG8_SA(1, 0), a3, o2[0]);
            PG8_WAIT_V(8); PG8_WAIT_L(0); PG8_BAR; PG8_MMA(1, 0, At, B0); PG8_MMA(1, 1, At, B1); PG8_BAR; PG8_SCHED;
        }
        if (Epi::MID_T >= 0) { if (seg == 0) E.mid(acc, cur, wr, wc, fr, fq); }
        }
        if constexpr (FP8) asm volatile("s_nop 15\n\ts_nop 7" ::: "memory");
        if constexpr (ALIGN_EPI) { if (wr == 0) PG8_BAR; }
        cur.pm = __builtin_amdgcn_readfirstlane(cur.pm); cur.pn = __builtin_amdgcn_readfirstlane(cur.pn); cur.e = __builtin_amdgcn_readfirstlane(cur.e); cur.ui = __builtin_amdgcn_readfirstlane(cur.ui);
        asm volatile("" : "+s"(cur.pm), "+s"(cur.pn), "+s"(cur.e), "+s"(cur.ui));
        { int t_ = tid; asm volatile("" : "+v"(t_)); const int fr_ = t_ & 15, fq_ = (t_ & 63) >> 4;
          E(acc, cur, wr, wc, fr_, fq_, pre); } S.done(cur);
        if (!has_next) break;
#pragma unroll
        for (int a = 0; a < 2; ++a)
#pragma unroll
            for (int b = 0; b < 2; ++b)
#pragma unroll
                for (int m = 0; m < 4; ++m)
#pragma unroll
                    for (int n = 0; n < 2; ++n) acc[a][b][m][n] = (f32x4){0.f, 0.f, 0.f, 0.f};
        cur = nxt; cB = nB; ++ui;
        PG8_AOFF(aoc, cur);
        if constexpr (ALIGN_EPI) { if (wr == 1) PG8_BAR; }
    }
    PG8_WAIT_V(0);
    if constexpr (!ALIGN_EPI) { if (wr == 0) PG8_BAR; }
    PG8_BAR;
#undef PG8_AOFF
#undef PG8_SA
#undef PG8_SB
#undef PG8_STAGE
#undef PG8_LDA
#undef PG8_LDB
#undef PG8_MMA
#undef PG8_LO
#undef PG8_HI
#undef PG8_WAIT_V
#undef PG8_WAIT_L
#undef PG8_BAR
#undef PG8_SCHED
}
}

namespace mk {
constexpr int T = 16384, D = 1024, SEQ = 2048, NB = 8, INW = 5632, NE = 32, DFF = 1024, NMOD = 6144;
constexpr int NW = 8, NTHR = 512;
constexpr float EPS = 1e-6f;
constexpr float W8_SCALE = 64.f, A8_SCALE = 8.f, MOE_DESCALE = 1.f / 512.f;
constexpr float C2 = 0.18033688011112042f;
constexpr int LDS_BYTES = 155648;
constexpr int RING_OFF = 0, TAB_OFF = 131072, MISC_OFF = 155648 - 256;

struct Params {
    const GAS float *x, *c; const GAS int* pos;
    const GAS float *w_mod, *b_mod, *g_pre_mix, *w_in, *lq1, *lk1, *lq2, *lk2, *g_sub, *w_pg, *pool_scale, *w_att, *w_pb, *w_out, *g_post_mix, *g_pre_ffn, *w_router, *b_router, *w_gu, *b_gu, *w_dn, *b_dn, *g_post_ffn;
    GAS float* out;
    GAS unsigned* ctl; GAS float* modp; GAS float* rope;
    GAS bf16 *Wt_in, *Wt_mix, *Wt_out, *Wt_pg, *Wt_gu, *Wt_dn;
    GAS bf16 *U, *QKV, *PB, *GR, *SGP, *AM, *MERGED, *MIXOUT, *ACT, *Y;
    GAS float* prob; GAS int* lists;
    int ph_lo, ph_hi, li, flags;
};
#define P_x ((const float*)p.x)
#define P_c ((const float*)p.c)
#define P_w_mod ((const float*)p.w_mod)
#define P_b_mod ((const float*)p.b_mod)
#define P_g_pre_mix ((const float*)p.g_pre_mix)
#define P_w_in ((const float*)p.w_in)
#define P_lq1 ((const float*)p.lq1)
#define P_lk1 ((const float*)p.lk1)
#define P_lq2 ((const float*)p.lq2)
#define P_lk2 ((const float*)p.lk2)
#define P_g_sub ((const float*)p.g_sub)
#define P_w_pg ((const float*)p.w_pg)
#define P_pool_scale ((const float*)p.pool_scale)
#define P_w_att ((const float*)p.w_att)
#define P_w_pb ((const float*)p.w_pb)
#define P_w_out ((const float*)p.w_out)
#define P_g_post_mix ((const float*)p.g_post_mix)
#define P_g_pre_ffn ((const float*)p.g_pre_ffn)
#define P_w_router ((const float*)p.w_router)
#define P_b_router ((const float*)p.b_router)
#define P_w_gu ((const float*)p.w_gu)
#define P_b_gu ((const float*)p.b_gu)
#define P_w_dn ((const float*)p.w_dn)
#define P_b_dn ((const float*)p.b_dn)
#define P_g_post_ffn ((const float*)p.g_post_ffn)
#define P_pos ((const int*)p.pos)
#define P_out ((float*)p.out)
#define P_ctl ((unsigned*)p.ctl)
#define P_modp ((float*)p.modp)
#define P_rope ((float*)p.rope)
#define P_prob ((float*)p.prob)
#define P_lists ((int*)p.lists)
#define P_Wt_in ((bf16*)p.Wt_in)
#define P_Wt_mix ((bf16*)p.Wt_mix)
#define P_Wt_out ((bf16*)p.Wt_out)
#define P_Wt_pg ((bf16*)p.Wt_pg)
#define P_Wt_gu ((bf16*)p.Wt_gu)
#define P_Wt_dn ((bf16*)p.Wt_dn)
#define P_U ((bf16*)p.U)
#define P_QKV ((bf16*)p.QKV)
#define P_PB ((bf16*)p.PB)
#define P_GR ((bf16*)p.GR)
#define P_SGP ((bf16*)p.SGP)
#define P_AM ((bf16*)p.AM)
#define P_MERGED ((bf16*)p.MERGED)
#define P_MIXOUT ((bf16*)p.MIXOUT)
#define P_ACT ((bf16*)p.ACT)
#define P_Y ((bf16*)p.Y)
constexpr int CW_TMO = 0, CW_CNT = 64  , CW_BAR = 4096  ;

__device__ __forceinline__ float wave_sum(float v) {
#pragma unroll
    for (int o = 1; o < 64; o <<= 1) v += __shfl_xor(v, o);
    return v;
}
__device__ __forceinline__ void tr_item(const float* W, int ldw, int k0, int n0, bf16* WT, int ldt, int drow0, int kcol0, LAS float* scr, int lane) {
#pragma unroll 8
    for (int i = 0; i < 32; ++i) { const int kk = 2 * i + (lane >> 5); scr[kk * 33 + (lane & 31)] = __builtin_nontemporal_load(&W[(size_t)(k0 + kk) * ldw + n0 + (lane & 31)]); }
    LDS_WAIT(); asm volatile("" ::: "memory");
    const int c = lane & 7;
#pragma unroll
    for (int j = 0; j < 4; ++j) { const int n = (lane >> 3) + 8 * j; const LAS float* s = scr + (8 * c) * 33 + n;
        v4u o; o.x = pk2(s[0 * 33], s[1 * 33]); o.y = pk2(s[2 * 33], s[3 * 33]); o.z = pk2(s[4 * 33], s[5 * 33]); o.w = pk2(s[6 * 33], s[7 * 33]);
        *(GAS v4u*)(WT + (size_t)(drow0 + n) * ldt + kcol0 + k0 + 8 * c) = o; }
    LDS_WAIT(); asm volatile("" ::: "memory");
}
__device__ __forceinline__ unsigned pk4_fp8(float a, float b, float c, float d) {
    a = fminf(fmaxf(a, -448.f), 448.f); b = fminf(fmaxf(b, -448.f), 448.f); c = fminf(fmaxf(c, -448.f), 448.f); d = fminf(fmaxf(d, -448.f), 448.f);
    int w = __builtin_amdgcn_cvt_pk_fp8_f32(a, b, 0, false); w = __builtin_amdgcn_cvt_pk_fp8_f32(c, d, w, true); return (unsigned)w; }
__device__ __forceinline__ void tr_item8(const float* W, int ldw, int k0, int n0, unsigned char* WT, int ldt, int drow0, LAS float* scr, int lane, float scale) {
#pragma unroll 8
    for (int i = 0; i < 64; ++i) { const int kk = 2 * i + (lane >> 5); scr[kk * 33 + (lane & 31)] = __builtin_nontemporal_load(&W[(size_t)(k0 + kk) * ldw + n0 + (lane & 31)]); }
    LDS_WAIT(); asm volatile("" ::: "memory");
    const int c = lane & 7;
#pragma unroll
    for (int j = 0; j < 4; ++j) { const int n = (lane >> 3) + 8 * j; const LAS float* s = scr + (16 * c) * 33 + n;
        v4u o; o.x = pk4_fp8(s[0 * 33] * scale, s[1 * 33] * scale, s[2 * 33] * scale, s[3 * 33] * scale); o.y = pk4_fp8(s[4 * 33] * scale, s[5 * 33] * scale, s[6 * 33] * scale, s[7 * 33] * scale);
        o.z = pk4_fp8(s[8 * 33] * scale, s[9 * 33] * scale, s[10 * 33] * scale, s[11 * 33] * scale); o.w = pk4_fp8(s[12 * 33] * scale, s[13 * 33] * scale, s[14 * 33] * scale, s[15 * 33] * scale);
        *(GAS v4u*)(WT + (size_t)(drow0 + n) * ldt + k0 + 16 * c) = o; }
    LDS_WAIT(); asm volatile("" ::: "memory");
}
__device__ __forceinline__ int ilv_row(int n, int H) { const int w = n >= H ? 1 : 0, c = n - w * H; return 256 * (c >> 7) + 128 * w + (c & 127); }

__device__ __forceinline__ void p0_prologue(const Params& p, LAS unsigned char* lds, int tid, int wave, int lane, int vcu, int G) {
    LAS float* sc = (LAS float*)lds;
    for (int i = tid; i < NB * D; i += NTHR) { const float cv = P_c[i]; sc[i] = cv / (1.f + expf(-cv)); }
    __syncthreads();
    const int gw = vcu * NW + wave, NGW = G * NW;
    for (int task = (wave < 3 ? vcu * 3 + wave : 96 * 8); task < 96 * 8; task += G * 3) {
        const int cg = task >> 3, ks = task & 7, col = cg * 64 + lane;
        float acc[NB];
#pragma unroll
        for (int b = 0; b < NB; ++b) acc[b] = 0.f;
#pragma unroll 1
        for (int k0 = ks * 128; k0 < ks * 128 + 128; k0 += 32) {
            float wv[32];
#pragma unroll
            for (int i = 0; i < 32; ++i) wv[i] = __builtin_nontemporal_load(&P_w_mod[(size_t)(k0 + i) * NMOD + col]);
#pragma unroll
            for (int i = 0; i < 32; ++i) {
#pragma unroll
                for (int b = 0; b < NB; ++b) acc[b] += sc[b * D + k0 + i] * wv[i]; } }
#pragma unroll
        for (int b = 0; b < NB; ++b) P_modp[(size_t)(ks * NB + b) * NMOD + col] = acc[b];
    }
    __syncthreads();
    LAS float* scr = (LAS float*)(lds + wave * 17408);
    constexpr int I1 = 16 * 176, I2 = 16 * 32, I3 = 8 * 32, I4 = 16 * 32, I5 = 32, I6E = 8 * 64, I7E = 8 * 32;
    const int nitems = (p.flags & 1) ? (I1 + I2 + I3 + I4 + I5) : (I1 + I2 + I3 + I4 + I5 + NE * I6E + NE * I7E);
    for (int it = gw; it < nitems; it += NGW) {
        int r = it;
        if (r < I1) { const int kb = r / 176, nb = r % 176, n0 = nb * 32; const int dr = n0 < 3584 ? n0 : 3584 + ilv_row(n0 - 3584, 1024);
            tr_item(P_w_in, INW, kb * 64, n0, P_Wt_in, D, dr, 0, scr, lane); continue; } r -= I1;
        if (r < I2) { const int kb = r / 32, nb = r % 32; tr_item(P_w_att, D, kb * 64, nb * 32, P_Wt_mix, 1536, nb * 32, 0, scr, lane); continue; } r -= I2;
        if (r < I3) { const int kb = r / 32, nb = r % 32; tr_item(P_w_pb, D, kb * 64, nb * 32, P_Wt_mix, 1536, nb * 32, 1024, scr, lane); continue; } r -= I3;
        if (r < I4) { const int kb = r / 32, nb = r % 32; tr_item(P_w_out, D, kb * 64, nb * 32, P_Wt_out, D, nb * 32, 0, scr, lane); continue; } r -= I4;
        if (r < I5) { const int g = r >> 3, q = r & 7, kb = q >> 2, nb = q & 3; tr_item(P_w_pg + (size_t)g * 128 * 128, 128, kb * 64, nb * 32, P_Wt_pg + (size_t)g * 128 * 128, 128, nb * 32, 0, scr, lane); continue; } r -= I5;
        if (r < NE * I6E) { const int e = r / I6E, q = r % I6E, kb = q / 64, nb = q % 64, n0 = nb * 32;
            tr_item8(P_w_gu + (size_t)e * D * 2 * DFF, 2 * DFF, kb * 128, n0, (unsigned char*)P_Wt_gu + (size_t)e * 2 * DFF * D, D, ilv_row(n0, DFF), scr, lane, W8_SCALE); continue; } r -= NE * I6E;
        { const int e = r / I7E, q = r % I7E, kb = q / 32, nb = q % 32; tr_item8(P_w_dn + (size_t)e * DFF * D, D, kb * 128, nb * 32, (unsigned char*)P_Wt_dn + (size_t)e * D * DFF, DFF, nb * 32, scr, lane, W8_SCALE); }
    }
}
__device__ __forceinline__ double rope_invf(int i) {
    return i == 0 ? 1.0 : i == 1 ? 0.19392274474868576 : i == 2 ? 0.03760603093086393 : i == 3 ? 0.007292664737217109 : i == 4 ? 0.001414213562373095 : i == 5 ? 0.0002742481756762073 : i == 6 ? 5.318295896944988e-05 : 1.031338537721246e-05;
}
__device__ __forceinline__ f32x4 mod4(const Params& p, int b, int off, int k) {
    const float* base = P_modp + (size_t)b * NMOD + off + k;
    f32x4 t[9]; t[8] = *(const f32x4*)(P_b_mod + off + k);
#pragma unroll
    for (int ks = 0; ks < 8; ++ks) t[ks] = *(const f32x4*)(base + (size_t)ks * NB * NMOD);
    asm volatile("" : "+v"(t[0]), "+v"(t[1]), "+v"(t[2]), "+v"(t[3]), "+v"(t[4]), "+v"(t[5]), "+v"(t[6]), "+v"(t[7]), "+v"(t[8]));
    return t[8] + (((t[0] + t[1]) + (t[2] + t[3])) + ((t[4] + t[5]) + (t[6] + t[7])));
}
constexpr int MODF_OFF = 8 * NB * NMOD;
__device__ __forceinline__ void p1_rows(const Params& p, LAS unsigned char* lds, int tid, int wave, int lane, int vcu, int G) {
    LAS float* av = (LAS float*)lds; LAS float* sv = av + D;
    for (int grp = vcu; grp < T / 64; grp += G) {
        const int row0 = grp * 64 + wave * 8, b = row0 / SEQ;
        __syncthreads();
        { const int k = 4 * (tid & 255);
          if (tid < 256) *(LAS f32x4*)(av + k) = *(const f32x4*)(P_g_pre_mix + k) * (1.f + mod4(p, b, 1024, k)); else *(LAS f32x4*)(sv + k) = mod4(p, b, 0, k);
          if ((grp & 31) == 0) {
#pragma unroll
              for (int q = 0; q < 2; ++q) { const int vi = (tid >> 8) * 2 + q; const int off = vi == 0 ? 2048 : vi == 1 ? 3072 : vi == 2 ? 4096 : 5120;
                  *(f32x4*)(P_modp + MODF_OFF + (size_t)(b * 4 + vi) * D + k) = mod4(p, b, off, k); } } }
        __syncthreads();
        f32x4 a[4], sh[4];
#pragma unroll
        for (int j = 0; j < 4; ++j) { const int k = 4 * lane + 256 * j; a[j] = *(const LAS f32x4*)(av + k); sh[j] = *(const LAS f32x4*)(sv + k); }
#pragma unroll 1
        for (int rb = 0; rb < 8; rb += 4) {
            f32x4 v[4][4]; float ss[4];
#pragma unroll
            for (int r = 0; r < 4; ++r) { const GAS f32x4* xr = (const GAS f32x4*)(P_x + (size_t)(row0 + rb + r) * D) + lane;
#pragma unroll
                for (int j = 0; j < 4; ++j) v[r][j] = __builtin_nontemporal_load(xr + 64 * j); }
#pragma unroll
            for (int r = 0; r < 4; ++r) { float s = 0.f;
#pragma unroll
                for (int j = 0; j < 4; ++j) s += (v[r][j].x * v[r][j].x + v[r][j].y * v[r][j].y) + (v[r][j].z * v[r][j].z + v[r][j].w * v[r][j].w);
                ss[r] = s; }
#pragma unroll
            for (int o = 1; o < 64; o <<= 1) {
#pragma unroll
                for (int r = 0; r < 4; ++r) ss[r] += __shfl_xor(ss[r], o); }
#pragma unroll
            for (int r = 0; r < 4; ++r) { const int m = row0 + rb + r; const float rstd = 1.f / sqrtf(ss[r] * (1.f / D) + EPS);
                GAS unsigned long long* o8 = (GAS unsigned long long*)(P_U + (size_t)m * D) + lane;
#pragma unroll
                for (int j = 0; j < 4; ++j) { const f32x4 u = v[r][j] * rstd * a[j] + sh[j]; o8[64 * j] = (unsigned long long)pk2(u.x, u.y) | ((unsigned long long)pk2(u.z, u.w) << 32); } }
        }
        if (lane < 8) {
            const double invf = rope_invf(lane);
#pragma unroll 1
            for (int r = 0; r < 8; ++r) { const int m = row0 + r; const double ang = (double)P_pos[m] * invf; const double kk = __builtin_rint(ang * 0.15915494309189535);
                const float rr = (float)(ang - kk * 6.283185307179586); P_rope[(size_t)m * 16 + lane] = cosf(rr); P_rope[(size_t)m * 16 + 8 + lane] = sinf(rr); }
        }
    }
}
struct EpiZ {
    static constexpr bool PERM = true; static constexpr int MID_T = -1;
    bf16 *QKV, *PB, *GR, *SGP; const float* rope;
    struct Pre {}; __device__ __forceinline__ Pre pre(const pg8::Unit&, int, int, int, int) const { return Pre{}; }
    __device__ __forceinline__ void mid(pg8::f32x4 (&)[2][2][4][2], const pg8::Unit&, int, int, int, int) const {}
    __device__ __forceinline__ void operator()(const pg8::f32x4 (&acc)[2][2][4][2], const pg8::Unit& u, int wr, int wc, int fr, int fq, const Pre&) const {
        const int row0 = u.pm * 256 + wr * 64 + fr, pn = u.pn, cw = wc * 32 + 8 * fq;
        if (pn < 14) {
            const bool rp = pn < 8 && (wc & 1) == 0; const float sc = pn < 4 ? C2 : 1.f;
            bf16* base = pn < 12 ? QKV : PB; const int ld = pn < 12 ? 3072 : 512; const int colt = (pn < 12 ? pn : pn - 12) * 256 + cw;
#pragma unroll
            for (int ai = 0; ai < 2; ++ai)
#pragma unroll
                for (int m = 0; m < 4; ++m) {
                    const int row = row0 + ai * 128 + m * 16;
                    f32x4 c0 = {1.f, 1.f, 1.f, 1.f}, c1 = c0, s0 = {0.f, 0.f, 0.f, 0.f}, s1 = s0;
                    if (rp) { const f32x4* rt = (const f32x4*)(rope + (size_t)row * 16); c0 = rt[0]; c1 = rt[1]; s0 = rt[2]; s1 = rt[3]; }
#pragma unroll
                    for (int bj = 0; bj < 2; ++bj) {
                        f32x4 v0 = acc[ai][bj][m][0], v1 = acc[ai][bj][m][1];
                        if (rp) {
                            f32x4 p0, p1;
#pragma unroll
                            for (int j = 0; j < 4; ++j) { p0[j] = __shfl_xor(v0[j], 16); p1[j] = __shfl_xor(v1[j], 16); }
                            if (fq == 0) { v0 = v0 * c0 - p0 * s0; v1 = v1 * c1 - p1 * s1; }
                            else if (fq == 1) { v0 = v0 * c0 + p0 * s0; v1 = v1 * c1 + p1 * s1; }
                        }
                        v0 = v0 * sc; v1 = v1 * sc;
                        pg8::u32x4 w; w.x = pg8::cvt_pk_bf16(v0[0], v0[1]); w.y = pg8::cvt_pk_bf16(v0[2], v0[3]); w.z = pg8::cvt_pk_bf16(v1[0], v1[1]); w.w = pg8::cvt_pk_bf16(v1[2], v1[3]);
                        *(pg8::u32x4*)(base + (size_t)row * ld + colt + bj * 128) = w;
                    }
                }
        } else {
            const int colt = (pn - 14) * 128 + cw;
#pragma unroll
            for (int ai = 0; ai < 2; ++ai)
#pragma unroll
                for (int m = 0; m < 4; ++m) {
                    const int row = row0 + ai * 128 + m * 16;
                    float r[8], g[8];
#pragma unroll
                    for (int n = 0; n < 2; ++n)
#pragma unroll
                        for (int j = 0; j < 4; ++j) { const float a = fminf(fmaxf(acc[ai][0][m][n][j], -30.f), 30.f), b = fminf(fmaxf(acc[ai][1][m][n][j], -30.f), 30.f);
                            const float ea = __builtin_amdgcn_exp2f(-1.4426950408889634f * a), eb = __builtin_amdgcn_exp2f(-1.4426950408889634f * b); r[n * 4 + j] = (1.f + eb) * __builtin_amdgcn_rcpf(1.f + ea); g[n * 4 + j] = __builtin_amdgcn_rcpf(1.f + eb); }
                    pg8::u32x4 w; w.x = pg8::cvt_pk_bf16(r[0], r[1]); w.y = pg8::cvt_pk_bf16(r[2], r[3]); w.z = pg8::cvt_pk_bf16(r[4], r[5]); w.w = pg8::cvt_pk_bf16(r[6], r[7]);
                    *(pg8::u32x4*)(GR + (size_t)row * D + colt) = w;
                    w.x = pg8::cvt_pk_bf16(g[0], g[1]); w.y = pg8::cvt_pk_bf16(g[2], g[3]); w.z = pg8::cvt_pk_bf16(g[4], g[5]); w.w = pg8::cvt_pk_bf16(g[6], g[7]);
                    *(pg8::u32x4*)(SGP + (size_t)row * D + colt) = w;
                }
        }
    }
};
}

namespace mk {
__device__ __forceinline__ float bf2f(unsigned short v) { return __uint_as_float((unsigned)v << 16); }
__device__ __forceinline__ float lam_value(const Params& p, int lane) {
    const float a = P_lq1[lane] * P_lk1[lane], b = P_lq2[lane] * P_lk2[lane];
    return expf(wave_sum(a)) - expf(wave_sum(b)) + 0.2f;
}
__device__ __forceinline__ void attn_interim(const Params& p, LAS unsigned char* lds, int tid, int vcu, int G) {
    const float lam = lam_value(p, tid & 63);
    const int sub = tid >> 8, t = tid & 255, r = t >> 2, j = t & 3;
    LAS float* Ks1 = (LAS float*)(lds + sub * 65536); LAS float* Ks2 = Ks1 + 4096; LAS float* Vs = Ks2 + 4096;
    for (int it = 0;; ++it) {
        const int pi = vcu + G * it; if (pi >= 1024) break;
        const int cc = pi & 31, c = (it & 1) ? 31 - cc : cc;
        const int bh = 2 * (pi >> 5) + sub, b = bh >> 3, h = bh & 7;
        const size_t m = (size_t)b * SEQ + c * 64 + r;
        float q1[16], q2[16];
#pragma unroll
        for (int i = 0; i < 16; ++i) { q1[i] = bf2f(P_QKV[m * 3072 + (2 * h) * 64 + j * 16 + i]); q2[i] = bf2f(P_QKV[m * 3072 + (2 * h + 1) * 64 + j * 16 + i]); }
        float m1 = -INFINITY, l1 = 0.f, m2 = -INFINITY, l2 = 0.f, a1[32], a2[32];
#pragma unroll
        for (int d = 0; d < 32; ++d) { a1[d] = 0.f; a2[d] = 0.f; }
        for (int kt = 0; kt <= c; ++kt) {
            __syncthreads();
            for (int e = t; e < 64 * 64; e += 256) { const int kr = e >> 6, kc = e & 63; const size_t km = (size_t)b * SEQ + kt * 64 + kr;
                Ks1[e] = bf2f(P_QKV[km * 3072 + 1024 + (2 * h) * 64 + kc]); Ks2[e] = bf2f(P_QKV[km * 3072 + 1024 + (2 * h + 1) * 64 + kc]); }
            for (int e = t; e < 64 * 128; e += 256) { const int kr = e >> 7, kc = e & 127; const size_t km = (size_t)b * SEQ + kt * 64 + kr; Vs[e] = bf2f(P_QKV[km * 3072 + 2048 + h * 128 + kc]); }
            __syncthreads();
            for (int kk = 0; kk < 64; ++kk) {
                float s1 = 0.f, s2 = 0.f;
#pragma unroll
                for (int i = 0; i < 16; ++i) { s1 += q1[i] * Ks1[kk * 64 + j * 16 + i]; s2 += q2[i] * Ks2[kk * 64 + j * 16 + i]; }
                s1 += __shfl_xor(s1, 1); s1 += __shfl_xor(s1, 2); s2 += __shfl_xor(s2, 1); s2 += __shfl_xor(s2, 2);
                { const float mn = fmaxf(m1, s1), al = exp2f(m1 - mn), pp = exp2f(s1 - mn); l1 = l1 * al + pp; m1 = mn;
#pragma unroll
                  for (int d = 0; d < 32; ++d) a1[d] = a1[d] * al + pp * Vs[kk * 128 + j * 32 + d]; }
                { const float mn = fmaxf(m2, s2), al = exp2f(m2 - mn), pp = exp2f(s2 - mn); l2 = l2 * al + pp; m2 = mn;
#pragma unroll
                  for (int d = 0; d < 32; ++d) a2[d] = a2[d] * al + pp * Vs[kk * 128 + j * 32 + d]; }
            }
        }
        float ss = 0.f; const float i1 = 1.f / l1, i2 = lam / l2;
#pragma unroll
        for (int d = 0; d < 32; ++d) { a1[d] = a1[d] * i1 - a2[d] * i2; ss += a1[d] * a1[d]; }
        ss += __shfl_xor(ss, 1); ss += __shfl_xor(ss, 2);
        const float rstd = (1.f / sqrtf(ss * (1.f / 128.f) + EPS)) * 0.8f;
#pragma unroll
        for (int d = 0; d < 32; d += 2) { const float o0 = a1[d] * rstd * P_g_sub[j * 32 + d], o1 = a1[d + 1] * rstd * P_g_sub[j * 32 + d + 1];
            *(unsigned*)(P_AM + m * 1536 + h * 128 + j * 32 + d) = pk2(o0, o1); }
    }
    __syncthreads();
}
__device__ __forceinline__ void pool_phase(const Params& p, LAS unsigned char* lds, int tid, int wave, int lane, int vcu, int G) {
    LAS float* Pf = (LAS float*)lds;
    LAS unsigned short* Mx = (LAS unsigned short*)(lds + 144 * 128 * 4);
    const int fr = lane & 15, fq = lane >> 4;
    for (int unit = vcu; unit < 512; unit += G) {
        const int rt = unit >> 2, g = unit & 3, w = 2 << g, row0 = rt * 128, s0 = row0 & (SEQ - 1);
        for (int ch = tid; ch < 144 * 16; ch += NTHR) { const int r = ch >> 4, c8 = (ch & 15) * 8, tt = s0 - 16 + r;
            v4u raw = {0u, 0u, 0u, 0u};
            if (tt >= 0) raw = *(const GAS v4u*)(P_PB + (size_t)(row0 - 16 + r) * 512 + g * 128 + c8);
            LAS float* d = Pf + r * 128 + c8;
            d[0] = __uint_as_float(raw.x << 16); d[1] = __uint_as_float(raw.x & 0xffff0000u); d[2] = __uint_as_float(raw.y << 16); d[3] = __uint_as_float(raw.y & 0xffff0000u);
            d[4] = __uint_as_float(raw.z << 16); d[5] = __uint_as_float(raw.z & 0xffff0000u); d[6] = __uint_as_float(raw.w << 16); d[7] = __uint_as_float(raw.w & 0xffff0000u); }
        __syncthreads();
        { const int c = tid & 127, rb = (tid >> 7) * 32;
          float ssum = 0.f;
          for (int q = 0; q < w; ++q) ssum += Pf[(rb + 16 - q) * 128 + c];
          for (int i = 0; i < 32; ++i) { const int r = rb + i, s = s0 + r; const int cnt = (s + 1) < w ? (s + 1) : w;
              const float pv = Pf[(r + 16) * 128 + c]; const float mx = ssum * __builtin_amdgcn_rcpf((float)cnt) - pv;
              Mx[r * 136 + c] = (unsigned short)f2bf(mx);
              if (i < 31) ssum += Pf[(r + 17) * 128 + c] - Pf[(r + 17 - w) * 128 + c]; } }
        __syncthreads();
        f32x4 acc[8];
#pragma unroll
        for (int nt = 0; nt < 8; ++nt) acc[nt] = (f32x4){0.f, 0.f, 0.f, 0.f};
        const bf16* Wg = P_Wt_pg + (size_t)g * 128 * 128;
#pragma unroll
        for (int ks = 0; ks < 4; ++ks) {
            const bf16x8 a = *(const LAS bf16x8*)(Mx + (16 * wave + fr) * 136 + 32 * ks + 8 * fq);
#pragma unroll
            for (int nt = 0; nt < 8; ++nt) { const bf16x8 bw = *(const GAS bf16x8*)(Wg + (size_t)(16 * nt + fr) * 128 + 32 * ks + 8 * fq);
                acc[nt] = __builtin_amdgcn_mfma_f32_16x16x32_bf16(bw, a, acc[nt], 0, 0, 0); }
        }
        bf16* orow = P_AM + (size_t)(row0 + 16 * wave + fr) * 1536 + 1024 + g * 128;
#pragma unroll
        for (int nt = 0; nt < 8; ++nt) { const int d = 16 * nt + 4 * fq; const f32x4 sc = *(const f32x4*)(P_pool_scale + g * 128 + d); const f32x4 v = acc[nt] * sc;
            *(GAS unsigned long long*)(orow + d) = (unsigned long long)pk2(v[0], v[1]) | ((unsigned long long)pk2(v[2], v[3]) << 32); }
        __syncthreads();
    }
}
struct EpiMerge {
    static constexpr bool PERM = true; static constexpr int MID_T = 16;
    const bf16 *GR, *SGP; bf16* O;
    struct Pre {}; __device__ __forceinline__ Pre pre(const pg8::Unit&, int, int, int, int) const { return Pre{}; }
    __device__ __forceinline__ void scale(pg8::f32x4 (&acc)[2][2][4][2], const bf16* Sm, const pg8::Unit& u, int wr, int wc, int fr, int fq) const {
        const __amdgpu_buffer_rsrc_t rs = __builtin_amdgcn_make_buffer_rsrc((void*)Sm, 0, T * D * 2, 0x00020000);
        const int voff = ((u.pm * 256 + wr * 64 + fr) * D + u.pn * 256 + wc * 32 + 8 * fq) * 2;
#pragma unroll
        for (int ai = 0; ai < 2; ++ai)
#pragma unroll
            for (int m = 0; m < 4; ++m) {
#pragma unroll
                for (int bj = 0; bj < 2; ++bj) { const pg8::u32x4 w = __builtin_amdgcn_raw_buffer_load_b128(rs, voff, ((ai * 128 + m * 16) * D + bj * 128) * 2, 0);
                    acc[ai][bj][m][0][0] *= __uint_as_float(w.x << 16); acc[ai][bj][m][0][1] *= __uint_as_float(w.x & 0xffff0000u); acc[ai][bj][m][0][2] *= __uint_as_float(w.y << 16); acc[ai][bj][m][0][3] *= __uint_as_float(w.y & 0xffff0000u);
                    acc[ai][bj][m][1][0] *= __uint_as_float(w.z << 16); acc[ai][bj][m][1][1] *= __uint_as_float(w.z & 0xffff0000u); acc[ai][bj][m][1][2] *= __uint_as_float(w.w << 16); acc[ai][bj][m][1][3] *= __uint_as_float(w.w & 0xffff0000u); }
                asm volatile("" : "+v"(acc[ai][0][m][0]), "+v"(acc[ai][0][m][1]), "+v"(acc[ai][1][m][0]), "+v"(acc[ai][1][m][1])); asm volatile("" ::: "memory");
            }
    }
    __device__ __forceinline__ void mid(pg8::f32x4 (&acc)[2][2][4][2], const pg8::Unit& u, int wr, int wc, int fr, int fq) const { scale(acc, GR, u, wr, wc, fr, fq); }
    __device__ __forceinline__ void operator()(pg8::f32x4 (&acc)[2][2][4][2], const pg8::Unit& u, int wr, int wc, int fr, int fq, const Pre&) const {
        scale(acc, SGP, u, wr, wc, fr, fq);
        const int row0 = u.pm * 256 + wr * 64 + fr, col0 = u.pn * 256 + wc * 32 + 8 * fq;
#pragma unroll
        for (int ai = 0; ai < 2; ++ai)
#pragma unroll
            for (int m = 0; m < 4; ++m)
#pragma unroll
                for (int bj = 0; bj < 2; ++bj) { const pg8::f32x4 v0 = acc[ai][bj][m][0], v1 = acc[ai][bj][m][1];
                    pg8::u32x4 w; w.x = pg8::cvt_pk_bf16(v0[0], v0[1]); w.y = pg8::cvt_pk_bf16(v0[2], v0[3]); w.z = pg8::cvt_pk_bf16(v1[0], v1[1]); w.w = pg8::cvt_pk_bf16(v1[2], v1[3]);
                    *(pg8::u32x4*)(O + (size_t)(row0 + ai * 128 + m * 16) * D + col0 + bj * 128) = w; }
    }
};
struct EpiNull {
    static constexpr bool PERM = true; static constexpr int MID_T = -1;
    struct Pre {}; __device__ __forceinline__ Pre pre(const pg8::Unit&, int, int, int, int) const { return Pre{}; }
    __device__ __forceinline__ void mid(pg8::f32x4 (&)[2][2][4][2], const pg8::Unit&, int, int, int, int) const {}
    __device__ __forceinline__ void operator()(pg8::f32x4 (&acc)[2][2][4][2], const pg8::Unit&, int, int, int, int, const Pre&) const {
#pragma unroll
        for (int ai = 0; ai < 2; ++ai)
#pragma unroll
            for (int bj = 0; bj < 2; ++bj)
#pragma unroll
                for (int m = 0; m < 4; ++m) asm volatile("" :: "v"(acc[ai][bj][m][0]), "v"(acc[ai][bj][m][1]));
    }
};
struct EpiStore {
    static constexpr bool PERM = true; static constexpr int MID_T = -1;
    bf16* O; int ldc;
    struct Pre {}; __device__ __forceinline__ Pre pre(const pg8::Unit&, int, int, int, int) const { return Pre{}; }
    __device__ __forceinline__ void mid(pg8::f32x4 (&)[2][2][4][2], const pg8::Unit&, int, int, int, int) const {}
    __device__ __forceinline__ void operator()(pg8::f32x4 (&acc)[2][2][4][2], const pg8::Unit& u, int wr, int wc, int fr, int fq, const Pre&) const {
        const int row0 = u.pm * 256 + wr * 64 + fr, col0 = u.pn * 256 + wc * 32 + 8 * fq;
#pragma unroll
        for (int ai = 0; ai < 2; ++ai)
#pragma unroll
            for (int m = 0; m < 4; ++m)
#pragma unroll
                for (int bj = 0; bj < 2; ++bj) { const pg8::f32x4 v0 = acc[ai][bj][m][0], v1 = acc[ai][bj][m][1];
                    pg8::u32x4 w; w.x = pg8::cvt_pk_bf16(v0[0], v0[1]); w.y = pg8::cvt_pk_bf16(v0[2], v0[3]); w.z = pg8::cvt_pk_bf16(v1[0], v1[1]); w.w = pg8::cvt_pk_bf16(v1[2], v1[3]);
                    *(pg8::u32x4*)(O + (size_t)(row0 + ai * 128 + m * 16) * ldc + col0 + bj * 128) = w; }
    }
};
typedef float f32x16 __attribute__((ext_vector_type(16)));
__device__ __forceinline__ void p6_rows(const Params& p, LAS unsigned char* lds, int tid, int wave, int lane, int vcu, int G) {
    LAS float* tile = (LAS float*)lds;
    constexpr int RB = 1;
    float wreg[64];
#pragma unroll
    for (int i = 0; i < 64; ++i) wreg[i] = P_w_router[(size_t)(128 * wave + 2 * i + (lane >> 5)) * NE + (lane & 31)];
    for (int grp = vcu; grp < T / 64; grp += G) {
        const int b = (grp * 64) / SEQ;
        LAS float* vec = (LAS float*)(lds + TAB_OFF + 256);
        LAS int* lcnt = (LAS int*)(lds + TAB_OFF + 256 + 16384); LAS int* gbase = lcnt + 32; LAS int* pel = lcnt + 64;
        __syncthreads();
        if (tid < NE) lcnt[tid] = 0;
        if (tid < 256) { const int k = 4 * tid; const float* mf = P_modp + MODF_OFF + (size_t)b * 4 * D + k;
            const f32x4 a = *(const f32x4*)mf, g1 = *(const f32x4*)(P_g_post_mix + k), c = *(const f32x4*)(P_g_pre_ffn + k) * (1.f + *(const f32x4*)(mf + 2 * D)), d = *(const f32x4*)(mf + D);
            *(LAS f32x4*)(vec + k) = a; *(LAS f32x4*)(vec + 1024 + k) = g1; *(LAS f32x4*)(vec + 2048 + k) = c; *(LAS f32x4*)(vec + 3072 + k) = d; }
        __syncthreads();
#pragma unroll 1
        for (int half = 0; half < 2; ++half) {
#pragma unroll 1
            for (int sb = 0; sb < 4; sb += RB) {
                const int tr0 = wave * 4 + sb, m0 = grp * 64 + half * 32 + tr0;
                unsigned long long mw[RB][4]; f32x4 xv[RB][4]; float ss[RB];
#pragma unroll
                for (int rr = 0; rr < RB; ++rr)
#pragma unroll
                    for (int j = 0; j < 4; ++j) { mw[rr][j] = __builtin_nontemporal_load((const GAS unsigned long long*)(P_MIXOUT + (size_t)(m0 + rr) * D) + lane + 64 * j); xv[rr][j] = __builtin_nontemporal_load((const GAS f32x4*)(P_x + (size_t)(m0 + rr) * D) + lane + 64 * j); }
#define P6_UNPK(w) ((f32x4){__uint_as_float((unsigned)(w) << 16), __uint_as_float((unsigned)(w) & 0xffff0000u), __uint_as_float((unsigned)((w) >> 32) << 16), __uint_as_float((unsigned)((w) >> 32) & 0xffff0000u)})
#pragma unroll
                for (int rr = 0; rr < RB; ++rr) { float s = 0.f;
#pragma unroll
                    for (int j = 0; j < 4; ++j) { const f32x4 v = P6_UNPK(mw[rr][j]); s += (v.x * v.x + v.y * v.y) + (v.z * v.z + v.w * v.w); }
                    ss[rr] = s; }
#pragma unroll
                for (int o = 1; o < 64; o <<= 1) {
#pragma unroll
                    for (int rr = 0; rr < RB; ++rr) ss[rr] += __shfl_xor(ss[rr], o); }
#pragma unroll
                for (int rr = 0; rr < RB; ++rr) { const float rstd = 1.f / sqrtf(ss[rr] * (1.f / D) + EPS); GAS f32x4* orow = (GAS f32x4*)(P_out + (size_t)(m0 + rr) * D) + lane; float s = 0.f;
#pragma unroll
                    for (int j = 0; j < 4; ++j) { const int k = 4 * lane + 256 * j; const f32x4 v = P6_UNPK(mw[rr][j]);
                        const f32x4 x1 = xv[rr][j] + *(const LAS f32x4*)(vec + k) * (v * rstd * *(const LAS f32x4*)(vec + 1024 + k)); xv[rr][j] = x1; orow[64 * j] = x1; s += (x1.x * x1.x + x1.y * x1.y) + (x1.z * x1.z + x1.w * x1.w); }
                    ss[rr] = s; }
#undef P6_UNPK
#pragma unroll
                for (int o = 1; o < 64; o <<= 1) {
#pragma unroll
                    for (int rr = 0; rr < RB; ++rr) ss[rr] += __shfl_xor(ss[rr], o); }
#pragma unroll
                for (int rr = 0; rr < RB; ++rr) { const float rstd = 1.f / sqrtf(ss[rr] * (1.f / D) + EPS);
#pragma unroll
                    for (int j = 0; j < 4; ++j) { const int k = 4 * lane + 256 * j; const f32x4 u = xv[rr][j] * rstd * *(const LAS f32x4*)(vec + 2048 + k) + *(const LAS f32x4*)(vec + 3072 + k);
                        *((GAS unsigned*)((unsigned char*)P_U + (size_t)(m0 + rr) * D) + lane + 64 * j) = pk4_fp8(u.x * A8_SCALE, u.y * A8_SCALE, u.z * A8_SCALE, u.w * A8_SCALE);
                        LAS float* tp = tile + (tr0 + rr) * 1025 + k; tp[0] = u.x; tp[1] = u.y; tp[2] = u.z; tp[3] = u.w; } }
            }
            __syncthreads();
            f32x16 acc;
#pragma unroll
            for (int r = 0; r < 16; ++r) acc[r] = 0.f;
            { const LAS float* ap = tile + (lane & 31) * 1025 + 128 * wave + (lane >> 5);
#pragma unroll
              for (int i = 0; i < 64; ++i) acc = __builtin_amdgcn_mfma_f32_32x32x2f32(ap[2 * i], wreg[i], acc, 0, 0, 0); }
            __syncthreads();
            LAS float* part = (LAS float*)lds;
#pragma unroll
            for (int r = 0; r < 16; ++r) part[(wave * 32 + (r & 3) + 8 * (r >> 2) + 4 * (lane >> 5)) * 32 + (lane & 31)] = acc[r];
            __syncthreads();
#pragma unroll 1
            for (int rr = 0; rr < 4; ++rr) {
                const int tr = wave * 4 + rr, m = grp * 64 + half * 32 + tr;
                float mylg = -INFINITY;
                if (lane < 32) { float s = P_b_router[lane];
#pragma unroll
                    for (int w8 = 0; w8 < 8; ++w8) s += part[(w8 * 32 + tr) * 32 + lane];
                    mylg = s; }
                int sel[4]; float sv[4];
#pragma unroll
                for (int k = 0; k < 4; ++k) { float bv = mylg; int bi = lane;
#pragma unroll
                    for (int off = 1; off < 64; off <<= 1) { const float ov = __shfl_xor(bv, off); const int oi = __shfl_xor(bi, off);
                        if (ov > bv || (ov == bv && oi < bi)) { bv = ov; bi = oi; } }
                    sel[k] = bi; sv[k] = bv; if (lane == bi) mylg = -INFINITY; }
                float den = 0.f, pe[4];
#pragma unroll
                for (int k = 0; k < 4; ++k) { pe[k] = __expf(sv[k] - sv[0]); den += pe[k]; }
                if (lane == 0) {
#pragma unroll
                    for (int k = 0; k < 4; ++k) { P_prob[m * 4 + k] = pe[k] / den; const int loc = __hip_atomic_fetch_add(lcnt + sel[k], 1, __ATOMIC_RELAXED, __HIP_MEMORY_SCOPE_WORKGROUP);
                        pel[(half * 32 + tr) * 4 + k] = (sel[k] << 16) | loc; }
                }
            }
            __syncthreads();
        }
        if (tid < NE) { const int c = lcnt[tid]; gbase[tid] = c ? (int)__hip_atomic_fetch_add(P_ctl + CW_CNT + 64 * tid, (unsigned)c, __ATOMIC_RELAXED, __HIP_MEMORY_SCOPE_AGENT) : 0; }
        __syncthreads();
        if (tid < 256) { const int v = pel[tid], e = v >> 16, loc = v & 0xffff; P_lists[(size_t)e * T + gbase[e] + loc] = grp * 256 + tid; }
        __syncthreads();
    }
}
constexpr int MOE_MAXU = 10;
struct MoeSched {
    const bf16* Bt_all; size_t bstride; int K, ncol, a_shift, lda, G, c, total;
    const LAS int* pre;
    const LAS int* idx;
    const LAS int* utab;
    __device__ __forceinline__ bool locate(int i, pg8::Unit& u) const {
        const int L = (G == 256) ? ((i * 8 + (c & 7)) * 32 + (c >> 3)) : (i * G + c);
        if (L >= total || i >= MOE_MAXU) return false;
        const int RT = L / ncol; u.pn = L - RT * ncol;
        int e = 0;
#pragma unroll 1
        for (int q = 1; q < NE; ++q) e += (pre[q] <= RT) ? 1 : 0;
        u.e = e; u.pm = RT - pre[e]; u.ui = i; return true;
    }
    __device__ __forceinline__ bool next(int i, pg8::Unit& u) const {
        if (i >= MOE_MAXU) return false;
        const pg8::v4i_t t = *(const LAS pg8::v4i_t*)(utab + 4 * i);
        u.e = t[0]; u.pm = t[1]; u.pn = t[2]; u.ui = i; return t[3] != 0;
    }
    __device__ __forceinline__ unsigned a_off(const pg8::Unit& u, int r, int C) const {
        int pair = idx[u.ui * 256 + r]; if (pair < 0) pair = idx[u.ui * 256];
        return (unsigned)(((size_t)(pair >> a_shift) * lda + C) * 2u);
    }
    __device__ __forceinline__ const char* b_base(const pg8::Unit& u) const { return (const char*)(Bt_all + (size_t)u.e * bstride + (size_t)u.pn * 256 * K); }
    __device__ __forceinline__ void a_ready(const pg8::Unit&) const {}
    __device__ __forceinline__ void done(const pg8::Unit&) const {}
};
__device__ __forceinline__ void moe_setup(const Params& p, MoeSched& S, LAS int* pre, LAS int* idx, int tid) {
    LAS int* utab = pre + 48;
    LAS int* cnts = pre + 96;
    if (tid < NE) {
        const int c = (int)__hip_atomic_load(P_ctl + CW_CNT + 64 * tid, __ATOMIC_RELAXED, __HIP_MEMORY_SCOPE_AGENT); cnts[tid] = c;
        int v = (c + 255) >> 8;
#pragma unroll
        for (int o = 1; o < 32; o <<= 1) { const int t = __shfl_up(v, o); if (tid >= o) v += t; }
        pre[tid + 1] = v; if (tid == 0) pre[0] = 0;
    }
    __syncthreads();
    S.pre = pre; S.idx = idx; S.utab = utab; S.total = pre[NE] * S.ncol;
    for (int i = 0; i < MOE_MAXU; ++i) { pg8::Unit u; const bool ok = S.locate(i, u);
        if (tid == 0) { utab[4 * i] = ok ? u.e : 0; utab[4 * i + 1] = ok ? u.pm : 0; utab[4 * i + 2] = ok ? u.pn : 0; utab[4 * i + 3] = ok ? 1 : 0; }
        if (!ok) continue;
        if (tid < 256) { const int cnt = cnts[u.e]; const int r = u.pm * 256 + tid;
            idx[i * 256 + tid] = r < cnt ? P_lists[(size_t)u.e * T + r] : -1; } }
    __syncthreads();
}
struct EpiAct {
    static constexpr bool PERM = true; static constexpr int MID_T = -1;
    bf16* ACT; const float* b_gu; const LAS int* idx;
    struct Pre { f32x4 bg0, bg1, bu0, bu1; };
    __device__ __forceinline__ Pre pre(const pg8::Unit& u, int, int wc, int, int fq) const { const float* bg = b_gu + (size_t)u.e * 2 * DFF + u.pn * 128 + wc * 32 + 8 * fq;
        return Pre{*(const f32x4*)bg, *(const f32x4*)(bg + 4), *(const f32x4*)(bg + DFF), *(const f32x4*)(bg + DFF + 4)}; }
    __device__ __forceinline__ void mid(pg8::f32x4 (&)[2][2][4][2], const pg8::Unit&, int, int, int, int) const {}
    __device__ __forceinline__ void operator()(pg8::f32x4 (&acc)[2][2][4][2], const pg8::Unit& u, int wr, int wc, int fr, int fq, const Pre& q) const {
        const int col = u.pn * 128 + wc * 32 + 8 * fq;
        const f32x4 bg0 = q.bg0, bg1 = q.bg1, bu0 = q.bu0, bu1 = q.bu1;
#pragma unroll
        for (int ai = 0; ai < 2; ++ai)
#pragma unroll
            for (int m = 0; m < 4; ++m) {
                const int pair = idx[u.ui * 256 + ai * 128 + wr * 64 + m * 16 + fr];
                float o[8];
#pragma unroll
                for (int n = 0; n < 2; ++n)
#pragma unroll
                    for (int j = 0; j < 4; ++j) { float g = acc[ai][0][m][n][j] * MOE_DESCALE + (n ? bg1[j] : bg0[j]); float up = acc[ai][1][m][n][j] * MOE_DESCALE + (n ? bu1[j] : bu0[j]);
                        g = fminf(g, 7.f); up = fminf(fmaxf(up, -7.f), 7.f);
                        o[n * 4 + j] = (up * A8_SCALE + A8_SCALE) * (g * __builtin_amdgcn_rcpf(1.f + __builtin_amdgcn_exp2f(-2.4554669595930156f * g))); }
                if (pair >= 0) { pg8::u32x2 w; int w0 = __builtin_amdgcn_cvt_pk_fp8_f32(o[0], o[1], 0, false); w0 = __builtin_amdgcn_cvt_pk_fp8_f32(o[2], o[3], w0, true);
                    int w1 = __builtin_amdgcn_cvt_pk_fp8_f32(o[4], o[5], 0, false); w1 = __builtin_amdgcn_cvt_pk_fp8_f32(o[6], o[7], w1, true); w.x = (unsigned)w0; w.y = (unsigned)w1;
                    *(pg8::u32x2*)((unsigned char*)ACT + (size_t)pair * DFF + col) = w; }
            }
    }
};
struct EpiY {
    static constexpr bool PERM = true; static constexpr int MID_T = -1;
    bf16* Y; const float* b_dn; const LAS int* idx;
    struct Pre { f32x4 b00, b01, b10, b11; };
    __device__ __forceinline__ Pre pre(const pg8::Unit& u, int, int wc, int, int fq) const { const float* bb = b_dn + (size_t)u.e * D + u.pn * 256 + wc * 32 + 8 * fq;
        return Pre{*(const f32x4*)bb, *(const f32x4*)(bb + 4), *(const f32x4*)(bb + 128), *(const f32x4*)(bb + 132)}; }
    __device__ __forceinline__ void mid(pg8::f32x4 (&)[2][2][4][2], const pg8::Unit&, int, int, int, int) const {}
    __device__ __forceinline__ void operator()(pg8::f32x4 (&acc)[2][2][4][2], const pg8::Unit& u, int wr, int wc, int fr, int fq, const Pre& q) const {
        const int col0 = u.pn * 256 + wc * 32 + 8 * fq;
        f32x4 bv[2][2]; bv[0][0] = q.b00; bv[0][1] = q.b01; bv[1][0] = q.b10; bv[1][1] = q.b11;
#pragma unroll
        for (int ai = 0; ai < 2; ++ai)
#pragma unroll
            for (int m = 0; m < 4; ++m) {
                const int pair = idx[u.ui * 256 + ai * 128 + wr * 64 + m * 16 + fr];
                if (pair >= 0) {
#pragma unroll
                    for (int bj = 0; bj < 2; ++bj) { const pg8::f32x4 v0 = acc[ai][bj][m][0] * MOE_DESCALE + bv[bj][0], v1 = acc[ai][bj][m][1] * MOE_DESCALE + bv[bj][1];
                        pg8::u32x4 w; w.x = pg8::cvt_pk_bf16(v0[0], v0[1]); w.y = pg8::cvt_pk_bf16(v0[2], v0[3]); w.z = pg8::cvt_pk_bf16(v1[0], v1[1]); w.w = pg8::cvt_pk_bf16(v1[2], v1[3]);
                        *(pg8::u32x4*)(Y + (size_t)pair * D + col0 + bj * 128) = w; }
                }
            }
    }
};
__device__ __forceinline__ void p9_rows(const Params& p, int wave, int lane, int vcu, int G) {
    for (int grp = vcu; grp < T / 64; grp += G) {
        const int row0 = grp * 64 + wave * 8, b = row0 / SEQ;
        f32x4 gf[2][2];
#pragma unroll
        for (int j = 0; j < 2; ++j)
#pragma unroll
            for (int q = 0; q < 2; ++q) { const int k = 8 * lane + 512 * j + 4 * q; gf[j][q] = *(const f32x4*)(P_modp + MODF_OFF + (size_t)(b * 4 + 3) * D + k) * *(const f32x4*)(P_g_post_ffn + k); }
#pragma unroll 1
        for (int rb = 0; rb < 8; rb += 2) {
            v4u yw[2][4][2]; f32x4 xv[2][2][2]; f32x4 pr[2];
#pragma unroll
            for (int r = 0; r < 2; ++r) { const int m = row0 + rb + r; pr[r] = *(const f32x4*)(P_prob + (size_t)m * 4);
#pragma unroll
                for (int kk = 0; kk < 4; ++kk)
#pragma unroll
                    for (int j = 0; j < 2; ++j) yw[r][kk][j] = __builtin_nontemporal_load((const GAS v4u*)(P_Y + ((size_t)m * 4 + kk) * D) + lane + 64 * j);
#pragma unroll
                for (int j = 0; j < 2; ++j)
#pragma unroll
                    for (int q = 0; q < 2; ++q) xv[r][j][q] = *((const GAS f32x4*)(P_out + (size_t)m * D) + 2 * lane + 128 * j + q); }
            f32x4 f[2][2][2]; float ss[2];
#pragma unroll
            for (int r = 0; r < 2; ++r) { float s = 0.f;
#pragma unroll
                for (int j = 0; j < 2; ++j) { f32x4 f0 = {0.f, 0.f, 0.f, 0.f}, f1 = f0;
#pragma unroll
                    for (int kk = 0; kk < 4; ++kk) { const v4u w = yw[r][kk][j]; const float pk = pr[r][kk];
                        f0 += (f32x4){__uint_as_float(w.x << 16), __uint_as_float(w.x & 0xffff0000u), __uint_as_float(w.y << 16), __uint_as_float(w.y & 0xffff0000u)} * pk;
                        f1 += (f32x4){__uint_as_float(w.z << 16), __uint_as_float(w.z & 0xffff0000u), __uint_as_float(w.w << 16), __uint_as_float(w.w & 0xffff0000u)} * pk; }
                    f[r][j][0] = f0; f[r][j][1] = f1; s += (f0.x * f0.x + f0.y * f0.y) + (f0.z * f0.z + f0.w * f0.w) + (f1.x * f1.x + f1.y * f1.y) + (f1.z * f1.z + f1.w * f1.w); }
                ss[r] = s; }
#pragma unroll
            for (int o = 1; o < 64; o <<= 1) {
#pragma unroll
                for (int r = 0; r < 2; ++r) ss[r] += __shfl_xor(ss[r], o); }
#pragma unroll
            for (int r = 0; r < 2; ++r) { const int m = row0 + rb + r; const float rstd = 1.f / sqrtf(ss[r] * (1.f / D) + EPS);
#pragma unroll
                for (int j = 0; j < 2; ++j)
#pragma unroll
                    for (int q = 0; q < 2; ++q) __builtin_nontemporal_store(xv[r][j][q] + gf[j][q] * (f[r][j][q] * rstd), (GAS f32x4*)(P_out + (size_t)m * D) + 2 * lane + 128 * j + q); }
        }
    }
}
}

namespace mk {
namespace at {
typedef float f32x16 __attribute__((ext_vector_type(16)));
typedef short s16x4 __attribute__((ext_vector_type(4)));
typedef short v4i16_t __attribute__((ext_vector_type(4)));
typedef LAS const char* lds_cptr;
constexpr int KSLOT = 8192, VSLOT = 16384;
constexpr int L_K = 0, L_V = 3 * KSLOT, L_WS = L_V + 3 * VSLOT, L_ST = L_WS + NW * 256, L_END = L_ST + NW * 8192;
static_assert(L_END <= MISC_OFF, "attention LDS map");
__device__ __forceinline__ int crow(int r, int hi) { return (r & 3) + 8 * (r >> 2) + 4 * hi; }
__device__ __forceinline__ void glds16(const void* gsrc, unsigned lds_dst) { unsigned keep;
    asm volatile("s_mov_b32 %0, m0\n\ts_mov_b32 m0, %2\n\ts_nop 0\n\tglobal_load_lds_dwordx4 %1, off\n\ts_mov_b32 m0, %0" : "=&s"(keep) : "v"(gsrc), "s"(lds_dst) : "memory"); }
__device__ __forceinline__ void glds16s(const void* sbase, unsigned voff, unsigned lds_dst) { unsigned keep;
    asm volatile("s_mov_b32 %0, m0\n\ts_mov_b32 m0, %3\n\ts_nop 0\n\tglobal_load_lds_dwordx4 %1, %2\n\ts_mov_b32 m0, %0" : "=&s"(keep) : "v"(voff), "s"(sbase), "s"(lds_dst) : "memory"); }
__device__ __forceinline__ unsigned cvtpk(float lo, float hi) { typedef float f2 __attribute__((ext_vector_type(2))); typedef __bf16 b2 __attribute__((ext_vector_type(2))); f2 v = {lo, hi}; b2 b = __builtin_convertvector(v, b2); return __builtin_bit_cast(unsigned, b); }
__device__ __forceinline__ s16x4 vtr(lds_cptr p) { return __builtin_bit_cast(s16x4, __builtin_amdgcn_ds_read_tr16_b64_v4i16((LAS v4i16_t*)p)); }
__device__ __forceinline__ float swap_max(float m) { auto rr = __builtin_amdgcn_permlane32_swap(__float_as_uint(m), __float_as_uint(m), false, false); return fmaxf(__uint_as_float(rr[0]), __uint_as_float(rr[1])); }
__device__ __forceinline__ float swap_sum(float m) { auto rr = __builtin_amdgcn_permlane32_swap(__float_as_uint(m), __float_as_uint(m), false, false); return __uint_as_float(rr[0]) + __uint_as_float(rr[1]); }
#define AT_MFMA(a, b, c) __builtin_amdgcn_mfma_f32_32x32x16_bf16(a, b, c, 0, 0, 0)
__device__ __forceinline__ float at_max3(float a, float b, float c) { float r; asm("v_max3_f32 %0, %1, %2, %3" : "=v"(r) : "v"(a), "v"(b), "v"(c)); return r; }

constexpr float THRL = 8.f;
template <int VAR>
__device__ __forceinline__ void attn_unit(const Params& p, LAS unsigned char* lds, int tid, int b, int h, int qb, float lam, bf16* AMo) {
    const int lane = tid & 63, r32 = lane & 31, hi = lane >> 5; const int wid = __builtin_amdgcn_readfirstlane(tid >> 6);
    const size_t rowbase = (size_t)b * SEQ;
    const int q0 = qb * 256 + wid * 32;
    const int NT = 4 * qb + 4;
    const int my_last = 4 * qb + (wid >> 1);
    const unsigned lds0 = (unsigned)(uintptr_t)lds;
    LAS float* wsf = (LAS float*)(lds + L_WS) + wid * 64;
    const lds_cptr kp0 = (lds_cptr)(lds + L_K) + hi * 1024 + r32 * 16;
    const lds_cptr vp0 = (lds_cptr)(lds + L_V) + ((lane >> 4) & 1) * 32 + (lane & 3) * 8 + (4 * hi + ((lane & 15) >> 2)) * 64;
    LAS unsigned short* const stg = (LAS unsigned short*)(lds + L_ST + wid * 8192);
#pragma unroll 1
    for (int mp = 0; mp < 2; ++mp) {
        const int n = 2 * h + mp;
        bf16x8 qr[4];
        { const bf16* qw = P_QKV + (rowbase + q0 + r32) * 3072 + n * 64 + hi * 8;
#pragma unroll
          for (int d0 = 0; d0 < 4; ++d0) qr[d0] = *(const GAS bf16x8*)(qw + d0 * 16); }
        asm volatile("" : "+v"(qr[0]), "+v"(qr[1]), "+v"(qr[2]), "+v"(qr[3]));
        const char* kbase = (const char*)(P_QKV + rowbase * 3072 + 1024 + n * 64 + wid * 8);
        const char* vbase = (const char*)(P_QKV + (rowbase + 16 * (wid & 3)) * 3072 + 2048 + h * 128 + (wid >> 2) * 32);
        const unsigned klo = (unsigned)lane * 6144u, vlo = (unsigned)(lane >> 2) * 6144u + (unsigned)(lane & 3) * 16u;
#define AT_DMA(t, s) do { const size_t to_ = (size_t)(t) * 64 * 6144; \
                          glds16s(kbase + to_, klo, (unsigned)__builtin_amdgcn_readfirstlane(lds0 + L_K + (s) * KSLOT + wid * 1024)); \
                          glds16s(vbase + to_, vlo, (unsigned)__builtin_amdgcn_readfirstlane(lds0 + L_V + (s) * VSLOT + wid * 1024)); \
                          glds16s(vbase + to_ + 128, vlo, (unsigned)__builtin_amdgcn_readfirstlane(lds0 + L_V + (s) * VSLOT + (wid + 8) * 1024)); } while (0)
        AT_DMA(0, 0); AT_DMA(1, 1);
        f32x16 o[4];
        float mrow = 0.f, lsum = 0.f;
        int s = 0;
        f32x16 pA0, pA1, pB0, pB1;
        f32x16 negm = {0.f, 0.f, 0.f, 0.f, 0.f, 0.f, 0.f, 0.f, 0.f, 0.f, 0.f, 0.f, 0.f, 0.f, 0.f, 0.f};
#define AT_KRD(dst, kb, d0) do { dst[0] = *(const LAS bf16x8*)((kb) + (d0) * 2048); dst[1] = *(const LAS bf16x8*)((kb) + (d0) * 2048 + 512); } while (0)
#define AT_QK(P0, P1, sl) do { const lds_cptr kb_ = kp0 + (sl) * KSLOT; bf16x8 ka_[2], kb2_[2]; \
            AT_KRD(ka_, kb_, 0); AT_KRD(kb2_, kb_, 1); __builtin_amdgcn_sched_barrier(0); \
            P0 = AT_MFMA(ka_[0], qr[0], negm); P1 = AT_MFMA(ka_[1], qr[0], negm); AT_KRD(ka_, kb_, 2); __builtin_amdgcn_sched_barrier(0); \
            P0 = AT_MFMA(kb2_[0], qr[1], P0); P1 = AT_MFMA(kb2_[1], qr[1], P1); AT_KRD(kb2_, kb_, 3); __builtin_amdgcn_sched_barrier(0); \
            P0 = AT_MFMA(ka_[0], qr[2], P0); P1 = AT_MFMA(ka_[1], qr[2], P1); __builtin_amdgcn_sched_barrier(0); \
            P0 = AT_MFMA(kb2_[0], qr[3], P0); P1 = AT_MFMA(kb2_[1], qr[3], P1); __builtin_amdgcn_sched_barrier(0); } while (0)
#define AT_VRD(i, ks0) do { const s16x4 lo_ = vtr(vb_ + ((i) & 3) * 4096 + ((ks0) + ((i) >> 2)) * 1024), hh_ = vtr(vb_ + ((i) & 3) * 4096 + ((ks0) + ((i) >> 2)) * 1024 + 512); \
            F_[i] = (bf16x8){lo_[0], lo_[1], lo_[2], lo_[3], hh_[0], hh_[1], hh_[2], hh_[3]}; } while (0)
#define AT_MX3(a, b, c) at_max3(a, b, c)
#define AT_STEP(PC0, PC1, PN0, PN1, T) do { \
            asm volatile("s_waitcnt vmcnt(0) lgkmcnt(0)\n\ts_barrier" ::: "memory");     \
            const int s1_ = (s == 2) ? 0 : s + 1, s2_ = (s1_ == 2) ? 0 : s1_ + 1; \
            if ((T) + 2 < NT) AT_DMA((T) + 2, s2_); \
            if (VAR != 1 && (T) <= my_last) { \
                float ra_ = AT_MX3(PC0[0], PC0[1], PC1[0]), rb_ = AT_MX3(PC0[2], PC0[3], PC1[1]); ra_ = AT_MX3(ra_, PC1[2], PC1[3]); \
                _Pragma("unroll") for (int r = 4; r < 16; r += 4) { ra_ = AT_MX3(ra_, PC0[r], PC0[r + 1]); rb_ = AT_MX3(rb_, PC0[r + 2], PC0[r + 3]); ra_ = AT_MX3(ra_, PC1[r], PC1[r + 1]); rb_ = AT_MX3(rb_, PC1[r + 2], PC1[r + 3]); } \
                float rm_ = swap_max(fmaxf(ra_, rb_));                   \
                if ((T) == 0 || __any(rm_ > THRL)) {                      \
                    const float dl_ = ((T) == 0) ? rm_ : fmaxf(rm_, 0.f); \
                    mrow += dl_; \
                    _Pragma("unroll") for (int r = 0; r < 16; ++r) { PC0[r] -= dl_; PC1[r] -= dl_; negm[r] = -mrow; } \
                    if ((T) != 0) { const float al_ = __builtin_amdgcn_exp2f(-dl_); lsum *= al_; \
                        if (hi == 0) wsf[r32] = al_; \
                        asm volatile("s_waitcnt lgkmcnt(0)" ::: "memory"); \
                        _Pragma("unroll") for (int r = 0; r < 16; ++r) { const float f_ = wsf[crow(r, hi)]; \
                            _Pragma("unroll") for (int d0 = 0; d0 < 4; ++d0) o[d0][r] *= f_; } } } \
                __builtin_amdgcn_sched_barrier(0); \
                if ((T) + 1 <= my_last) AT_QK(PN0, PN1, s1_);             \
                if (VAR == 2) { asm volatile("" :: "v"(PC0), "v"(PC1)); } else { \
                const lds_cptr vb_ = vp0 + s * VSLOT; v4u pw_[4]; bf16x8 F_[8]; float sacc_ = 0.f; \
                if (VAR != 3) { AT_VRD(0, 0); AT_VRD(1, 0); AT_VRD(2, 0); AT_VRD(3, 0); AT_VRD(4, 0); AT_VRD(5, 0); AT_VRD(6, 0); AT_VRD(7, 0); }     \
                __builtin_amdgcn_sched_barrier(0); \
                _Pragma("unroll") for (int r = 0; r < 16; ++r) { PC0[r] = __builtin_amdgcn_exp2f(PC0[r]); sacc_ += PC0[r]; } \
                _Pragma("unroll") for (int i = 0; i < 4; ++i) { pw_[0][i] = cvtpk(PC0[2 * i], PC0[2 * i + 1]); pw_[1][i] = cvtpk(PC0[8 + 2 * i], PC0[9 + 2 * i]); } \
                __builtin_amdgcn_sched_barrier(0); \
                  \
                AT_GAP1(PC1, 0); AT_GAP1(PC1, 1); AT_GAP1(PC1, 2); AT_GAP1(PC1, 3); AT_GAP1(PC1, 4); AT_GAP1(PC1, 5); AT_GAP1(PC1, 6); AT_GAP1(PC1, 7); \
                _Pragma("unroll") for (int i = 0; i < 4; ++i) { pw_[2][i] = cvtpk(PC1[2 * i], PC1[2 * i + 1]); pw_[3][i] = cvtpk(PC1[8 + 2 * i], PC1[9 + 2 * i]); } \
                lsum += sacc_; \
                __builtin_amdgcn_sched_barrier(0); \
                if (VAR != 3) { _Pragma("unroll") for (int i = 0; i < 8; ++i) o[i & 3] = AT_MFMA(__builtin_bit_cast(bf16x8, pw_[2 + (i >> 2)]), F_[i], o[i & 3]); } else { asm volatile("" :: "v"(pw_[0]), "v"(pw_[1]), "v"(pw_[2]), "v"(pw_[3])); } \
                __builtin_amdgcn_sched_barrier(0); \
            } } \
            s = s1_; } while (0)
#define AT_GAP1(P1, i) do { if (VAR != 3) { o[(i) & 3] = AT_MFMA(__builtin_bit_cast(bf16x8, pw_[(i) >> 2]), F_[i], o[(i) & 3]); AT_VRD(i, 2); } \
            P1[2 * (i)] = __builtin_amdgcn_exp2f(P1[2 * (i)]); P1[2 * (i) + 1] = __builtin_amdgcn_exp2f(P1[2 * (i) + 1]); sacc_ += P1[2 * (i)]; sacc_ += P1[2 * (i) + 1]; \
            asm volatile("" : "+v"(P1), "+v"(sacc_)); __builtin_amdgcn_sched_barrier(0); } while (0)
        asm volatile("s_waitcnt vmcnt(3)\n\ts_barrier" ::: "memory");
#pragma unroll
        for (int r = 0; r < 16; ++r) {
#pragma unroll
            for (int d0 = 0; d0 < 4; ++d0) o[d0][r] = 0.f; }
        if (VAR != 1) AT_QK(pA0, pA1, 0);
        asm volatile("s_nop 7\n\ts_nop 7" ::: "memory");
#pragma unroll 1
        for (int t = 0; t < NT; t += 2) {
            AT_STEP(pA0, pA1, pB0, pB1, t);
            AT_STEP(pB0, pB1, pA0, pA1, t + 1);
        }
        asm volatile("s_waitcnt lgkmcnt(0)\n\ts_barrier" ::: "memory");
#undef AT_STEP
#undef AT_GAP1
#undef AT_MX3
#undef AT_VRD
#undef AT_QK
#undef AT_KRD
        int le_ = lane; asm volatile("" : "+v"(le_)); const int r32e = le_ & 31, hie = le_ >> 5;
        LAS unsigned short* const stge = (LAS unsigned short*)(lds + L_ST + wid * 8192) + r32e;
        lsum = swap_sum(lsum);
        if (hie == 0) wsf[32 + r32e] = 1.f / lsum;
        asm volatile("s_waitcnt lgkmcnt(0)" ::: "memory");
        float rli[16];
#pragma unroll
        for (int r = 0; r < 16; ++r) rli[r] = wsf[32 + crow(r, hie)];
        asm volatile("s_waitcnt lgkmcnt(0)" ::: "memory");
        if (mp == 0) {
#pragma unroll
            for (int r = 0; r < 16; ++r) { const int q = crow(r, hie);
#pragma unroll
                for (int d0 = 0; d0 < 4; ++d0) stge[q * 128 + 32 * d0] = (unsigned short)f2bf(o[d0][r] * rli[r]); }
            asm volatile("s_waitcnt lgkmcnt(0)" ::: "memory");
        } else {
            float ssq[16];
#pragma unroll
            for (int r = 0; r < 16; ++r) { ssq[r] = 0.f; const int q = crow(r, hie);
#pragma unroll
                for (int d0 = 0; d0 < 4; ++d0) { const float a0 = __uint_as_float((unsigned)stge[q * 128 + 32 * d0] << 16); const float v0 = a0 - lam * (o[d0][r] * rli[r]); o[d0][r] = v0; ssq[r] += v0 * v0; } }
            asm volatile("s_waitcnt lgkmcnt(0)" ::: "memory");
#pragma unroll
            for (int off = 1; off < 32; off <<= 1)
#pragma unroll
                for (int r = 0; r < 16; ++r) ssq[r] += __shfl_xor(ssq[r], off);
#pragma unroll
            for (int r = 0; r < 16; ++r) { const float rs = (1.f / sqrtf(ssq[r] * (1.f / 128.f) + EPS)) * 0.8f; const int q = crow(r, hie);
#pragma unroll
                for (int d0 = 0; d0 < 4; ++d0) { stge[q * 128 + 32 * d0] = (unsigned short)f2bf(o[d0][r] * rs * P_g_sub[r32e + 32 * d0]); } }
            asm volatile("s_waitcnt lgkmcnt(0)" ::: "memory");
            bf16* ow = AMo + (rowbase + q0) * 1536 + h * 128;
#pragma unroll
            for (int i = 0; i < 8; ++i) { const int row = i * 4 + (le_ >> 4), ch = le_ & 15; const v4u v = *(const LAS v4u*)(stge - r32e + row * 128 + ch * 8); *(GAS v4u*)(ow + (size_t)row * 1536 + ch * 8) = v; }
        }
#undef AT_DMA
    }
}
}
template <int VAR = 0>
__device__ __forceinline__ void attn_phase(const Params& p, LAS unsigned char* lds, int tid, int vcu, int G) {
    const float lam = lam_value(p, tid & 63);
    bf16* AMo = VAR == 0 ? P_AM : P_ACT;
    for (int pr = vcu; pr < 256; pr += G) {
        const int bh = pr >> 2, s = pr & 3, b = bh >> 3, h = bh & 7;
#pragma unroll 1
        for (int u = 0; u < 2; ++u) at::attn_unit<VAR>(p, lds, tid, b, h, u ? 7 - s : s, lam, AMo);
    }
}
}

namespace mk {
constexpr int NPH = 10;
#ifndef MK_SKIP
#define MK_SKIP 0
#endif
#ifndef MK_REPEAT
#define MK_REPEAT 0
#endif
#ifndef MK_PROFILE_PREFIX
#define MK_PROFILE_PREFIX 0
#endif
__global__ void __launch_bounds__(NTHR, 2) mega(Params p) {
    extern __shared__ __attribute__((aligned(16))) unsigned char lds_raw[];
    LAS unsigned char* lds = (LAS unsigned char*)lds_raw;
    volatile LAS unsigned* MISC = (volatile LAS unsigned*)(lds + MISC_OFF);
    const int tid0 = threadIdx.x;
    typedef __attribute__((address_space(4))) const Params CParams;
    CParams* const kp0 = (CParams*)__builtin_amdgcn_kernarg_segment_ptr();
#define FRESH int tid = tid0; asm volatile("" : "+v"(tid)); const int lane = tid & 63, wave = __builtin_amdgcn_readfirstlane(tid >> 6); (void)lane; (void)wave; \
              CParams* kp_ = kp0; asm volatile("" : "+s"(kp_)); Params p; { typedef __attribute__((address_space(4))) const unsigned long long cu64_; cu64_* s_ = (cu64_*)kp_; unsigned long long* d_ = (unsigned long long*)&p; \
              _Pragma("unroll") for (int i_ = 0; i_ < (int)(sizeof(Params) / 8); ++i_) d_[i_] = s_[i_]; }
    const int G = gridDim.x; const int bx = blockIdx.x; const int vcu = (G % 8 == 0) ? (bx % 8) * (G / 8) + bx / 8 : bx;
    if (tid0 < 64) MISC[tid0] = 0u;
    __syncthreads();
    XcdBarrier bar = xcd_barrier_post(P_ctl + CW_BAR + p.li * XCD_BAR_WORDS, MISC + 8);
    LAS int* pre = (LAS int*)(lds + TAB_OFF); LAS int* idx = (LAS int*)(lds + TAB_OFF + 512);
#ifdef MK_DOUBLE_BAR
#define SEAM(k) do { if (IN(k) && IN((k) + 1)) { xcd_barrier(bar); xcd_barrier(bar); } } while (0)
#else
#define SEAM(k) do { if (IN(k) && IN((k) + 1)) xcd_barrier(bar); } while (0)
#endif
#ifndef MK_ATTN_VAR
#define MK_ATTN_VAR 0
#endif
#define PHASE(k, ...) if (IN(k) && !(MK_SKIP & (1 << (k)))) { { FRESH; __VA_ARGS__ } if (MK_REPEAT & (1 << (k))) { __syncthreads(); FRESH; __VA_ARGS__ } } SEAM(k);
#ifdef MK_P2_NULL
#define PHASE_P2NULL if (IN(2)) { FRESH; pg8::Gemm g{P_U, D}; pg8::StaticOrder S; S.init(T, INW, D, D, P_Wt_in, G, bx); EpiNull E{}; pg8::gemm_phase<EpiNull, pg8::StaticOrder, true>(lds + RING_OFF, g, S, E, tid); xcd_barrier(bar); }
#else
#define PHASE_P2NULL
#endif
#ifdef MK_P7_NULL
#define PHASE_P7NULL if (IN(7)) { FRESH; MoeSched S{P_Wt_gu, (size_t)2 * DFF * D / 2, D / 2, 8, 2, D / 2, G, bx, 0, nullptr, nullptr, nullptr}; moe_setup(p, S, pre, idx, tid); pg8::Gemm g{P_U, D / 2}; EpiNull E{}; pg8::gemm_phase<EpiNull, MoeSched, true, true>(lds + RING_OFF, g, S, E, tid); xcd_barrier(bar); }
#else
#define PHASE_P7NULL
#endif
#define PROGRAM \
    PHASE(0, p0_prologue(p, lds, tid, wave, lane, vcu, G);) \
    PHASE(1, p1_rows(p, lds, tid, wave, lane, vcu, G);) \
    PHASE(2, pg8::Gemm g{P_U, D}; pg8::StaticOrder S; S.init(T, INW, D, D, P_Wt_in, G, bx); \
             EpiZ E{P_QKV, P_PB, P_GR, P_SGP, P_rope}; \
             pg8::gemm_phase<EpiZ, pg8::StaticOrder, true>(lds + RING_OFF, g, S, E, tid);) \
    PHASE_P2NULL \
    PHASE(3, if (!(p.flags & 2)) attn_phase<0>(p, lds, tid, vcu, G); \
             pool_phase(p, lds, tid, wave, lane, vcu, G); \
             if (MK_ATTN_VAR) { __syncthreads(); attn_phase<MK_ATTN_VAR>(p, lds, tid, vcu, G); }) \
    PHASE(4, pg8::Gemm g{P_AM, 1536}; pg8::StaticOrder S; S.init(T, D, 1536, 1536, P_Wt_mix, G, bx); \
             EpiMerge E{P_GR, P_SGP, P_MERGED}; \
             pg8::gemm_phase<EpiMerge, pg8::StaticOrder, true>(lds + RING_OFF, g, S, E, tid);) \
    PHASE(5, if (MK_PROFILE_PREFIX && bx == 0 && tid < NE) __hip_atomic_store(P_ctl + CW_CNT + 64 * tid, 0u, __ATOMIC_RELAXED, __HIP_MEMORY_SCOPE_AGENT); \
             pg8::Gemm g{P_MERGED, D}; pg8::StaticOrder S; S.init(T, D, D, D, P_Wt_out, G, bx); \
             EpiStore E{P_MIXOUT, D}; \
             pg8::gemm_phase<EpiStore, pg8::StaticOrder, true>(lds + RING_OFF, g, S, E, tid);) \
    PHASE(6, p6_rows(p, lds, tid, wave, lane, vcu, G);) \
    PHASE(7, MoeSched S{P_Wt_gu, (size_t)2 * DFF * D / 2, D / 2, 8, 2, D / 2, G, bx, 0, nullptr, nullptr, nullptr};     \
             moe_setup(p, S, pre, idx, tid); \
             pg8::Gemm g{P_U, D / 2}; EpiAct E{P_ACT, P_b_gu, idx}; \
             pg8::gemm_phase<EpiAct, MoeSched, true, true>(lds + RING_OFF, g, S, E, tid);) \
    PHASE_P7NULL \
    PHASE(8, MoeSched S{P_Wt_dn, (size_t)D * DFF / 2, DFF / 2, 4, 0, DFF / 2, G, bx, 0, nullptr, nullptr, nullptr}; \
             moe_setup(p, S, pre, idx, tid); \
             pg8::Gemm g{P_ACT, DFF / 2}; EpiY E{P_Y, P_b_dn, idx}; \
             pg8::gemm_phase<EpiY, MoeSched, true, true>(lds + RING_OFF, g, S, E, tid);) \
    PHASE(9, p9_rows(p, wave, lane, vcu, G);)
#if MK_PROFILE_PREFIX
    {
#define IN(k) ((k) < MK_PROFILE_PREFIX)
        PROGRAM
#undef IN
        xcd_barrier(bar);
    }
#endif
    {
        const int lo = p.ph_lo, hi = p.ph_hi;
#define IN(k) (lo <= (k) && (k) < hi)
        PROGRAM
#undef IN
    }
#undef PROGRAM
#undef SEAM
#undef PHASE
#undef FRESH
}
}

static int g_grid = 0;
static int mk_setup() {
    if (g_grid) return g_grid;
    int dev = 0, cus = 0;
    if (hipGetDevice(&dev) != hipSuccess || hipDeviceGetAttribute(&cus, hipDeviceAttributeMultiprocessorCount, dev) != hipSuccess) { g_grid = -1; return -1; }
    if (hipFuncSetAttribute((const void*)mk::mega, hipFuncAttributeMaxDynamicSharedMemorySize, mk::LDS_BYTES) != hipSuccess) { g_grid = -1; return -1; }
    int per_cu = 0;
    if (hipOccupancyMaxActiveBlocksPerMultiprocessor(&per_cu, (const void*)mk::mega, mk::NTHR, mk::LDS_BYTES) != hipSuccess || per_cu < 1) { fprintf(stderr, "kernel_launch: occupancy query reports %d workgroups per CU\n", per_cu); }
    (void)hipGetLastError();
    g_grid = cus;
    return g_grid;
}
extern "C" void kernel_launch(void* const* d_in, const int* in_sizes, int n_in, void* d_out, int out_size, void* d_ws, size_t ws_size, hipStream_t stream) {
    if (mk_setup() < 0 || n_in != 26) return;
    unsigned char* wsb = (unsigned char*)d_ws;
    const size_t MiB = 1u << 20;
    mk::Params p{};
    p.x = (const GAS float*)d_in[0]; p.c = (const GAS float*)d_in[1]; p.pos = (const GAS int*)d_in[2]; p.w_mod = (const GAS float*)d_in[3]; p.b_mod = (const GAS float*)d_in[4]; p.g_pre_mix = (const GAS float*)d_in[5];
    p.w_in = (const GAS float*)d_in[6]; p.lq1 = (const GAS float*)d_in[7]; p.lk1 = (const GAS float*)d_in[8]; p.lq2 = (const GAS float*)d_in[9]; p.lk2 = (const GAS float*)d_in[10]; p.g_sub = (const GAS float*)d_in[11];
    p.w_pg = (const GAS float*)d_in[12]; p.pool_scale = (const GAS float*)d_in[13]; p.w_att = (const GAS float*)d_in[14]; p.w_pb = (const GAS float*)d_in[15]; p.w_out = (const GAS float*)d_in[16];
    p.g_post_mix = (const GAS float*)d_in[17]; p.g_pre_ffn = (const GAS float*)d_in[18]; p.w_router = (const GAS float*)d_in[19]; p.b_router = (const GAS float*)d_in[20];
    p.w_gu = (const GAS float*)d_in[21]; p.b_gu = (const GAS float*)d_in[22]; p.w_dn = (const GAS float*)d_in[23]; p.b_dn = (const GAS float*)d_in[24]; p.g_post_ffn = (const GAS float*)d_in[25];
    p.out = (GAS float*)d_out;
    size_t off = 0;
    auto carve = [&](size_t mib) { unsigned char* r = wsb + off; off += mib * MiB; return r; };
    p.ctl = (GAS unsigned*)carve(1); p.modp = (GAS float*)carve(2); p.rope = (GAS float*)carve(1);
    p.Wt_in = (GAS bf16*)carve(11); p.Wt_mix = (GAS bf16*)carve(3); p.Wt_out = (GAS bf16*)carve(2); p.Wt_pg = (GAS bf16*)carve(1);
    p.prob = (GAS float*)carve(1); p.lists = (GAS int*)carve(2);
    p.U = (GAS bf16*)carve(32); p.QKV = (GAS bf16*)carve(96); p.PB = (GAS bf16*)carve(16); p.GR = (GAS bf16*)carve(32); p.SGP = (GAS bf16*)carve(32);
    p.AM = (GAS bf16*)carve(48); p.MERGED = (GAS bf16*)carve(32); p.MIXOUT = (GAS bf16*)carve(32);
    p.Wt_gu = (GAS bf16*)carve(128); p.Wt_dn = (GAS bf16*)carve(64); p.ACT = (GAS bf16*)carve(128); p.Y = (GAS bf16*)carve(128);
    if (off > ws_size) { fprintf(stderr, "kernel_launch: workspace too small: need %zu, have %zu\n", off, ws_size); return; }
    p.flags = 0; p.ph_lo = 0; p.ph_hi = mk::NPH; p.li = 0;
    if (hipMemsetAsync(wsb, 0, 1 * MiB, stream) != hipSuccess) return;
    hipLaunchKernelGGL(mk::mega, dim3(g_grid), dim3(mk::NTHR), mk::LDS_BYTES, stream, p);
}
```

```cpp
#include <hip/hip_runtime.h>
#include <hip/hip_bf16.h>
#include <cstdio>
#include <cstdint>
#include <cmath>
#define GAS __attribute__((address_space(1)))
#define LAS __attribute__((address_space(3)))
typedef unsigned short bf16;
typedef unsigned v4u __attribute__((ext_vector_type(4)));
typedef float f32x4 __attribute__((ext_vector_type(4)));
typedef short bf16x8 __attribute__((ext_vector_type(8)));
typedef GAS unsigned gu32;
typedef GAS unsigned long long gu64;
#define RLX_AGENT __ATOMIC_RELAXED, __HIP_MEMORY_SCOPE_AGENT
#define LDS_WAIT() asm volatile("s_waitcnt lgkmcnt(0)" ::: "memory")
#define VM_WAIT() asm volatile("s_waitcnt vmcnt(0)" ::: "memory")
__device__ __forceinline__ unsigned long long rt() { return __builtin_amdgcn_s_memrealtime(); }
__device__ __forceinline__ unsigned f2bf(float f) { unsigned u = __builtin_bit_cast(unsigned, f); return (u + 0x7fffu + ((u >> 16) & 1u)) >> 16; }
__device__ __forceinline__ unsigned pk2(float lo, float hi) { return f2bf(lo) | (f2bf(hi) << 16); }

#define XB_TMO      128
#define XB_XCNT(j)  (256  + 64 * (j))
#define XB_XSUB(j)  (1280 + 64 * (j))
#define XB_XGEN(j)  (2304 + 64 * (j))
#define XB_TOP      3328
#define XB_TOPGEN   3392
#define XCD_BAR_WORDS 3456
#define XB_SPIN_CAP (1u << 18)

__device__ __forceinline__ unsigned xb_ld(unsigned* p)              { return __hip_atomic_load(p, __ATOMIC_RELAXED, __HIP_MEMORY_SCOPE_AGENT); }
__device__ __forceinline__ unsigned xb_add(unsigned* p, unsigned v) { return __hip_atomic_fetch_add(p, v, __ATOMIC_RELAXED, __HIP_MEMORY_SCOPE_AGENT); }
__device__ __forceinline__ unsigned xb_xcc_id() { return (unsigned)__builtin_amdgcn_s_getreg((3 << 11) | 20) & 0xFu; }
#define XB_SPIN(cond, bar) do { unsigned _sp = 0; while (cond) { __builtin_amdgcn_s_sleep(1); \
    if ((++_sp & 255u) == 0u) { if (xb_ld(&(bar)[XB_TMO])) break; if (_sp > XB_SPIN_CAP) { atomicAdd(&(bar)[XB_TMO], 1u); break; } } } } while (0)

struct XcdBarrier {
    unsigned* bar; unsigned x;
    volatile LAS unsigned* st;
};

__device__ __forceinline__ XcdBarrier xcd_barrier_post(unsigned* bar, volatile LAS unsigned* st) {
    XcdBarrier b; b.bar = bar; b.x = xb_xcc_id(); b.st = st;
    if (threadIdx.x == 0) (void)xb_add(&bar[XB_XCNT(b.x)], 1u);
    return b;
}
__device__ __forceinline__ void xcd_barrier_complete(unsigned* bar, unsigned x, unsigned& nloc, unsigned& nx) {
    const unsigned G = gridDim.x * gridDim.y * gridDim.z;
    unsigned sum, cnt, mine, sp = 0u;
    for (;;) {
        sum = 0u; cnt = 0u; mine = 0u;
#pragma unroll
        for (unsigned j = 0; j < 16; ++j) { const unsigned c = xb_ld(&bar[XB_XCNT(j)]); sum += c; cnt += (c > 0u) ? 1u : 0u; mine = (j == x) ? c : mine; }
        if (sum == G) break;
        __builtin_amdgcn_s_sleep(1);
        if ((++sp & 255u) == 0u) { if (xb_ld(&bar[XB_TMO])) break; if (sp > XB_SPIN_CAP) { atomicAdd(&bar[XB_TMO], 1u); break; } }
    }
    nloc = mine > 0u ? mine : 1u; nx = cnt > 0u ? cnt : 1u;
}

__device__ __forceinline__ void xcd_barrier(const XcdBarrier& b) {
    asm volatile("s_waitcnt vmcnt(0)" ::: "memory");
    __syncthreads();
    if (threadIdx.x == 0) {
        unsigned* bar = b.bar;
        __builtin_amdgcn_s_waitcnt(0);
        unsigned nloc = b.st[0], nx = b.st[1];
        if (nloc == 0u) { xcd_barrier_complete(bar, b.x, nloc, nx); b.st[0] = nloc; b.st[1] = nx; }
        const unsigned old = xb_add(&bar[XB_XSUB(b.x)], 1u);
        const unsigned gen = old / nloc;
        if (old + 1u == (gen + 1u) * nloc) {
            __builtin_amdgcn_fence(__ATOMIC_RELEASE, "agent");
            asm volatile("s_waitcnt vmcnt(0)" ::: "memory");
            const unsigned og = xb_add(&bar[XB_TOP], 1u);
            const unsigned tg = og / nx;
            if (og + 1u == (tg + 1u) * nx) xb_add(&bar[XB_TOPGEN], 1u);
            else XB_SPIN(xb_ld(&bar[XB_TOPGEN]) == tg, bar);
            __builtin_amdgcn_fence(__ATOMIC_ACQUIRE, "agent");
            xb_add(&bar[XB_XGEN(b.x)], 1u);
            asm volatile("s_waitcnt vmcnt(0)" ::: "memory");
        } else {
            XB_SPIN(xb_ld(&bar[XB_XGEN(b.x)]) == gen, bar);
            __builtin_amdgcn_fence(__ATOMIC_ACQUIRE, "agent");
            asm volatile("s_waitcnt vmcnt(0)" ::: "memory");
        }
    }
    __syncthreads();
}


namespace pg8 {
#define PG8_LAS __attribute__((address_space(3)))
typedef unsigned short bf16_t;
typedef short bf16x8 __attribute__((ext_vector_type(8)));
typedef float f32x4 __attribute__((ext_vector_type(4)));
typedef unsigned u32x4 __attribute__((ext_vector_type(4)));
typedef unsigned u32x2 __attribute__((ext_vector_type(2)));
constexpr int BM = 256, BK = 64, HALF = 128, HTB = HALF * BK * 2  , STAGE_BYTES = 8 * HTB, NXCD = 8, WGM = 8;

__host__ __device__ __forceinline__ int lds_byte(int r, int c) { const int st = (r >> 4) * 2 + (c >> 5), rr = r & 15, cc = c & 31, ob = rr * 64 + cc * 2; return st * 1024 + (ob ^ (((ob >> 9) & 1) << 5)); }
__host__ __device__ __forceinline__ void stage_rc(int b, int& R, int& C) { const int st = b / 1024, sb = b % 1024, swz = sb ^ (((sb >> 9) & 1) << 5); R = (st >> 1) * 16 + swz / 64; C = (st & 1) * 32 + (swz % 64) / 2; }
__host__ __device__ __forceinline__ int perm32(int rho) { const int n = rho >> 4, i = rho & 15; return 8 * (i >> 2) + 4 * n + (i & 3); }

struct Unit { int pm, pn, e, ui; };
struct Gemm { const bf16_t* A; int K; };

struct StaticOrder {
    int nM, nN, nwg, G, c, lda; const bf16_t* Bt; int K;
    __device__ void init(int M, int N, int K_, int lda_, const bf16_t* Bt_, int G_, int c_) { nM = M / BM; nN = N / BM; nwg = nM * nN; G = G_; c = c_; lda = lda_; Bt = Bt_; K = K_; }
    __device__ bool next(int i, Unit& u) const {
        const long L = (long)i * G + c; if (L >= nwg) return false;
        int wgid = (int)L; { const int q = nwg / NXCD, r = nwg % NXCD, xcd = wgid % NXCD, off = wgid / NXCD; wgid = (xcd < r ? xcd * (q + 1) : r * (q + 1) + (xcd - r) * q) + off; }
        const int nig = WGM * nN, gid = wgid / nig, fm = gid * WGM;
        u.pm = fm + ((wgid % nig) % WGM); u.pn = (wgid % nig) / WGM; u.e = 0; u.ui = i; return true;
    }
    __device__ __forceinline__ unsigned a_off(const Unit& u, int r, int C) const { return (unsigned)(((size_t)(u.pm * BM + r) * lda + C) * 2u); }
    __device__ __forceinline__ const char* b_base(const Unit& u) const { return (const char*)Bt + (size_t)u.pn * BM * K * 2; }
    __device__ __forceinline__ void a_ready(const Unit&) const {}
    __device__ __forceinline__ void done(const Unit&) const {}
};

typedef int v8i_t __attribute__((ext_vector_type(8))); typedef int v4i_t __attribute__((ext_vector_type(4)));
__device__ __forceinline__ v8i_t cat8(bf16x8 a, bf16x8 b) { const v4i_t x = __builtin_bit_cast(v4i_t, a), y = __builtin_bit_cast(v4i_t, b); return __builtin_shufflevector(x, y, 0, 1, 2, 3, 4, 5, 6, 7); }
__device__ __forceinline__ unsigned cvt_pk_bf16(float lo, float hi) { unsigned r; asm volatile("v_cvt_pk_bf16_f32 %0, %1, %2" : "=v"(r) : "v"(lo), "v"(hi)); return r; }

template <class Epi, class Sched, bool ALIGN_EPI = true, bool FP8 = false>
__device__ __forceinline__ void gemm_phase(PG8_LAS unsigned char* lds, const Gemm g, const Sched& S, const Epi& E, const int tid) {
    const int wid = __builtin_amdgcn_readfirstlane(tid >> 6), lane = tid & 63, wr = wid >> 2, wc = wid & 3, fr = lane & 15, fq = lane >> 4;
    const int K = g.K, nt = K / BK;
    unsigned voffB[2];
#pragma unroll
    for (int i = 0; i < 2; ++i) { int R, C; stage_rc(tid * 16 + i * 8192, R, C); const int Rb = Epi::PERM ? ((R & ~31) + perm32(R & 31)) : R; voffB[i] = (unsigned)(Rb * K + C) * 2u; }
#define PG8_AOFF(dst, unit) do { _Pragma("unroll") for (int _i = 0; _i < 2; ++_i) { int _R, _C; stage_rc(tid * 16 + _i * 8192, _R, _C); dst[0][_i] = S.a_off(unit, _R, _C); dst[1][_i] = S.a_off(unit, HALF + _R, _C); } } while (0)
    const size_t kstep = (size_t)(BK * 2);
    const size_t hstepB = (size_t)HALF * K * 2;
    const unsigned ldsw = (unsigned)wid * 1024u;
    const int aoff = lds_byte(wr * 64 + fr, fq * 8), boff = lds_byte(wc * 32 + fr, fq * 8);
#define PG8_SA(b, h) (((b) * 2 + (h)) * HTB)
#define PG8_SB(b, h) ((4 + (b) * 2 + (h)) * HTB)
#define PG8_STAGE(bufoff, gbase, voff) do { _Pragma("unroll") for (int _i = 0; _i < 2; ++_i) { unsigned _o = (voff)[_i]; asm volatile("" : "+v"(_o));     \
        __builtin_amdgcn_global_load_lds((const unsigned*)((const char*)(gbase) + _o), (PG8_LAS unsigned*)(lds + (bufoff) + ldsw + _i * 8192), 16, 0, 0); } } while (0)
#define PG8_LDA(dst, b, h) do { _Pragma("unroll") for (int m = 0; m < 4; ++m) { const v4i_t _lo = *(const PG8_LAS v4i_t*)(lds + PG8_SA(b, h) + aoff + m * 2048), _hi = *(const PG8_LAS v4i_t*)(lds + PG8_SA(b, h) + aoff + m * 2048 + 1024); \
        dst[m] = __builtin_shufflevector(_lo, _hi, 0, 1, 2, 3, 4, 5, 6, 7); } } while (0)
#define PG8_LDB(dst, b, h) do { _Pragma("unroll") for (int n = 0; n < 2; ++n) { const v4i_t _lo = *(const PG8_LAS v4i_t*)(lds + PG8_SB(b, h) + boff + n * 2048), _hi = *(const PG8_LAS v4i_t*)(lds + PG8_SB(b, h) + boff + n * 2048 + 1024); \
        dst[n] = __builtin_shufflevector(_lo, _hi, 0, 1, 2, 3, 4, 5, 6, 7); } } while (0)
#define PG8_LO(v) __builtin_bit_cast(bf16x8, __builtin_shufflevector(v, v, 0, 1, 2, 3))
#define PG8_HI(v) __builtin_bit_cast(bf16x8, __builtin_shufflevector(v, v, 4, 5, 6, 7))
#define PG8_MMA(ai, bj, At, Bt) do { __builtin_amdgcn_s_setprio(1); \
        if constexpr (FP8) { _Pragma("unroll") for (int m = 0; m < 4; ++m) _Pragma("unroll") for (int n = 0; n < 2; ++n) \
            asm volatile("v_mfma_scale_f32_16x16x128_f8f6f4 %0, %1, %2, %0, %3, %3 op_sel_hi:[0,0,0]" : "+v"(acc[ai][bj][m][n]) : "v"(Bt[n]), "v"(At[m]), "v"(sc1)); } \
        else { _Pragma("unroll") for (int m = 0; m < 4; ++m) _Pragma("unroll") for (int n = 0; n < 2; ++n) { \
            acc[ai][bj][m][n] = __builtin_amdgcn_mfma_f32_16x16x32_bf16(PG8_LO(Bt[n]), PG8_LO(At[m]), acc[ai][bj][m][n], 0, 0, 0); \
            acc[ai][bj][m][n] = __builtin_amdgcn_mfma_f32_16x16x32_bf16(PG8_HI(Bt[n]), PG8_HI(At[m]), acc[ai][bj][m][n], 0, 0, 0); } } \
        __builtin_amdgcn_s_setprio(0); } while (0)
#define PG8_WAIT_V(n) asm volatile("s_waitcnt vmcnt(" #n ")" ::: "memory")
#define PG8_WAIT_L(n) asm volatile("s_waitcnt lgkmcnt(" #n ")" ::: "memory")
#define PG8_BAR __builtin_amdgcn_s_barrier()
#define PG8_SCHED __builtin_amdgcn_sched_barrier(0)
    Unit cur, nxt; int ui = 0;
    if (!S.next(0, cur)) return;
    f32x4 acc[2][2][4][2];
    int sc1 = 0x7F7F7F7F; asm volatile("" : "+v"(sc1));
    typename Epi::Pre pre{};
    v8i_t At[4], B0[2], B1[2];
    const char* const Ab = (const char*)g.A;
    unsigned aoc[2][2];
    PG8_AOFF(aoc, cur);
    const char* cB = S.b_base(cur);
    S.a_ready(cur);
    PG8_STAGE(PG8_SB(0, 0), cB, voffB); PG8_STAGE(PG8_SB(0, 1), cB + hstepB, voffB); PG8_STAGE(PG8_SA(0, 0), Ab, aoc[0]); PG8_STAGE(PG8_SA(0, 1), Ab, aoc[1]);
    if (wr == 1) PG8_BAR;
    PG8_WAIT_V(2); PG8_BAR;
    PG8_STAGE(PG8_SB(1, 0), cB + kstep, voffB); PG8_STAGE(PG8_SA(1, 0), Ab + kstep, aoc[0]); PG8_STAGE(PG8_SB(1, 1), cB + hstepB + kstep, voffB);
    PG8_WAIT_V(6); PG8_BAR;
#pragma unroll
    for (int a = 0; a < 2; ++a)
#pragma unroll
        for (int b = 0; b < 2; ++b)
#pragma unroll
            for (int m = 0; m < 4; ++m)
#pragma unroll
                for (int n = 0; n < 2; ++n) acc[a][b][m][n] = (f32x4){0.f, 0.f, 0.f, 0.f};
    for (;;) {
        const bool has_next = S.next(ui + 1, nxt);
        const char* nB = has_next ? S.b_base(nxt) : cB;
        int t = 0;
#pragma unroll 1
        for (int seg = 0; seg < (Epi::MID_T >= 0 ? 2 : 1); ++seg) {
        const int tend = (Epi::MID_T >= 0 && seg == 0) ? Epi::MID_T : nt;
#pragma unroll 1
        for (; t < tend; t += 2) {
            const bool last = (t == nt - 2);
            if (last) pre = E.pre(cur, wr, wc, fr, fq);
            const char* a1 = Ab + (size_t)(t + 1) * kstep;
            const char* a2 = last ? Ab : Ab + (size_t)(t + 2) * kstep; const char* b2 = last ? nB : cB + (size_t)(t + 2) * kstep;
            const char* a3 = a2 + kstep; const char* b3 = b2 + kstep;
            unsigned o2[2][2];
#pragma unroll
            for (int h = 0; h < 2; ++h)
#pragma unroll
                for (int i = 0; i < 2; ++i) o2[h][i] = aoc[h][i];
            if (last && has_next) PG8_AOFF(o2, nxt);
            if (last && has_next) S.a_ready(nxt);
            PG8_LDB(B0, 0, 0); PG8_LDB(B1, 0, 1); PG8_SCHED; PG8_LDA(At, 0, 0); PG8_STAGE(PG8_SA(1, 1), a1, aoc[1]);
            PG8_WAIT_V(8); PG8_WAIT_L(0); PG8_BAR; PG8_MMA(0, 0, At, B0); PG8_MMA(0, 1, At, B1); PG8_BAR; PG8_SCHED;
            PG8_LDA(At, 0, 1); PG8_STAGE(PG8_SB(0, 0), b2, voffB); PG8_STAGE(PG8_SB(0, 1), b2 + hstepB, voffB); PG8_STAGE(PG8_SA(0, 0), a2, o2[0]);
            PG8_WAIT_V(8); PG8_WAIT_L(0); PG8_BAR; PG8_MMA(1, 0, At, B0); PG8_MMA(1, 1, At, B1); PG8_BAR; PG8_SCHED;
            PG8_LDB(B0, 1, 0); PG8_LDB(B1, 1, 1); PG8_SCHED; PG8_LDA(At, 1, 0); PG8_STAGE(PG8_SA(0, 1), a2, o2[1]);
            PG8_WAIT_V(8); PG8_WAIT_L(0); PG8_BAR; PG8_MMA(0, 0, At, B0); PG8_MMA(0, 1, At, B1); PG8_BAR; PG8_SCHED;
            PG8_LDA(At, 1, 1); PG8_STAGE(PG8_SB(1, 0), b3, voffB); PG8_STAGE(PG8_SB(1, 1), b3 + hstepB, voffB); PG8_STAGE(PG8_SA(1, 0), a3, o2[0]);
            PG8_WAIT_V(8); PG8_WAIT_L(0); PG8_BAR; PG8_MMA(1, 0, At, B0); PG8_MMA(1, 1, At, B1); PG8_BAR; PG8_SCHED;
        }
        if (Epi::MID_T >= 0) { if (seg == 0) E.mid(acc, cur, wr, wc, fr, fq); }
        }
        if constexpr (FP8) asm volatile("s_nop 15\n\ts_nop 7" ::: "memory");
        if constexpr (ALIGN_EPI) { if (wr == 0) PG8_BAR; }
        cur.pm = __builtin_amdgcn_readfirstlane(cur.pm); cur.pn = __builtin_amdgcn_readfirstlane(cur.pn); cur.e = __builtin_amdgcn_readfirstlane(cur.e); cur.ui = __builtin_amdgcn_readfirstlane(cur.ui);
        asm volatile("" : "+s"(cur.pm), "+s"(cur.pn), "+s"(cur.e), "+s"(cur.ui));
        { int t_ = tid; asm volatile("" : "+v"(t_)); const int fr_ = t_ & 15, fq_ = (t_ & 63) >> 4;
          E(acc, cur, wr, wc, fr_, fq_, pre); } S.done(cur);
        if (!has_next) break;
#pragma unroll
        for (int a = 0; a < 2; ++a)
#pragma unroll
            for (int b = 0; b < 2; ++b)
#pragma unroll
                for (int m = 0; m < 4; ++m)
#pragma unroll
                    for (int n = 0; n < 2; ++n) acc[a][b][m][n] = (f32x4){0.f, 0.f, 0.f, 0.f};
        cur = nxt; cB = nB; ++ui;
        PG8_AOFF(aoc, cur);
        if constexpr (ALIGN_EPI) { if (wr == 1) PG8_BAR; }
    }
    PG8_WAIT_V(0);
    if constexpr (!ALIGN_EPI) { if (wr == 0) PG8_BAR; }
    PG8_BAR;
#undef PG8_AOFF
#undef PG8_SA
#undef PG8_SB
#undef PG8_STAGE
#undef PG8_LDA
#undef PG8_LDB
#undef PG8_MMA
#undef PG8_LO
#undef PG8_HI
#undef PG8_WAIT_V
#undef PG8_WAIT_L
#undef PG8_BAR
#undef PG8_SCHED
}
}

namespace mk {
constexpr int T = 16384, D = 1024, SEQ = 2048, NB = 8, INW = 5632, NE = 32, DFF = 1024, NMOD = 6144;
constexpr int NW = 8, NTHR = 512;
constexpr float EPS = 1e-6f;
constexpr float W8_SCALE = 64.f, A8_SCALE = 8.f, MOE_DESCALE = 1.f / 512.f;
constexpr float C2 = 0.18033688011112042f;
constexpr int LDS_BYTES = 155648;
constexpr int RING_OFF = 0, TAB_OFF = 131072, MISC_OFF = 155648 - 256;

struct Params {
    const GAS float *x, *c; const GAS int* pos;
    const GAS float *w_mod, *b_mod, *g_pre_mix, *w_in, *lq1, *lk1, *lq2, *lk2, *g_sub, *w_pg, *pool_scale, *w_att, *w_pb, *w_out, *g_post_mix, *g_pre_ffn, *w_router, *b_router, *w_gu, *b_gu, *w_dn, *b_dn, *g_post_ffn;
    GAS float* out;
    GAS unsigned* ctl; GAS float* modp; GAS float* rope;
    GAS bf16 *Wt_in, *Wt_mix, *Wt_out, *Wt_pg, *Wt_gu, *Wt_dn;
    GAS bf16 *U, *QKV, *PB, *GR, *SGP, *AM, *MERGED, *MIXOUT, *ACT, *Y;
    GAS float* prob; GAS int* lists;
    int ph_lo, ph_hi, li, flags;
};
#define P_x ((const float*)p.x)
#define P_c ((const float*)p.c)
#define P_w_mod ((const float*)p.w_mod)
#define P_b_mod ((const float*)p.b_mod)
#define P_g_pre_mix ((const float*)p.g_pre_mix)
#define P_w_in ((const float*)p.w_in)
#define P_lq1 ((const float*)p.lq1)
#define P_lk1 ((const float*)p.lk1)
#define P_lq2 ((const float*)p.lq2)
#define P_lk2 ((const float*)p.lk2)
#define P_g_sub ((const float*)p.g_sub)
#define P_w_pg ((const float*)p.w_pg)
#define P_pool_scale ((const float*)p.pool_scale)
#define P_w_att ((const float*)p.w_att)
#define P_w_pb ((const float*)p.w_pb)
#define P_w_out ((const float*)p.w_out)
#define P_g_post_mix ((const float*)p.g_post_mix)
#define P_g_pre_ffn ((const float*)p.g_pre_ffn)
#define P_w_router ((const float*)p.w_router)
#define P_b_router ((const float*)p.b_router)
#define P_w_gu ((const float*)p.w_gu)
#define P_b_gu ((const float*)p.b_gu)
#define P_w_dn ((const float*)p.w_dn)
#define P_b_dn ((const float*)p.b_dn)
#define P_g_post_ffn ((const float*)p.g_post_ffn)
#define P_pos ((const int*)p.pos)
#define P_out ((float*)p.out)
#define P_ctl ((unsigned*)p.ctl)
#define P_modp ((float*)p.modp)
#define P_rope ((float*)p.rope)
#define P_prob ((float*)p.prob)
#define P_lists ((int*)p.lists)
#define P_Wt_in ((bf16*)p.Wt_in)
#define P_Wt_mix ((bf16*)p.Wt_mix)
#define P_Wt_out ((bf16*)p.Wt_out)
#define P_Wt_pg ((bf16*)p.Wt_pg)
#define P_Wt_gu ((bf16*)p.Wt_gu)
#define P_Wt_dn ((bf16*)p.Wt_dn)
#define P_U ((bf16*)p.U)
#define P_QKV ((bf16*)p.QKV)
#define P_PB ((bf16*)p.PB)
#define P_GR ((bf16*)p.GR)
#define P_SGP ((bf16*)p.SGP)
#define P_AM ((bf16*)p.AM)
#define P_MERGED ((bf16*)p.MERGED)
#define P_MIXOUT ((bf16*)p.MIXOUT)
#define P_ACT ((bf16*)p.ACT)
#define P_Y ((bf16*)p.Y)
constexpr int CW_TMO = 0, CW_CNT = 64  , CW_BAR = 4096  ;

__device__ __forceinline__ float wave_sum(float v) {
#pragma unroll
    for (int o = 1; o < 64; o <<= 1) v += __shfl_xor(v, o);
    return v;
}
__device__ __forceinline__ void tr_item(const float* W, int ldw, int k0, int n0, bf16* WT, int ldt, int drow0, int kcol0, LAS float* scr, int lane) {
    float v_[32];
#pragma unroll
    for (int i = 0; i < 32; ++i) v_[i] = __builtin_nontemporal_load(&W[(size_t)(k0 + 2 * i + (lane >> 5)) * ldw + n0 + (lane & 31)]);
    asm volatile("" : "+v"(v_[0]), "+v"(v_[31]));
#pragma unroll
    for (int i = 0; i < 32; ++i) scr[(2 * i + (lane >> 5)) * 33 + (lane & 31)] = v_[i];
    LDS_WAIT(); asm volatile("" ::: "memory");
    const int c = lane & 7;
#pragma unroll
    for (int j = 0; j < 4; ++j) { const int n = (lane >> 3) + 8 * j; const LAS float* s = scr + (8 * c) * 33 + n;
        v4u o; o.x = pk2(s[0 * 33], s[1 * 33]); o.y = pk2(s[2 * 33], s[3 * 33]); o.z = pk2(s[4 * 33], s[5 * 33]); o.w = pk2(s[6 * 33], s[7 * 33]);
        *(GAS v4u*)(WT + (size_t)(drow0 + n) * ldt + kcol0 + k0 + 8 * c) = o; }
    LDS_WAIT(); asm volatile("" ::: "memory");
}
__device__ __forceinline__ unsigned pk4_fp8(float a, float b, float c, float d) {
    a = fminf(fmaxf(a, -448.f), 448.f); b = fminf(fmaxf(b, -448.f), 448.f); c = fminf(fmaxf(c, -448.f), 448.f); d = fminf(fmaxf(d, -448.f), 448.f);
    int w = __builtin_amdgcn_cvt_pk_fp8_f32(a, b, 0, false); w = __builtin_amdgcn_cvt_pk_fp8_f32(c, d, w, true); return (unsigned)w; }
__device__ __forceinline__ void tr_item8(const float* W, int ldw, int k0, int n0, unsigned char* WT, int ldt, int drow0, LAS float* scr, int lane, float scale) {
    float v_[64];
#pragma unroll
    for (int i = 0; i < 64; ++i) v_[i] = __builtin_nontemporal_load(&W[(size_t)(k0 + 2 * i + (lane >> 5)) * ldw + n0 + (lane & 31)]);
    asm volatile("" : "+v"(v_[0]), "+v"(v_[63]));
#pragma unroll
    for (int i = 0; i < 64; ++i) scr[(2 * i + (lane >> 5)) * 33 + (lane & 31)] = v_[i];
    LDS_WAIT(); asm volatile("" ::: "memory");
    const int c = lane & 7;
#pragma unroll
    for (int j = 0; j < 4; ++j) { const int n = (lane >> 3) + 8 * j; const LAS float* s = scr + (16 * c) * 33 + n;
        v4u o; o.x = pk4_fp8(s[0 * 33] * scale, s[1 * 33] * scale, s[2 * 33] * scale, s[3 * 33] * scale); o.y = pk4_fp8(s[4 * 33] * scale, s[5 * 33] * scale, s[6 * 33] * scale, s[7 * 33] * scale);
        o.z = pk4_fp8(s[8 * 33] * scale, s[9 * 33] * scale, s[10 * 33] * scale, s[11 * 33] * scale); o.w = pk4_fp8(s[12 * 33] * scale, s[13 * 33] * scale, s[14 * 33] * scale, s[15 * 33] * scale);
        *(GAS v4u*)(WT + (size_t)(drow0 + n) * ldt + k0 + 16 * c) = o; }
    LDS_WAIT(); asm volatile("" ::: "memory");
}
__device__ __forceinline__ int ilv_row(int n, int H) { const int w = n >= H ? 1 : 0, c = n - w * H; return 256 * (c >> 7) + 128 * w + (c & 127); }

__device__ __forceinline__ void p0_prologue(const Params& p, LAS unsigned char* lds, int tid, int wave, int lane, int vcu, int G) {
    LAS float* sc = (LAS float*)lds;
    for (int i = tid; i < NB * D; i += NTHR) { const float cv = P_c[i]; sc[i] = cv / (1.f + expf(-cv)); }
    __syncthreads();
    const int gw = vcu * NW + wave, NGW = G * NW;
    for (int task = (wave < 3 ? vcu * 3 + wave : 96 * 8); task < 96 * 8; task += G * 3) {
        const int cg = task >> 3, ks = task & 7, col = cg * 64 + lane;
        float acc[NB];
#pragma unroll
        for (int b = 0; b < NB; ++b) acc[b] = 0.f;
#pragma unroll 1
        for (int k0 = ks * 128; k0 < ks * 128 + 128; k0 += 32) {
            float wv[32];
#pragma unroll
            for (int i = 0; i < 32; ++i) wv[i] = __builtin_nontemporal_load(&P_w_mod[(size_t)(k0 + i) * NMOD + col]);
#pragma unroll
            for (int i = 0; i < 32; ++i) {
#pragma unroll
                for (int b = 0; b < NB; ++b) acc[b] += sc[b * D + k0 + i] * wv[i]; } }
#pragma unroll
        for (int b = 0; b < NB; ++b) P_modp[(size_t)(ks * NB + b) * NMOD + col] = acc[b];
    }
    __syncthreads();
    LAS float* scr = (LAS float*)(lds + wave * 17408);
    constexpr int I1 = 16 * 176, I2 = 16 * 32, I3 = 8 * 32, I4 = 16 * 32, I5 = 32, I6E = 8 * 64, I7E = 8 * 32;
    const int nitems = (p.flags & 1) ? (I1 + I2 + I3 + I4 + I5) : (I1 + I2 + I3 + I4 + I5 + NE * I6E + NE * I7E);
    for (int it = gw; it < nitems; it += NGW) {
        int r = it;
        if (r < I1) { const int kb = r / 176, nb = r % 176, n0 = nb * 32; const int dr = n0 < 3584 ? n0 : 3584 + ilv_row(n0 - 3584, 1024);
            tr_item(P_w_in, INW, kb * 64, n0, P_Wt_in, D, dr, 0, scr, lane); continue; } r -= I1;
        if (r < I2) { const int kb = r / 32, nb = r % 32; tr_item(P_w_att, D, kb * 64, nb * 32, P_Wt_mix, 1536, nb * 32, 0, scr, lane); continue; } r -= I2;
        if (r < I3) { const int kb = r / 32, nb = r % 32; tr_item(P_w_pb, D, kb * 64, nb * 32, P_Wt_mix, 1536, nb * 32, 1024, scr, lane); continue; } r -= I3;
        if (r < I4) { const int kb = r / 32, nb = r % 32; tr_item(P_w_out, D, kb * 64, nb * 32, P_Wt_out, D, nb * 32, 0, scr, lane); continue; } r -= I4;
        if (r < I5) { const int g = r >> 3, q = r & 7, kb = q >> 2, nb = q & 3; tr_item(P_w_pg + (size_t)g * 128 * 128, 128, kb * 64, nb * 32, P_Wt_pg + (size_t)g * 128 * 128, 128, nb * 32, 0, scr, lane); continue; } r -= I5;
        if (r < NE * I6E) { const int e = r / I6E, q = r % I6E, kb = q / 64, nb = q % 64, n0 = nb * 32;
            tr_item8(P_w_gu + (size_t)e * D * 2 * DFF, 2 * DFF, kb * 128, n0, (unsigned char*)P_Wt_gu + (size_t)e * 2 * DFF * D, D, ilv_row(n0, DFF), scr, lane, W8_SCALE); continue; } r -= NE * I6E;
        { const int e = r / I7E, q = r % I7E, kb = q / 32, nb = q % 32; tr_item8(P_w_dn + (size_t)e * DFF * D, D, kb * 128, nb * 32, (unsigned char*)P_Wt_dn + (size_t)e * D * DFF, DFF, nb * 32, scr, lane, W8_SCALE); }
    }
}
__device__ __forceinline__ double rope_invf(int i) {
    return i == 0 ? 1.0 : i == 1 ? 0.19392274474868576 : i == 2 ? 0.03760603093086393 : i == 3 ? 0.007292664737217109 : i == 4 ? 0.001414213562373095 : i == 5 ? 0.0002742481756762073 : i == 6 ? 5.318295896944988e-05 : 1.031338537721246e-05;
}
__device__ __forceinline__ f32x4 mod4(const Params& p, int b, int off, int k) {
    const float* base = P_modp + (size_t)b * NMOD + off + k;
    f32x4 t[9]; t[8] = *(const f32x4*)(P_b_mod + off + k);
#pragma unroll
    for (int ks = 0; ks < 8; ++ks) t[ks] = *(const f32x4*)(base + (size_t)ks * NB * NMOD);
    asm volatile("" : "+v"(t[0]), "+v"(t[1]), "+v"(t[2]), "+v"(t[3]), "+v"(t[4]), "+v"(t[5]), "+v"(t[6]), "+v"(t[7]), "+v"(t[8]));
    return t[8] + (((t[0] + t[1]) + (t[2] + t[3])) + ((t[4] + t[5]) + (t[6] + t[7])));
}
constexpr int MODF_OFF = 8 * NB * NMOD;
__device__ __forceinline__ void p1_rows(const Params& p, LAS unsigned char* lds, int tid, int wave, int lane, int vcu, int G) {
    LAS float* av = (LAS float*)lds; LAS float* sv = av + D;
    for (int grp = vcu; grp < T / 64; grp += G) {
        const int row0 = grp * 64 + wave * 8, b = row0 / SEQ;
        __syncthreads();
        { const int k = 4 * (tid & 255);
          if (tid < 256) *(LAS f32x4*)(av + k) = *(const f32x4*)(P_g_pre_mix + k) * (1.f + mod4(p, b, 1024, k)); else *(LAS f32x4*)(sv + k) = mod4(p, b, 0, k);
          if ((grp & 31) == 0) {
#pragma unroll
              for (int q = 0; q < 2; ++q) { const int vi = (tid >> 8) * 2 + q; const int off = vi == 0 ? 2048 : vi == 1 ? 3072 : vi == 2 ? 4096 : 5120;
                  *(f32x4*)(P_modp + MODF_OFF + (size_t)(b * 4 + vi) * D + k) = mod4(p, b, off, k); } } }
        __syncthreads();
        f32x4 a[4], sh[4];
#pragma unroll
        for (int j = 0; j < 4; ++j) { const int k = 4 * lane + 256 * j; a[j] = *(const LAS f32x4*)(av + k); sh[j] = *(const LAS f32x4*)(sv + k); }
#pragma unroll 1
        for (int rb = 0; rb < 8; rb += 4) {
            f32x4 v[4][4]; float ss[4];
#pragma unroll
            for (int r = 0; r < 4; ++r) { const GAS f32x4* xr = (const GAS f32x4*)(P_x + (size_t)(row0 + rb + r) * D) + lane;
#pragma unroll
                for (int j = 0; j < 4; ++j) v[r][j] = __builtin_nontemporal_load(xr + 64 * j); }
#pragma unroll
            for (int r = 0; r < 4; ++r) { float s = 0.f;
#pragma unroll
                for (int j = 0; j < 4; ++j) s += (v[r][j].x * v[r][j].x + v[r][j].y * v[r][j].y) + (v[r][j].z * v[r][j].z + v[r][j].w * v[r][j].w);
                ss[r] = s; }
#pragma unroll
            for (int o = 1; o < 64; o <<= 1) {
#pragma unroll
                for (int r = 0; r < 4; ++r) ss[r] += __shfl_xor(ss[r], o); }
#pragma unroll
            for (int r = 0; r < 4; ++r) { const int m = row0 + rb + r; const float rstd = 1.f / sqrtf(ss[r] * (1.f / D) + EPS);
                GAS unsigned long long* o8 = (GAS unsigned long long*)(P_U + (size_t)m * D) + lane;
#pragma unroll
                for (int j = 0; j < 4; ++j) { const f32x4 u = v[r][j] * rstd * a[j] + sh[j]; o8[64 * j] = (unsigned long long)pk2(u.x, u.y) | ((unsigned long long)pk2(u.z, u.w) << 32); } }
        }
        if (lane < 8) {
            const double invf = rope_invf(lane);
#pragma unroll 1
            for (int r = 0; r < 8; ++r) { const int m = row0 + r; const double ang = (double)P_pos[m] * invf; const double kk = __builtin_rint(ang * 0.15915494309189535);
                const float rr = (float)(ang - kk * 6.283185307179586); P_rope[(size_t)m * 16 + lane] = cosf(rr); P_rope[(size_t)m * 16 + 8 + lane] = sinf(rr); }
        }
    }
}
struct EpiZ {
    static constexpr bool PERM = true; static constexpr int MID_T = -1;
    bf16 *QKV, *PB, *GR, *SGP; const float* rope;
    struct Pre {}; __device__ __forceinline__ Pre pre(const pg8::Unit&, int, int, int, int) const { return Pre{}; }
    __device__ __forceinline__ void mid(pg8::f32x4 (&)[2][2][4][2], const pg8::Unit&, int, int, int, int) const {}
    __device__ __forceinline__ void operator()(const pg8::f32x4 (&acc)[2][2][4][2], const pg8::Unit& u, int wr, int wc, int fr, int fq, const Pre&) const {
        const int row0 = u.pm * 256 + wr * 64 + fr, pn = u.pn, cw = wc * 32 + 8 * fq;
        if (pn < 14) {
            const bool rp = pn < 8 && (wc & 1) == 0; const float sc = pn < 4 ? C2 : 1.f;
            bf16* base = pn < 12 ? QKV : PB; const int ld = pn < 12 ? 3072 : 512; const int colt = (pn < 12 ? pn : pn - 12) * 256 + cw;
#pragma unroll
            for (int ai = 0; ai < 2; ++ai)
#pragma unroll
                for (int m = 0; m < 4; ++m) {
                    const int row = row0 + ai * 128 + m * 16;
                    f32x4 c0 = {1.f, 1.f, 1.f, 1.f}, c1 = c0, s0 = {0.f, 0.f, 0.f, 0.f}, s1 = s0;
                    if (rp) { const f32x4* rt = (const f32x4*)(rope + (size_t)row * 16); c0 = rt[0]; c1 = rt[1]; s0 = rt[2]; s1 = rt[3]; }
#pragma unroll
                    for (int bj = 0; bj < 2; ++bj) {
                        f32x4 v0 = acc[ai][bj][m][0], v1 = acc[ai][bj][m][1];
                        if (rp) {
                            f32x4 p0, p1;
#pragma unroll
                            for (int j = 0; j < 4; ++j) { p0[j] = __shfl_xor(v0[j], 16); p1[j] = __shfl_xor(v1[j], 16); }
                            if (fq == 0) { v0 = v0 * c0 - p0 * s0; v1 = v1 * c1 - p1 * s1; }
                            else if (fq == 1) { v0 = v0 * c0 + p0 * s0; v1 = v1 * c1 + p1 * s1; }
                        }
                        v0 = v0 * sc; v1 = v1 * sc;
                        pg8::u32x4 w; w.x = pg8::cvt_pk_bf16(v0[0], v0[1]); w.y = pg8::cvt_pk_bf16(v0[2], v0[3]); w.z = pg8::cvt_pk_bf16(v1[0], v1[1]); w.w = pg8::cvt_pk_bf16(v1[2], v1[3]);
                        *(pg8::u32x4*)(base + (size_t)row * ld + colt + bj * 128) = w;
                    }
                }
        } else {
            const int colt = (pn - 14) * 128 + cw;
#pragma unroll
            for (int ai = 0; ai < 2; ++ai)
#pragma unroll
                for (int m = 0; m < 4; ++m) {
                    const int row = row0 + ai * 128 + m * 16;
                    float r[8], g[8];
#pragma unroll
                    for (int n = 0; n < 2; ++n)
#pragma unroll
                        for (int j = 0; j < 4; ++j) { const float a = fminf(fmaxf(acc[ai][0][m][n][j], -30.f), 30.f), b = fminf(fmaxf(acc[ai][1][m][n][j], -30.f), 30.f);
                            const float ea = __builtin_amdgcn_exp2f(-1.4426950408889634f * a), eb = __builtin_amdgcn_exp2f(-1.4426950408889634f * b); r[n * 4 + j] = (1.f + eb) * __builtin_amdgcn_rcpf(1.f + ea); g[n * 4 + j] = __builtin_amdgcn_rcpf(1.f + eb); }
                    pg8::u32x4 w; w.x = pg8::cvt_pk_bf16(r[0], r[1]); w.y = pg8::cvt_pk_bf16(r[2], r[3]); w.z = pg8::cvt_pk_bf16(r[4], r[5]); w.w = pg8::cvt_pk_bf16(r[6], r[7]);
                    *(pg8::u32x4*)(GR + (size_t)row * D + colt) = w;
                    w.x = pg8::cvt_pk_bf16(g[0], g[1]); w.y = pg8::cvt_pk_bf16(g[2], g[3]); w.z = pg8::cvt_pk_bf16(g[4], g[5]); w.w = pg8::cvt_pk_bf16(g[6], g[7]);
                    *(pg8::u32x4*)(SGP + (size_t)row * D + colt) = w;
                }
        }
    }
};
}

namespace mk {
__device__ __forceinline__ float bf2f(unsigned short v) { return __uint_as_float((unsigned)v << 16); }
__device__ __forceinline__ float lam_value(const Params& p, int lane) {
    const float a = P_lq1[lane] * P_lk1[lane], b = P_lq2[lane] * P_lk2[lane];
    return expf(wave_sum(a)) - expf(wave_sum(b)) + 0.2f;
}
__device__ __forceinline__ void attn_interim(const Params& p, LAS unsigned char* lds, int tid, int vcu, int G) {
    const float lam = lam_value(p, tid & 63);
    const int sub = tid >> 8, t = tid & 255, r = t >> 2, j = t & 3;
    LAS float* Ks1 = (LAS float*)(lds + sub * 65536); LAS float* Ks2 = Ks1 + 4096; LAS float* Vs = Ks2 + 4096;
    for (int it = 0;; ++it) {
        const int pi = vcu + G * it; if (pi >= 1024) break;
        const int cc = pi & 31, c = (it & 1) ? 31 - cc : cc;
        const int bh = 2 * (pi >> 5) + sub, b = bh >> 3, h = bh & 7;
        const size_t m = (size_t)b * SEQ + c * 64 + r;
        float q1[16], q2[16];
#pragma unroll
        for (int i = 0; i < 16; ++i) { q1[i] = bf2f(P_QKV[m * 3072 + (2 * h) * 64 + j * 16 + i]); q2[i] = bf2f(P_QKV[m * 3072 + (2 * h + 1) * 64 + j * 16 + i]); }
        float m1 = -INFINITY, l1 = 0.f, m2 = -INFINITY, l2 = 0.f, a1[32], a2[32];
#pragma unroll
        for (int d = 0; d < 32; ++d) { a1[d] = 0.f; a2[d] = 0.f; }
        for (int kt = 0; kt <= c; ++kt) {
            __syncthreads();
            for (int e = t; e < 64 * 64; e += 256) { const int kr = e >> 6, kc = e & 63; const size_t km = (size_t)b * SEQ + kt * 64 + kr;
                Ks1[e] = bf2f(P_QKV[km * 3072 + 1024 + (2 * h) * 64 + kc]); Ks2[e] = bf2f(P_QKV[km * 3072 + 1024 + (2 * h + 1) * 64 + kc]); }
            for (int e = t; e < 64 * 128; e += 256) { const int kr = e >> 7, kc = e & 127; const size_t km = (size_t)b * SEQ + kt * 64 + kr; Vs[e] = bf2f(P_QKV[km * 3072 + 2048 + h * 128 + kc]); }
            __syncthreads();
            for (int kk = 0; kk < 64; ++kk) {
                float s1 = 0.f, s2 = 0.f;
#pragma unroll
                for (int i = 0; i < 16; ++i) { s1 += q1[i] * Ks1[kk * 64 + j * 16 + i]; s2 += q2[i] * Ks2[kk * 64 + j * 16 + i]; }
                s1 += __shfl_xor(s1, 1); s1 += __shfl_xor(s1, 2); s2 += __shfl_xor(s2, 1); s2 += __shfl_xor(s2, 2);
                { const float mn = fmaxf(m1, s1), al = exp2f(m1 - mn), pp = exp2f(s1 - mn); l1 = l1 * al + pp; m1 = mn;
#pragma unroll
                  for (int d = 0; d < 32; ++d) a1[d] = a1[d] * al + pp * Vs[kk * 128 + j * 32 + d]; }
                { const float mn = fmaxf(m2, s2), al = exp2f(m2 - mn), pp = exp2f(s2 - mn); l2 = l2 * al + pp; m2 = mn;
#pragma unroll
                  for (int d = 0; d < 32; ++d) a2[d] = a2[d] * al + pp * Vs[kk * 128 + j * 32 + d]; }
            }
        }
        float ss = 0.f; const float i1 = 1.f / l1, i2 = lam / l2;
#pragma unroll
        for (int d = 0; d < 32; ++d) { a1[d] = a1[d] * i1 - a2[d] * i2; ss += a1[d] * a1[d]; }
        ss += __shfl_xor(ss, 1); ss += __shfl_xor(ss, 2);
        const float rstd = (1.f / sqrtf(ss * (1.f / 128.f) + EPS)) * 0.8f;
#pragma unroll
        for (int d = 0; d < 32; d += 2) { const float o0 = a1[d] * rstd * P_g_sub[j * 32 + d], o1 = a1[d + 1] * rstd * P_g_sub[j * 32 + d + 1];
            *(unsigned*)(P_AM + m * 1536 + h * 128 + j * 32 + d) = pk2(o0, o1); }
    }
    __syncthreads();
}
__device__ __forceinline__ void pool_phase(const Params& p, LAS unsigned char* lds, int tid, int wave, int lane, int vcu, int G) {
    LAS float* Pf = (LAS float*)lds;
    LAS unsigned short* Mx = (LAS unsigned short*)(lds + 144 * 128 * 4);
    const int fr = lane & 15, fq = lane >> 4;
    for (int unit = vcu; unit < 512; unit += G) {
        const int rt = unit >> 2, g = unit & 3, w = 2 << g, row0 = rt * 128, s0 = row0 & (SEQ - 1);
        for (int ch = tid; ch < 144 * 16; ch += NTHR) { const int r = ch >> 4, c8 = (ch & 15) * 8, tt = s0 - 16 + r;
            v4u raw = {0u, 0u, 0u, 0u};
            if (tt >= 0) raw = *(const GAS v4u*)(P_PB + (size_t)(row0 - 16 + r) * 512 + g * 128 + c8);
            LAS float* d = Pf + r * 128 + c8;
            d[0] = __uint_as_float(raw.x << 16); d[1] = __uint_as_float(raw.x & 0xffff0000u); d[2] = __uint_as_float(raw.y << 16); d[3] = __uint_as_float(raw.y & 0xffff0000u);
            d[4] = __uint_as_float(raw.z << 16); d[5] = __uint_as_float(raw.z & 0xffff0000u); d[6] = __uint_as_float(raw.w << 16); d[7] = __uint_as_float(raw.w & 0xffff0000u); }
        __syncthreads();
        { const int c = tid & 127, rb = (tid >> 7) * 32;
          float ssum = 0.f;
          for (int q = 0; q < w; ++q) ssum += Pf[(rb + 16 - q) * 128 + c];
          for (int i = 0; i < 32; ++i) { const int r = rb + i, s = s0 + r; const int cnt = (s + 1) < w ? (s + 1) : w;
              const float pv = Pf[(r + 16) * 128 + c]; const float mx = ssum * __builtin_amdgcn_rcpf((float)cnt) - pv;
              Mx[r * 136 + c] = (unsigned short)f2bf(mx);
              if (i < 31) ssum += Pf[(r + 17) * 128 + c] - Pf[(r + 17 - w) * 128 + c]; } }
        __syncthreads();
        f32x4 acc[8];
#pragma unroll
        for (int nt = 0; nt < 8; ++nt) acc[nt] = (f32x4){0.f, 0.f, 0.f, 0.f};
        const bf16* Wg = P_Wt_pg + (size_t)g * 128 * 128;
#pragma unroll
        for (int ks = 0; ks < 4; ++ks) {
            const bf16x8 a = *(const LAS bf16x8*)(Mx + (16 * wave + fr) * 136 + 32 * ks + 8 * fq);
#pragma unroll
            for (int nt = 0; nt < 8; ++nt) { const bf16x8 bw = *(const GAS bf16x8*)(Wg + (size_t)(16 * nt + fr) * 128 + 32 * ks + 8 * fq);
                acc[nt] = __builtin_amdgcn_mfma_f32_16x16x32_bf16(bw, a, acc[nt], 0, 0, 0); }
        }
        bf16* orow = P_AM + (size_t)(row0 + 16 * wave + fr) * 1536 + 1024 + g * 128;
#pragma unroll
        for (int nt = 0; nt < 8; ++nt) { const int d = 16 * nt + 4 * fq; const f32x4 sc = *(const f32x4*)(P_pool_scale + g * 128 + d); const f32x4 v = acc[nt] * sc;
            *(GAS unsigned long long*)(orow + d) = (unsigned long long)pk2(v[0], v[1]) | ((unsigned long long)pk2(v[2], v[3]) << 32); }
        __syncthreads();
    }
}
struct EpiMerge {
    static constexpr bool PERM = true; static constexpr int MID_T = 16;
    const bf16 *GR, *SGP; bf16* O;
    struct Pre {}; __device__ __forceinline__ Pre pre(const pg8::Unit&, int, int, int, int) const { return Pre{}; }
    __device__ __forceinline__ void scale(pg8::f32x4 (&acc)[2][2][4][2], const bf16* Sm, const pg8::Unit& u, int wr, int wc, int fr, int fq) const {
        const __amdgpu_buffer_rsrc_t rs = __builtin_amdgcn_make_buffer_rsrc((void*)Sm, 0, T * D * 2, 0x00020000);
        const int voff = ((u.pm * 256 + wr * 64 + fr) * D + u.pn * 256 + wc * 32 + 8 * fq) * 2;
#pragma unroll
        for (int ai = 0; ai < 2; ++ai)
#pragma unroll
            for (int m = 0; m < 4; ++m) {
#pragma unroll
                for (int bj = 0; bj < 2; ++bj) { const pg8::u32x4 w = __builtin_amdgcn_raw_buffer_load_b128(rs, voff, ((ai * 128 + m * 16) * D + bj * 128) * 2, 0);
                    acc[ai][bj][m][0][0] *= __uint_as_float(w.x << 16); acc[ai][bj][m][0][1] *= __uint_as_float(w.x & 0xffff0000u); acc[ai][bj][m][0][2] *= __uint_as_float(w.y << 16); acc[ai][bj][m][0][3] *= __uint_as_float(w.y & 0xffff0000u);
                    acc[ai][bj][m][1][0] *= __uint_as_float(w.z << 16); acc[ai][bj][m][1][1] *= __uint_as_float(w.z & 0xffff0000u); acc[ai][bj][m][1][2] *= __uint_as_float(w.w << 16); acc[ai][bj][m][1][3] *= __uint_as_float(w.w & 0xffff0000u); }
                asm volatile("" : "+v"(acc[ai][0][m][0]), "+v"(acc[ai][0][m][1]), "+v"(acc[ai][1][m][0]), "+v"(acc[ai][1][m][1])); asm volatile("" ::: "memory");
            }
    }
    __device__ __forceinline__ void mid(pg8::f32x4 (&acc)[2][2][4][2], const pg8::Unit& u, int wr, int wc, int fr, int fq) const { scale(acc, GR, u, wr, wc, fr, fq); }
    __device__ __forceinline__ void operator()(pg8::f32x4 (&acc)[2][2][4][2], const pg8::Unit& u, int wr, int wc, int fr, int fq, const Pre&) const {
        scale(acc, SGP, u, wr, wc, fr, fq);
        const int row0 = u.pm * 256 + wr * 64 + fr, col0 = u.pn * 256 + wc * 32 + 8 * fq;
#pragma unroll
        for (int ai = 0; ai < 2; ++ai)
#pragma unroll
            for (int m = 0; m < 4; ++m)
#pragma unroll
                for (int bj = 0; bj < 2; ++bj) { const pg8::f32x4 v0 = acc[ai][bj][m][0], v1 = acc[ai][bj][m][1];
                    pg8::u32x4 w; w.x = pg8::cvt_pk_bf16(v0[0], v0[1]); w.y = pg8::cvt_pk_bf16(v0[2], v0[3]); w.z = pg8::cvt_pk_bf16(v1[0], v1[1]); w.w = pg8::cvt_pk_bf16(v1[2], v1[3]);
                    *(pg8::u32x4*)(O + (size_t)(row0 + ai * 128 + m * 16) * D + col0 + bj * 128) = w; }
    }
};
struct EpiNull {
    static constexpr bool PERM = true; static constexpr int MID_T = -1;
    struct Pre {}; __device__ __forceinline__ Pre pre(const pg8::Unit&, int, int, int, int) const { return Pre{}; }
    __device__ __forceinline__ void mid(pg8::f32x4 (&)[2][2][4][2], const pg8::Unit&, int, int, int, int) const {}
    __device__ __forceinline__ void operator()(pg8::f32x4 (&acc)[2][2][4][2], const pg8::Unit&, int, int, int, int, const Pre&) const {
#pragma unroll
        for (int ai = 0; ai < 2; ++ai)
#pragma unroll
            for (int bj = 0; bj < 2; ++bj)
#pragma unroll
                for (int m = 0; m < 4; ++m) asm volatile("" :: "v"(acc[ai][bj][m][0]), "v"(acc[ai][bj][m][1]));
    }
};
struct EpiStore {
    static constexpr bool PERM = true; static constexpr int MID_T = -1;
    bf16* O; int ldc;
    struct Pre {}; __device__ __forceinline__ Pre pre(const pg8::Unit&, int, int, int, int) const { return Pre{}; }
    __device__ __forceinline__ void mid(pg8::f32x4 (&)[2][2][4][2], const pg8::Unit&, int, int, int, int) const {}
    __device__ __forceinline__ void operator()(pg8::f32x4 (&acc)[2][2][4][2], const pg8::Unit& u, int wr, int wc, int fr, int fq, const Pre&) const {
        const int row0 = u.pm * 256 + wr * 64 + fr, col0 = u.pn * 256 + wc * 32 + 8 * fq;
#pragma unroll
        for (int ai = 0; ai < 2; ++ai)
#pragma unroll
            for (int m = 0; m < 4; ++m)
#pragma unroll
                for (int bj = 0; bj < 2; ++bj) { const pg8::f32x4 v0 = acc[ai][bj][m][0], v1 = acc[ai][bj][m][1];
                    pg8::u32x4 w; w.x = pg8::cvt_pk_bf16(v0[0], v0[1]); w.y = pg8::cvt_pk_bf16(v0[2], v0[3]); w.z = pg8::cvt_pk_bf16(v1[0], v1[1]); w.w = pg8::cvt_pk_bf16(v1[2], v1[3]);
                    *(pg8::u32x4*)(O + (size_t)(row0 + ai * 128 + m * 16) * ldc + col0 + bj * 128) = w; }
    }
};
typedef float f32x16 __attribute__((ext_vector_type(16)));
__device__ __forceinline__ void p6_rows(const Params& p, LAS unsigned char* lds, int tid, int wave, int lane, int vcu, int G) {
    LAS float* tile = (LAS float*)lds;
    constexpr int RB = 1;
    float wreg[64];
#pragma unroll
    for (int i = 0; i < 64; ++i) wreg[i] = P_w_router[(size_t)(128 * wave + 2 * i + (lane >> 5)) * NE + (lane & 31)];
    for (int grp = vcu; grp < T / 64; grp += G) {
        const int b = (grp * 64) / SEQ;
        LAS float* vec = (LAS float*)(lds + TAB_OFF + 256);
        LAS int* lcnt = (LAS int*)(lds + TAB_OFF + 256 + 16384); LAS int* gbase = lcnt + 32; LAS int* pel = lcnt + 64;
        __syncthreads();
        if (tid < NE) lcnt[tid] = 0;
        if (tid < 256) { const int k = 4 * tid; const float* mf = P_modp + MODF_OFF + (size_t)b * 4 * D + k;
            const f32x4 a = *(const f32x4*)mf, g1 = *(const f32x4*)(P_g_post_mix + k), c = *(const f32x4*)(P_g_pre_ffn + k) * (1.f + *(const f32x4*)(mf + 2 * D)), d = *(const f32x4*)(mf + D);
            *(LAS f32x4*)(vec + k) = a; *(LAS f32x4*)(vec + 1024 + k) = g1; *(LAS f32x4*)(vec + 2048 + k) = c; *(LAS f32x4*)(vec + 3072 + k) = d; }
        __syncthreads();
#pragma unroll 1
        for (int half = 0; half < 2; ++half) {
#pragma unroll 1
            for (int sb = 0; sb < 4; sb += RB) {
                const int tr0 = wave * 4 + sb, m0 = grp * 64 + half * 32 + tr0;
                unsigned long long mw[RB][4]; f32x4 xv[RB][4]; float ss[RB];
#pragma unroll
                for (int rr = 0; rr < RB; ++rr)
#pragma unroll
                    for (int j = 0; j < 4; ++j) { mw[rr][j] = __builtin_nontemporal_load((const GAS unsigned long long*)(P_MIXOUT + (size_t)(m0 + rr) * D) + lane + 64 * j); xv[rr][j] = __builtin_nontemporal_load((const GAS f32x4*)(P_x + (size_t)(m0 + rr) * D) + lane + 64 * j); }
#define P6_UNPK(w) ((f32x4){__uint_as_float((unsigned)(w) << 16), __uint_as_float((unsigned)(w) & 0xffff0000u), __uint_as_float((unsigned)((w) >> 32) << 16), __uint_as_float((unsigned)((w) >> 32) & 0xffff0000u)})
#pragma unroll
                for (int rr = 0; rr < RB; ++rr) { float s = 0.f;
#pragma unroll
                    for (int j = 0; j < 4; ++j) { const f32x4 v = P6_UNPK(mw[rr][j]); s += (v.x * v.x + v.y * v.y) + (v.z * v.z + v.w * v.w); }
                    ss[rr] = s; }
#pragma unroll
                for (int o = 1; o < 64; o <<= 1) {
#pragma unroll
                    for (int rr = 0; rr < RB; ++rr) ss[rr] += __shfl_xor(ss[rr], o); }
#pragma unroll
                for (int rr = 0; rr < RB; ++rr) { const float rstd = 1.f / sqrtf(ss[rr] * (1.f / D) + EPS); GAS f32x4* orow = (GAS f32x4*)(P_out + (size_t)(m0 + rr) * D) + lane; float s = 0.f;
#pragma unroll
                    for (int j = 0; j < 4; ++j) { const int k = 4 * lane + 256 * j; const f32x4 v = P6_UNPK(mw[rr][j]);
                        const f32x4 x1 = xv[rr][j] + *(const LAS f32x4*)(vec + k) * (v * rstd * *(const LAS f32x4*)(vec + 1024 + k)); xv[rr][j] = x1; orow[64 * j] = x1; s += (x1.x * x1.x + x1.y * x1.y) + (x1.z * x1.z + x1.w * x1.w); }
                    ss[rr] = s; }
#undef P6_UNPK
#pragma unroll
                for (int o = 1; o < 64; o <<= 1) {
#pragma unroll
                    for (int rr = 0; rr < RB; ++rr) ss[rr] += __shfl_xor(ss[rr], o); }
#pragma unroll
                for (int rr = 0; rr < RB; ++rr) { const float rstd = 1.f / sqrtf(ss[rr] * (1.f / D) + EPS);
#pragma unroll
                    for (int j = 0; j < 4; ++j) { const int k = 4 * lane + 256 * j; const f32x4 u = xv[rr][j] * rstd * *(const LAS f32x4*)(vec + 2048 + k) + *(const LAS f32x4*)(vec + 3072 + k);
                        *((GAS unsigned*)((unsigned char*)P_U + (size_t)(m0 + rr) * D) + lane + 64 * j) = pk4_fp8(u.x * A8_SCALE, u.y * A8_SCALE, u.z * A8_SCALE, u.w * A8_SCALE);
                        LAS float* tp = tile + (tr0 + rr) * 1025 + k; tp[0] = u.x; tp[1] = u.y; tp[2] = u.z; tp[3] = u.w; } }
            }
            __syncthreads();
            f32x16 acc;
#pragma unroll
            for (int r = 0; r < 16; ++r) acc[r] = 0.f;
            { const LAS float* ap = tile + (lane & 31) * 1025 + 128 * wave + (lane >> 5);
#pragma unroll
              for (int i = 0; i < 64; ++i) acc = __builtin_amdgcn_mfma_f32_32x32x2f32(ap[2 * i], wreg[i], acc, 0, 0, 0); }
            __syncthreads();
            LAS float* part = (LAS float*)lds;
#pragma unroll
            for (int r = 0; r < 16; ++r) part[(wave * 32 + (r & 3) + 8 * (r >> 2) + 4 * (lane >> 5)) * 32 + (lane & 31)] = acc[r];
            __syncthreads();
#pragma unroll 1
            for (int rr = 0; rr < 4; ++rr) {
                const int tr = wave * 4 + rr, m = grp * 64 + half * 32 + tr;
                float mylg = -INFINITY;
                if (lane < 32) { float s = P_b_router[lane];
#pragma unroll
                    for (int w8 = 0; w8 < 8; ++w8) s += part[(w8 * 32 + tr) * 32 + lane];
                    mylg = s; }
                int sel[4]; float sv[4];
#pragma unroll
                for (int k = 0; k < 4; ++k) { float bv = mylg; int bi = lane;
#pragma unroll
                    for (int off = 1; off < 64; off <<= 1) { const float ov = __shfl_xor(bv, off); const int oi = __shfl_xor(bi, off);
                        if (ov > bv || (ov == bv && oi < bi)) { bv = ov; bi = oi; } }
                    sel[k] = bi; sv[k] = bv; if (lane == bi) mylg = -INFINITY; }
                float den = 0.f, pe[4];
#pragma unroll
                for (int k = 0; k < 4; ++k) { pe[k] = __expf(sv[k] - sv[0]); den += pe[k]; }
                if (lane == 0) {
#pragma unroll
                    for (int k = 0; k < 4; ++k) { P_prob[m * 4 + k] = pe[k] / den; const int loc = __hip_atomic_fetch_add(lcnt + sel[k], 1, __ATOMIC_RELAXED, __HIP_MEMORY_SCOPE_WORKGROUP);
                        pel[(half * 32 + tr) * 4 + k] = (sel[k] << 16) | loc; }
                }
            }
            __syncthreads();
        }
        if (tid < NE) { const int c = lcnt[tid]; gbase[tid] = c ? (int)__hip_atomic_fetch_add(P_ctl + CW_CNT + 64 * tid, (unsigned)c, __ATOMIC_RELAXED, __HIP_MEMORY_SCOPE_AGENT) : 0; }
        __syncthreads();
        if (tid < 256) { const int v = pel[tid], e = v >> 16, loc = v & 0xffff; P_lists[(size_t)e * T + gbase[e] + loc] = grp * 256 + tid; }
        __syncthreads();
    }
}
constexpr int MOE_MAXU = 10;
struct MoeSched {
    const bf16* Bt_all; size_t bstride; int K, ncol, a_shift, lda, G, c, total;
    const LAS int* pre;
    const LAS int* idx;
    const LAS int* utab;
    __device__ __forceinline__ bool locate(int i, pg8::Unit& u) const {
        const int L = (G == 256) ? ((i * 8 + (c & 7)) * 32 + (c >> 3)) : (i * G + c);
        if (L >= total || i >= MOE_MAXU) return false;
        const int RT = L / ncol; u.pn = L - RT * ncol;
        int e = 0;
#pragma unroll 1
        for (int q = 1; q < NE; ++q) e += (pre[q] <= RT) ? 1 : 0;
        u.e = e; u.pm = RT - pre[e]; u.ui = i; return true;
    }
    __device__ __forceinline__ bool next(int i, pg8::Unit& u) const {
        if (i >= MOE_MAXU) return false;
        const pg8::v4i_t t = *(const LAS pg8::v4i_t*)(utab + 4 * i);
        u.e = t[0]; u.pm = t[1]; u.pn = t[2]; u.ui = i; return t[3] != 0;
    }
    __device__ __forceinline__ unsigned a_off(const pg8::Unit& u, int r, int C) const {
        int pair = idx[u.ui * 256 + r]; if (pair < 0) pair = idx[u.ui * 256];
        return (unsigned)(((size_t)(pair >> a_shift) * lda + C) * 2u);
    }
    __device__ __forceinline__ const char* b_base(const pg8::Unit& u) const { return (const char*)(Bt_all + (size_t)u.e * bstride + (size_t)u.pn * 256 * K); }
    __device__ __forceinline__ void a_ready(const pg8::Unit&) const {}
    __device__ __forceinline__ void done(const pg8::Unit&) const {}
};
__device__ __forceinline__ void moe_setup(const Params& p, MoeSched& S, LAS int* pre, LAS int* idx, int tid) {
    LAS int* utab = pre + 48;
    LAS int* cnts = pre + 96;
    if (tid < NE) {
        const int c = (int)__hip_atomic_load(P_ctl + CW_CNT + 64 * tid, __ATOMIC_RELAXED, __HIP_MEMORY_SCOPE_AGENT); cnts[tid] = c;
        int v = (c + 255) >> 8;
#pragma unroll
        for (int o = 1; o < 32; o <<= 1) { const int t = __shfl_up(v, o); if (tid >= o) v += t; }
        pre[tid + 1] = v; if (tid == 0) pre[0] = 0;
    }
    __syncthreads();
    S.pre = pre; S.idx = idx; S.utab = utab; S.total = pre[NE] * S.ncol;
    for (int i = 0; i < MOE_MAXU; ++i) { pg8::Unit u; const bool ok = S.locate(i, u);
        if (tid == 0) { utab[4 * i] = ok ? u.e : 0; utab[4 * i + 1] = ok ? u.pm : 0; utab[4 * i + 2] = ok ? u.pn : 0; utab[4 * i + 3] = ok ? 1 : 0; }
        if (!ok) continue;
        if (tid < 256) { const int cnt = cnts[u.e]; const int r = u.pm * 256 + tid;
            idx[i * 256 + tid] = r < cnt ? P_lists[(size_t)u.e * T + r] : -1; } }
    __syncthreads();
}
struct EpiAct {
    static constexpr bool PERM = true; static constexpr int MID_T = -1;
    bf16* ACT; const float* b_gu; const LAS int* idx;
    struct Pre { f32x4 bg0, bg1, bu0, bu1; };
    __device__ __forceinline__ Pre pre(const pg8::Unit& u, int, int wc, int, int fq) const { const float* bg = b_gu + (size_t)u.e * 2 * DFF + u.pn * 128 + wc * 32 + 8 * fq;
        return Pre{*(const f32x4*)bg, *(const f32x4*)(bg + 4), *(const f32x4*)(bg + DFF), *(const f32x4*)(bg + DFF + 4)}; }
    __device__ __forceinline__ void mid(pg8::f32x4 (&)[2][2][4][2], const pg8::Unit&, int, int, int, int) const {}
    __device__ __forceinline__ void operator()(pg8::f32x4 (&acc)[2][2][4][2], const pg8::Unit& u, int wr, int wc, int fr, int fq, const Pre& q) const {
        const int col = u.pn * 128 + wc * 32 + 8 * fq;
        const f32x4 bg0 = q.bg0, bg1 = q.bg1, bu0 = q.bu0, bu1 = q.bu1;
#pragma unroll
        for (int ai = 0; ai < 2; ++ai)
#pragma unroll
            for (int m = 0; m < 4; ++m) {
                const int pair = idx[u.ui * 256 + ai * 128 + wr * 64 + m * 16 + fr];
                float o[8];
#pragma unroll
                for (int n = 0; n < 2; ++n)
#pragma unroll
                    for (int j = 0; j < 4; ++j) { float g = acc[ai][0][m][n][j] * MOE_DESCALE + (n ? bg1[j] : bg0[j]); float up = acc[ai][1][m][n][j] * MOE_DESCALE + (n ? bu1[j] : bu0[j]);
                        g = fminf(g, 7.f); up = fminf(fmaxf(up, -7.f), 7.f);
                        o[n * 4 + j] = (up * A8_SCALE + A8_SCALE) * (g * __builtin_amdgcn_rcpf(1.f + __builtin_amdgcn_exp2f(-2.4554669595930156f * g))); }
                if (pair >= 0) { pg8::u32x2 w; int w0 = __builtin_amdgcn_cvt_pk_fp8_f32(o[0], o[1], 0, false); w0 = __builtin_amdgcn_cvt_pk_fp8_f32(o[2], o[3], w0, true);
                    int w1 = __builtin_amdgcn_cvt_pk_fp8_f32(o[4], o[5], 0, false); w1 = __builtin_amdgcn_cvt_pk_fp8_f32(o[6], o[7], w1, true); w.x = (unsigned)w0; w.y = (unsigned)w1;
                    *(pg8::u32x2*)((unsigned char*)ACT + (size_t)pair * DFF + col) = w; }
            }
    }
};
struct EpiY {
    static constexpr bool PERM = true; static constexpr int MID_T = -1;
    bf16* Y; const float* b_dn; const LAS int* idx;
    struct Pre { f32x4 b00, b01, b10, b11; };
    __device__ __forceinline__ Pre pre(const pg8::Unit& u, int, int wc, int, int fq) const { const float* bb = b_dn + (size_t)u.e * D + u.pn * 256 + wc * 32 + 8 * fq;
        return Pre{*(const f32x4*)bb, *(const f32x4*)(bb + 4), *(const f32x4*)(bb + 128), *(const f32x4*)(bb + 132)}; }
    __device__ __forceinline__ void mid(pg8::f32x4 (&)[2][2][4][2], const pg8::Unit&, int, int, int, int) const {}
    __device__ __forceinline__ void operator()(pg8::f32x4 (&acc)[2][2][4][2], const pg8::Unit& u, int wr, int wc, int fr, int fq, const Pre& q) const {
        const int col0 = u.pn * 256 + wc * 32 + 8 * fq;
        f32x4 bv[2][2]; bv[0][0] = q.b00; bv[0][1] = q.b01; bv[1][0] = q.b10; bv[1][1] = q.b11;
#pragma unroll
        for (int ai = 0; ai < 2; ++ai)
#pragma unroll
            for (int m = 0; m < 4; ++m) {
                const int pair = idx[u.ui * 256 + ai * 128 + wr * 64 + m * 16 + fr];
                if (pair >= 0) {
#pragma unroll
                    for (int bj = 0; bj < 2; ++bj) { const pg8::f32x4 v0 = acc[ai][bj][m][0] * MOE_DESCALE + bv[bj][0], v1 = acc[ai][bj][m][1] * MOE_DESCALE + bv[bj][1];
                        pg8::u32x4 w; w.x = pg8::cvt_pk_bf16(v0[0], v0[1]); w.y = pg8::cvt_pk_bf16(v0[2], v0[3]); w.z = pg8::cvt_pk_bf16(v1[0], v1[1]); w.w = pg8::cvt_pk_bf16(v1[2], v1[3]);
                        *(pg8::u32x4*)(Y + (size_t)pair * D + col0 + bj * 128) = w; }
                }
            }
    }
};
__device__ __forceinline__ void p9_rows(const Params& p, int wave, int lane, int vcu, int G) {
    for (int grp = vcu; grp < T / 64; grp += G) {
        const int row0 = grp * 64 + wave * 8, b = row0 / SEQ;
        f32x4 gf[2][2];
#pragma unroll
        for (int j = 0; j < 2; ++j)
#pragma unroll
            for (int q = 0; q < 2; ++q) { const int k = 8 * lane + 512 * j + 4 * q; gf[j][q] = *(const f32x4*)(P_modp + MODF_OFF + (size_t)(b * 4 + 3) * D + k) * *(const f32x4*)(P_g_post_ffn + k); }
#pragma unroll 1
        for (int rb = 0; rb < 8; rb += 2) {
            v4u yw[2][4][2]; f32x4 xv[2][2][2]; f32x4 pr[2];
#pragma unroll
            for (int r = 0; r < 2; ++r) { const int m = row0 + rb + r; pr[r] = *(const f32x4*)(P_prob + (size_t)m * 4);
#pragma unroll
                for (int kk = 0; kk < 4; ++kk)
#pragma unroll
                    for (int j = 0; j < 2; ++j) yw[r][kk][j] = __builtin_nontemporal_load((const GAS v4u*)(P_Y + ((size_t)m * 4 + kk) * D) + lane + 64 * j);
#pragma unroll
                for (int j = 0; j < 2; ++j)
#pragma unroll
                    for (int q = 0; q < 2; ++q) xv[r][j][q] = *((const GAS f32x4*)(P_out + (size_t)m * D) + 2 * lane + 128 * j + q); }
            f32x4 f[2][2][2]; float ss[2];
#pragma unroll
            for (int r = 0; r < 2; ++r) { float s = 0.f;
#pragma unroll
                for (int j = 0; j < 2; ++j) { f32x4 f0 = {0.f, 0.f, 0.f, 0.f}, f1 = f0;
#pragma unroll
                    for (int kk = 0; kk < 4; ++kk) { const v4u w = yw[r][kk][j]; const float pk = pr[r][kk];
                        f0 += (f32x4){__uint_as_float(w.x << 16), __uint_as_float(w.x & 0xffff0000u), __uint_as_float(w.y << 16), __uint_as_float(w.y & 0xffff0000u)} * pk;
                        f1 += (f32x4){__uint_as_float(w.z << 16), __uint_as_float(w.z & 0xffff0000u), __uint_as_float(w.w << 16), __uint_as_float(w.w & 0xffff0000u)} * pk; }
                    f[r][j][0] = f0; f[r][j][1] = f1; s += (f0.x * f0.x + f0.y * f0.y) + (f0.z * f0.z + f0.w * f0.w) + (f1.x * f1.x + f1.y * f1.y) + (f1.z * f1.z + f1.w * f1.w); }
                ss[r] = s; }
#pragma unroll
            for (int o = 1; o < 64; o <<= 1) {
#pragma unroll
                for (int r = 0; r < 2; ++r) ss[r] += __shfl_xor(ss[r], o); }
#pragma unroll
            for (int r = 0; r < 2; ++r) { const int m = row0 + rb + r; const float rstd = 1.f / sqrtf(ss[r] * (1.f / D) + EPS);
#pragma unroll
                for (int j = 0; j < 2; ++j)
#pragma unroll
                    for (int q = 0; q < 2; ++q) __builtin_nontemporal_store(xv[r][j][q] + gf[j][q] * (f[r][j][q] * rstd), (GAS f32x4*)(P_out + (size_t)m * D) + 2 * lane + 128 * j + q); }
        }
    }
}
}

namespace mk {
namespace at {
typedef float f32x16 __attribute__((ext_vector_type(16)));
typedef short s16x4 __attribute__((ext_vector_type(4)));
typedef short v4i16_t __attribute__((ext_vector_type(4)));
typedef LAS const char* lds_cptr;
constexpr int KSLOT = 8192, VSLOT = 16384;
constexpr int L_K = 0, L_V = 3 * KSLOT, L_WS = L_V + 3 * VSLOT, L_ST = L_WS + NW * 256, L_END = L_ST + NW * 8192;
static_assert(L_END <= MISC_OFF, "attention LDS map");
__device__ __forceinline__ int crow(int r, int hi) { return (r & 3) + 8 * (r >> 2) + 4 * hi; }
__device__ __forceinline__ void glds16(const void* gsrc, unsigned lds_dst) { unsigned keep;
    asm volatile("s_mov_b32 %0, m0\n\ts_mov_b32 m0, %2\n\ts_nop 0\n\tglobal_load_lds_dwordx4 %1, off\n\ts_mov_b32 m0, %0" : "=&s"(keep) : "v"(gsrc), "s"(lds_dst) : "memory"); }
__device__ __forceinline__ void glds16s(const void* sbase, unsigned voff, unsigned lds_dst) { unsigned keep;
    asm volatile("s_mov_b32 %0, m0\n\ts_mov_b32 m0, %3\n\ts_nop 0\n\tglobal_load_lds_dwordx4 %1, %2\n\ts_mov_b32 m0, %0" : "=&s"(keep) : "v"(voff), "s"(sbase), "s"(lds_dst) : "memory"); }
__device__ __forceinline__ unsigned cvtpk(float lo, float hi) { typedef float f2 __attribute__((ext_vector_type(2))); typedef __bf16 b2 __attribute__((ext_vector_type(2))); f2 v = {lo, hi}; b2 b = __builtin_convertvector(v, b2); return __builtin_bit_cast(unsigned, b); }
__device__ __forceinline__ s16x4 vtr(lds_cptr p) { return __builtin_bit_cast(s16x4, __builtin_amdgcn_ds_read_tr16_b64_v4i16((LAS v4i16_t*)p)); }
__device__ __forceinline__ float swap_max(float m) { auto rr = __builtin_amdgcn_permlane32_swap(__float_as_uint(m), __float_as_uint(m), false, false); return fmaxf(__uint_as_float(rr[0]), __uint_as_float(rr[1])); }
__device__ __forceinline__ float swap_sum(float m) { auto rr = __builtin_amdgcn_permlane32_swap(__float_as_uint(m), __float_as_uint(m), false, false); return __uint_as_float(rr[0]) + __uint_as_float(rr[1]); }
#define AT_MFMA(a, b, c) __builtin_amdgcn_mfma_f32_32x32x16_bf16(a, b, c, 0, 0, 0)
__device__ __forceinline__ float at_max3(float a, float b, float c) { float r; asm("v_max3_f32 %0, %1, %2, %3" : "=v"(r) : "v"(a), "v"(b), "v"(c)); return r; }

constexpr float THRL = 8.f;
template <int VAR>
__device__ __forceinline__ void attn_unit(const Params& p, LAS unsigned char* lds, int tid, int b, int h, int qb, float lam, bf16* AMo) {
    const int lane = tid & 63, r32 = lane & 31, hi = lane >> 5; const int wid = __builtin_amdgcn_readfirstlane(tid >> 6);
    const size_t rowbase = (size_t)b * SEQ;
    const int q0 = qb * 256 + wid * 32;
    const int NT = 4 * qb + 4;
    const int my_last = 4 * qb + (wid >> 1);
    const unsigned lds0 = (unsigned)(uintptr_t)lds;
    LAS float* wsf = (LAS float*)(lds + L_WS) + wid * 64;
    const lds_cptr kp0 = (lds_cptr)(lds + L_K) + hi * 1024 + r32 * 16;
    const lds_cptr vp0 = (lds_cptr)(lds + L_V) + ((lane >> 4) & 1) * 32 + (lane & 3) * 8 + (4 * hi + ((lane & 15) >> 2)) * 64;
    LAS unsigned short* const stg = (LAS unsigned short*)(lds + L_ST + wid * 8192);
#pragma unroll 1
    for (int mp = 0; mp < 2; ++mp) {
        const int n = 2 * h + mp;
        bf16x8 qr[4];
        { const bf16* qw = P_QKV + (rowbase + q0 + r32) * 3072 + n * 64 + hi * 8;
#pragma unroll
          for (int d0 = 0; d0 < 4; ++d0) qr[d0] = *(const GAS bf16x8*)(qw + d0 * 16); }
        asm volatile("" : "+v"(qr[0]), "+v"(qr[1]), "+v"(qr[2]), "+v"(qr[3]));
        const char* kbase = (const char*)(P_QKV + rowbase * 3072 + 1024 + n * 64 + wid * 8);
        const char* vbase = (const char*)(P_QKV + (rowbase + 16 * (wid & 3)) * 3072 + 2048 + h * 128 + (wid >> 2) * 32);
        const unsigned klo = (unsigned)lane * 6144u, vlo = (unsigned)(lane >> 2) * 6144u + (unsigned)(lane & 3) * 16u;
#define AT_DMA(t, s) do { const size_t to_ = (size_t)(t) * 64 * 6144; \
                          glds16s(kbase + to_, klo, (unsigned)__builtin_amdgcn_readfirstlane(lds0 + L_K + (s) * KSLOT + wid * 1024)); \
                          glds16s(vbase + to_, vlo, (unsigned)__builtin_amdgcn_readfirstlane(lds0 + L_V + (s) * VSLOT + wid * 1024)); \
                          glds16s(vbase + to_ + 128, vlo, (unsigned)__builtin_amdgcn_readfirstlane(lds0 + L_V + (s) * VSLOT + (wid + 8) * 1024)); } while (0)
        AT_DMA(0, 0); AT_DMA(1, 1);
        f32x16 o[4];
        float mrow = 0.f, lsum = 0.f;
        int s = 0;
        f32x16 pA0, pA1, pB0, pB1;
        f32x16 negm = {0.f, 0.f, 0.f, 0.f, 0.f, 0.f, 0.f, 0.f, 0.f, 0.f, 0.f, 0.f, 0.f, 0.f, 0.f, 0.f};
#define AT_KRD(dst, kb, d0) do { dst[0] = *(const LAS bf16x8*)((kb) + (d0) * 2048); dst[1] = *(const LAS bf16x8*)((kb) + (d0) * 2048 + 512); } while (0)
#define AT_QK(P0, P1, sl) do { const lds_cptr kb_ = kp0 + (sl) * KSLOT; bf16x8 ka_[2], kb2_[2]; \
            AT_KRD(ka_, kb_, 0); AT_KRD(kb2_, kb_, 1); __builtin_amdgcn_sched_barrier(0); \
            P0 = AT_MFMA(ka_[0], qr[0], negm); P1 = AT_MFMA(ka_[1], qr[0], negm); AT_KRD(ka_, kb_, 2); __builtin_amdgcn_sched_barrier(0); \
            P0 = AT_MFMA(kb2_[0], qr[1], P0); P1 = AT_MFMA(kb2_[1], qr[1], P1); AT_KRD(kb2_, kb_, 3); __builtin_amdgcn_sched_barrier(0); \
            P0 = AT_MFMA(ka_[0], qr[2], P0); P1 = AT_MFMA(ka_[1], qr[2], P1); __builtin_amdgcn_sched_barrier(0); \
            P0 = AT_MFMA(kb2_[0], qr[3], P0); P1 = AT_MFMA(kb2_[1], qr[3], P1); __builtin_amdgcn_sched_barrier(0); } while (0)
#define AT_VRD(i, ks0) do { const s16x4 lo_ = vtr(vb_ + ((i) & 3) * 4096 + ((ks0) + ((i) >> 2)) * 1024), hh_ = vtr(vb_ + ((i) & 3) * 4096 + ((ks0) + ((i) >> 2)) * 1024 + 512); \
            F_[i] = (bf16x8){lo_[0], lo_[1], lo_[2], lo_[3], hh_[0], hh_[1], hh_[2], hh_[3]}; } while (0)
#define AT_MX3(a, b, c) at_max3(a, b, c)
#define AT_STEP(PC0, PC1, PN0, PN1, T) do { \
            asm volatile("s_waitcnt vmcnt(0) lgkmcnt(0)\n\ts_barrier" ::: "memory");     \
            const int s1_ = (s == 2) ? 0 : s + 1, s2_ = (s1_ == 2) ? 0 : s1_ + 1; \
            if ((T) + 2 < NT) AT_DMA((T) + 2, s2_); \
            if (VAR != 1 && (T) <= my_last) { \
                float ra_ = AT_MX3(PC0[0], PC0[1], PC1[0]), rb_ = AT_MX3(PC0[2], PC0[3], PC1[1]); ra_ = AT_MX3(ra_, PC1[2], PC1[3]); \
                _Pragma("unroll") for (int r = 4; r < 16; r += 4) { ra_ = AT_MX3(ra_, PC0[r], PC0[r + 1]); rb_ = AT_MX3(rb_, PC0[r + 2], PC0[r + 3]); ra_ = AT_MX3(ra_, PC1[r], PC1[r + 1]); rb_ = AT_MX3(rb_, PC1[r + 2], PC1[r + 3]); } \
                float rm_ = swap_max(fmaxf(ra_, rb_));                   \
                if ((T) == 0 || __any(rm_ > THRL)) {                      \
                    const float dl_ = ((T) == 0) ? rm_ : fmaxf(rm_, 0.f); \
                    mrow += dl_; \
                    _Pragma("unroll") for (int r = 0; r < 16; ++r) { PC0[r] -= dl_; PC1[r] -= dl_; negm[r] = -mrow; } \
                    if ((T) != 0) { const float al_ = __builtin_amdgcn_exp2f(-dl_); lsum *= al_; \
                        if (hi == 0) wsf[r32] = al_; \
                        asm volatile("s_waitcnt lgkmcnt(0)" ::: "memory"); \
                        _Pragma("unroll") for (int r = 0; r < 16; ++r) { const float f_ = wsf[crow(r, hi)]; \
                            _Pragma("unroll") for (int d0 = 0; d0 < 4; ++d0) o[d0][r] *= f_; } } } \
                __builtin_amdgcn_sched_barrier(0); \
                if ((T) + 1 <= my_last) AT_QK(PN0, PN1, s1_);             \
                if (VAR == 2) { asm volatile("" :: "v"(PC0), "v"(PC1)); } else { \
                const lds_cptr vb_ = vp0 + s * VSLOT; v4u pw_[4]; bf16x8 F_[8]; float sacc_ = 0.f; \
                if (VAR != 3) { AT_VRD(0, 0); AT_VRD(1, 0); AT_VRD(2, 0); AT_VRD(3, 0); AT_VRD(4, 0); AT_VRD(5, 0); AT_VRD(6, 0); AT_VRD(7, 0); }     \
                __builtin_amdgcn_sched_barrier(0); \
                _Pragma("unroll") for (int r = 0; r < 16; ++r) { PC0[r] = __builtin_amdgcn_exp2f(PC0[r]); sacc_ += PC0[r]; } \
                _Pragma("unroll") for (int i = 0; i < 4; ++i) { pw_[0][i] = cvtpk(PC0[2 * i], PC0[2 * i + 1]); pw_[1][i] = cvtpk(PC0[8 + 2 * i], PC0[9 + 2 * i]); } \
                __builtin_amdgcn_sched_barrier(0); \
                  \
                AT_GAP1(PC1, 0); AT_GAP1(PC1, 1); AT_GAP1(PC1, 2); AT_GAP1(PC1, 3); AT_GAP1(PC1, 4); AT_GAP1(PC1, 5); AT_GAP1(PC1, 6); AT_GAP1(PC1, 7); \
                _Pragma("unroll") for (int i = 0; i < 4; ++i) { pw_[2][i] = cvtpk(PC1[2 * i], PC1[2 * i + 1]); pw_[3][i] = cvtpk(PC1[8 + 2 * i], PC1[9 + 2 * i]); } \
                lsum += sacc_; \
                __builtin_amdgcn_sched_barrier(0); \
                if (VAR != 3) { _Pragma("unroll") for (int i = 0; i < 8; ++i) o[i & 3] = AT_MFMA(__builtin_bit_cast(bf16x8, pw_[2 + (i >> 2)]), F_[i], o[i & 3]); } else { asm volatile("" :: "v"(pw_[0]), "v"(pw_[1]), "v"(pw_[2]), "v"(pw_[3])); } \
                __builtin_amdgcn_sched_barrier(0); \
            } } \
            s = s1_; } while (0)
#define AT_GAP1(P1, i) do { if (VAR != 3) { o[(i) & 3] = AT_MFMA(__builtin_bit_cast(bf16x8, pw_[(i) >> 2]), F_[i], o[(i) & 3]); AT_VRD(i, 2); } \
            P1[2 * (i)] = __builtin_amdgcn_exp2f(P1[2 * (i)]); P1[2 * (i) + 1] = __builtin_amdgcn_exp2f(P1[2 * (i) + 1]); sacc_ += P1[2 * (i)]; sacc_ += P1[2 * (i) + 1]; \
            asm volatile("" : "+v"(P1), "+v"(sacc_)); __builtin_amdgcn_sched_barrier(0); } while (0)
        asm volatile("s_waitcnt vmcnt(3)\n\ts_barrier" ::: "memory");
#pragma unroll
        for (int r = 0; r < 16; ++r) {
#pragma unroll
            for (int d0 = 0; d0 < 4; ++d0) o[d0][r] = 0.f; }
        if (VAR != 1) AT_QK(pA0, pA1, 0);
        asm volatile("s_nop 7\n\ts_nop 7" ::: "memory");
#pragma unroll 1
        for (int t = 0; t < NT; t += 2) {
            AT_STEP(pA0, pA1, pB0, pB1, t);
            AT_STEP(pB0, pB1, pA0, pA1, t + 1);
        }
        asm volatile("s_waitcnt lgkmcnt(0)\n\ts_barrier" ::: "memory");
#undef AT_STEP
#undef AT_GAP1
#undef AT_MX3
#undef AT_VRD
#undef AT_QK
#undef AT_KRD
        int le_ = lane; asm volatile("" : "+v"(le_)); const int r32e = le_ & 31, hie = le_ >> 5;
        LAS unsigned short* const stge = (LAS unsigned short*)(lds + L_ST + wid * 8192) + r32e;
        lsum = swap_sum(lsum);
        if (hie == 0) wsf[32 + r32e] = 1.f / lsum;
        asm volatile("s_waitcnt lgkmcnt(0)" ::: "memory");
        float rli[16];
#pragma unroll
        for (int r = 0; r < 16; ++r) rli[r] = wsf[32 + crow(r, hie)];
        asm volatile("s_waitcnt lgkmcnt(0)" ::: "memory");
        if (mp == 0) {
#pragma unroll
            for (int r = 0; r < 16; ++r) { const int q = crow(r, hie);
#pragma unroll
                for (int d0 = 0; d0 < 4; ++d0) stge[q * 128 + 32 * d0] = (unsigned short)f2bf(o[d0][r] * rli[r]); }
            asm volatile("s_waitcnt lgkmcnt(0)" ::: "memory");
        } else {
            float ssq[16];
#pragma unroll
            for (int r = 0; r < 16; ++r) { ssq[r] = 0.f; const int q = crow(r, hie);
#pragma unroll
                for (int d0 = 0; d0 < 4; ++d0) { const float a0 = __uint_as_float((unsigned)stge[q * 128 + 32 * d0] << 16); const float v0 = a0 - lam * (o[d0][r] * rli[r]); o[d0][r] = v0; ssq[r] += v0 * v0; } }
            asm volatile("s_waitcnt lgkmcnt(0)" ::: "memory");
#pragma unroll
            for (int off = 1; off < 32; off <<= 1)
#pragma unroll
                for (int r = 0; r < 16; ++r) ssq[r] += __shfl_xor(ssq[r], off);
#pragma unroll
            for (int r = 0; r < 16; ++r) { const float rs = (1.f / sqrtf(ssq[r] * (1.f / 128.f) + EPS)) * 0.8f; const int q = crow(r, hie);
#pragma unroll
                for (int d0 = 0; d0 < 4; ++d0) { stge[q * 128 + 32 * d0] = (unsigned short)f2bf(o[d0][r] * rs * P_g_sub[r32e + 32 * d0]); } }
            asm volatile("s_waitcnt lgkmcnt(0)" ::: "memory");
            bf16* ow = AMo + (rowbase + q0) * 1536 + h * 128;
#pragma unroll
            for (int i = 0; i < 8; ++i) { const int row = i * 4 + (le_ >> 4), ch = le_ & 15; const v4u v = *(const LAS v4u*)(stge - r32e + row * 128 + ch * 8); *(GAS v4u*)(ow + (size_t)row * 1536 + ch * 8) = v; }
        }
#undef AT_DMA
    }
}
}
template <int VAR = 0>
__device__ __forceinline__ void attn_phase(const Params& p, LAS unsigned char* lds, int tid, int vcu, int G) {
    const float lam = lam_value(p, tid & 63);
    bf16* AMo = VAR == 0 ? P_AM : P_ACT;
    for (int pr = vcu; pr < 256; pr += G) {
        const int bh = pr >> 2, s = pr & 3, b = bh >> 3, h = bh & 7;
#pragma unroll 1
        for (int u = 0; u < 2; ++u) at::attn_unit<VAR>(p, lds, tid, b, h, u ? 7 - s : s, lam, AMo);
    }
}
}

namespace mk {
constexpr int NPH = 10;
#ifndef MK_SKIP
#define MK_SKIP 0
#endif
#ifndef MK_REPEAT
#define MK_REPEAT 0
#endif
#ifndef MK_PROFILE_PREFIX
#define MK_PROFILE_PREFIX 0
#endif
__global__ void __launch_bounds__(NTHR, 2) mega(Params p) {
    extern __shared__ __attribute__((aligned(16))) unsigned char lds_raw[];
    LAS unsigned char* lds = (LAS unsigned char*)lds_raw;
    volatile LAS unsigned* MISC = (volatile LAS unsigned*)(lds + MISC_OFF);
    const int tid0 = threadIdx.x;
    typedef __attribute__((address_space(4))) const Params CParams;
    CParams* const kp0 = (CParams*)__builtin_amdgcn_kernarg_segment_ptr();
#define FRESH int tid = tid0; asm volatile("" : "+v"(tid)); const int lane = tid & 63, wave = __builtin_amdgcn_readfirstlane(tid >> 6); (void)lane; (void)wave; \
              CParams* kp_ = kp0; asm volatile("" : "+s"(kp_)); Params p; { typedef __attribute__((address_space(4))) const unsigned long long cu64_; cu64_* s_ = (cu64_*)kp_; unsigned long long* d_ = (unsigned long long*)&p; \
              _Pragma("unroll") for (int i_ = 0; i_ < (int)(sizeof(Params) / 8); ++i_) d_[i_] = s_[i_]; }
    const int G = gridDim.x; const int bx = blockIdx.x; const int vcu = (G % 8 == 0) ? (bx % 8) * (G / 8) + bx / 8 : bx;
    if (tid0 < 64) MISC[tid0] = 0u;
    __syncthreads();
    XcdBarrier bar = xcd_barrier_post(P_ctl + CW_BAR + p.li * XCD_BAR_WORDS, MISC + 8);
    LAS int* pre = (LAS int*)(lds + TAB_OFF); LAS int* idx = (LAS int*)(lds + TAB_OFF + 512);
#ifdef MK_DOUBLE_BAR
#define SEAM(k) do { if (IN(k) && IN((k) + 1)) { xcd_barrier(bar); xcd_barrier(bar); } } while (0)
#else
#define SEAM(k) do { if (IN(k) && IN((k) + 1)) xcd_barrier(bar); } while (0)
#endif
#ifndef MK_ATTN_VAR
#define MK_ATTN_VAR 0
#endif
#define PHASE(k, ...) if (IN(k) && !(MK_SKIP & (1 << (k)))) { { FRESH; __VA_ARGS__ } if (MK_REPEAT & (1 << (k))) { __syncthreads(); FRESH; __VA_ARGS__ } } SEAM(k);
#ifdef MK_P2_NULL
#define PHASE_P2NULL if (IN(2)) { FRESH; pg8::Gemm g{P_U, D}; pg8::StaticOrder S; S.init(T, INW, D, D, P_Wt_in, G, bx); EpiNull E{}; pg8::gemm_phase<EpiNull, pg8::StaticOrder, true>(lds + RING_OFF, g, S, E, tid); xcd_barrier(bar); }
#else
#define PHASE_P2NULL
#endif
#ifdef MK_P7_NULL
#define PHASE_P7NULL if (IN(7)) { FRESH; MoeSched S{P_Wt_gu, (size_t)2 * DFF * D / 2, D / 2, 8, 2, D / 2, G, bx, 0, nullptr, nullptr, nullptr}; moe_setup(p, S, pre, idx, tid); pg8::Gemm g{P_U, D / 2}; EpiNull E{}; pg8::gemm_phase<EpiNull, MoeSched, true, true>(lds + RING_OFF, g, S, E, tid); xcd_barrier(bar); }
#else
#define PHASE_P7NULL
#endif
#define PROGRAM \
    PHASE(0, p0_prologue(p, lds, tid, wave, lane, vcu, G);) \
    PHASE(1, p1_rows(p, lds, tid, wave, lane, vcu, G);) \
    PHASE(2, pg8::Gemm g{P_U, D}; pg8::StaticOrder S; S.init(T, INW, D, D, P_Wt_in, G, bx); \
             EpiZ E{P_QKV, P_PB, P_GR, P_SGP, P_rope}; \
             pg8::gemm_phase<EpiZ, pg8::StaticOrder, true>(lds + RING_OFF, g, S, E, tid);) \
    PHASE_P2NULL \
    PHASE(3, if (!(p.flags & 2)) attn_phase<0>(p, lds, tid, vcu, G); \
             pool_phase(p, lds, tid, wave, lane, vcu, G); \
             if (MK_ATTN_VAR) { __syncthreads(); attn_phase<MK_ATTN_VAR>(p, lds, tid, vcu, G); }) \
    PHASE(4, pg8::Gemm g{P_AM, 1536}; pg8::StaticOrder S; S.init(T, D, 1536, 1536, P_Wt_mix, G, bx); \
             EpiMerge E{P_GR, P_SGP, P_MERGED}; \
             pg8::gemm_phase<EpiMerge, pg8::StaticOrder, true>(lds + RING_OFF, g, S, E, tid);) \
    PHASE(5, if (MK_PROFILE_PREFIX && bx == 0 && tid < NE) __hip_atomic_store(P_ctl + CW_CNT + 64 * tid, 0u, __ATOMIC_RELAXED, __HIP_MEMORY_SCOPE_AGENT); \
             pg8::Gemm g{P_MERGED, D}; pg8::StaticOrder S; S.init(T, D, D, D, P_Wt_out, G, bx); \
             EpiStore E{P_MIXOUT, D}; \
             pg8::gemm_phase<EpiStore, pg8::StaticOrder, true>(lds + RING_OFF, g, S, E, tid);) \
    PHASE(6, p6_rows(p, lds, tid, wave, lane, vcu, G);) \
    PHASE(7, MoeSched S{P_Wt_gu, (size_t)2 * DFF * D / 2, D / 2, 8, 2, D / 2, G, bx, 0, nullptr, nullptr, nullptr};     \
             moe_setup(p, S, pre, idx, tid); \
             pg8::Gemm g{P_U, D / 2}; EpiAct E{P_ACT, P_b_gu, idx}; \
             pg8::gemm_phase<EpiAct, MoeSched, true, true>(lds + RING_OFF, g, S, E, tid);) \
    PHASE_P7NULL \
    PHASE(8, MoeSched S{P_Wt_dn, (size_t)D * DFF / 2, DFF / 2, 4, 0, DFF / 2, G, bx, 0, nullptr, nullptr, nullptr}; \
             moe_setup(p, S, pre, idx, tid); \
             pg8::Gemm g{P_ACT, DFF / 2}; EpiY E{P_Y, P_b_dn, idx}; \
             pg8::gemm_phase<EpiY, MoeSched, true, true>(lds + RING_OFF, g, S, E, tid);) \
    PHASE(9, p9_rows(p, wave, lane, vcu, G);)
#if MK_PROFILE_PREFIX
    {
#define IN(k) ((k) < MK_PROFILE_PREFIX)
        PROGRAM
#undef IN
        xcd_barrier(bar);
    }
#endif
    {
        const int lo = p.ph_lo, hi = p.ph_hi;
#define IN(k) (lo <= (k) && (k) < hi)
        PROGRAM
#undef IN
    }
#undef PROGRAM
#undef SEAM
#undef PHASE
#undef FRESH
}
}

static int g_grid = 0;
static int mk_setup() {
    if (g_grid) return g_grid;
    int dev = 0, cus = 0;
    if (hipGetDevice(&dev) != hipSuccess || hipDeviceGetAttribute(&cus, hipDeviceAttributeMultiprocessorCount, dev) != hipSuccess) { g_grid = -1; return -1; }
    if (hipFuncSetAttribute((const void*)mk::mega, hipFuncAttributeMaxDynamicSharedMemorySize, mk::LDS_BYTES) != hipSuccess) { g_grid = -1; return -1; }
    int per_cu = 0;
    if (hipOccupancyMaxActiveBlocksPerMultiprocessor(&per_cu, (const void*)mk::mega, mk::NTHR, mk::LDS_BYTES) != hipSuccess || per_cu < 1) { fprintf(stderr, "kernel_launch: occupancy query reports %d workgroups per CU\n", per_cu); }
    (void)hipGetLastError();
    g_grid = cus;
    return g_grid;
}
extern "C" void kernel_launch(void* const* d_in, const int* in_sizes, int n_in, void* d_out, int out_size, void* d_ws, size_t ws_size, hipStream_t stream) {
    if (mk_setup() < 0 || n_in != 26) return;
    unsigned char* wsb = (unsigned char*)d_ws;
    const size_t MiB = 1u << 20;
    mk::Params p{};
    p.x = (const GAS float*)d_in[0]; p.c = (const GAS float*)d_in[1]; p.pos = (const GAS int*)d_in[2]; p.w_mod = (const GAS float*)d_in[3]; p.b_mod = (const GAS float*)d_in[4]; p.g_pre_mix = (const GAS float*)d_in[5];
    p.w_in = (const GAS float*)d_in[6]; p.lq1 = (const GAS float*)d_in[7]; p.lk1 = (const GAS float*)d_in[8]; p.lq2 = (const GAS float*)d_in[9]; p.lk2 = (const GAS float*)d_in[10]; p.g_sub = (const GAS float*)d_in[11];
    p.w_pg = (const GAS float*)d_in[12]; p.pool_scale = (const GAS float*)d_in[13]; p.w_att = (const GAS float*)d_in[14]; p.w_pb = (const GAS float*)d_in[15]; p.w_out = (const GAS float*)d_in[16];
    p.g_post_mix = (const GAS float*)d_in[17]; p.g_pre_ffn = (const GAS float*)d_in[18]; p.w_router = (const GAS float*)d_in[19]; p.b_router = (const GAS float*)d_in[20];
    p.w_gu = (const GAS float*)d_in[21]; p.b_gu = (const GAS float*)d_in[22]; p.w_dn = (const GAS float*)d_in[23]; p.b_dn = (const GAS float*)d_in[24]; p.g_post_ffn = (const GAS float*)d_in[25];
    p.out = (GAS float*)d_out;
    size_t off = 0;
    auto carve = [&](size_t mib) { unsigned char* r = wsb + off; off += mib * MiB; return r; };
    p.ctl = (GAS unsigned*)carve(1); p.modp = (GAS float*)carve(2); p.rope = (GAS float*)carve(1);
    p.Wt_in = (GAS bf16*)carve(11); p.Wt_mix = (GAS bf16*)carve(3); p.Wt_out = (GAS bf16*)carve(2); p.Wt_pg = (GAS bf16*)carve(1);
    p.prob = (GAS float*)carve(1); p.lists = (GAS int*)carve(2);
    p.U = (GAS bf16*)carve(32); p.QKV = (GAS bf16*)carve(96); p.PB = (GAS bf16*)carve(16); p.GR = (GAS bf16*)carve(32); p.SGP = (GAS bf16*)carve(32);
    p.AM = (GAS bf16*)carve(48); p.MERGED = (GAS bf16*)carve(32); p.MIXOUT = (GAS bf16*)carve(32);
    p.Wt_gu = (GAS bf16*)carve(128); p.Wt_dn = (GAS bf16*)carve(64); p.ACT = (GAS bf16*)carve(128); p.Y = (GAS bf16*)carve(128);
    if (off > ws_size) { fprintf(stderr, "kernel_launch: workspace too small: need %zu, have %zu\n", off, ws_size); return; }
    p.flags = 0; p.ph_lo = 0; p.ph_hi = mk::NPH; p.li = 0;
    if (hipMemsetAsync(wsb, 0, 1 * MiB, stream) != hipSuccess) return;
    hipLaunchKernelGGL(mk::mega, dim3(g_grid), dim3(mk::NTHR), mk::LDS_BYTES, stream, p);
}
```
